# Optimizing an MI355X kernel written in HIP

```python
import math
import jax, jax.numpy as jnp
from jax import lax
import numpy as np

D_MODEL = 1024
BATCH = 16
SEQ = 256
DEPTH = 1
DEC_BATCH = 8
DEC_SEQ = 4096
PAST_LEN = 256

GRID_W = 64
N_HEADS = 4
HEAD_DIM = 64
V_DIM = 2 * HEAD_DIM
QK_WIDTH = N_HEADS * 2 * HEAD_DIM
ATTN_WIDTH = N_HEADS * V_DIM
CONV_WIDTH = D_MODEL - ATTN_WIDTH
CONV_K = 3
IN_WIDTH = 2 * QK_WIDTH + ATTN_WIDTH + 3 * CONV_WIDTH
D_FF = -(-8 * D_MODEL // (3 * 256)) * 256
ROPE_THETA = 10000.0
Q_BLOCK = 128
EPS = 1e-6
ATTN_SCALE = HEAD_DIM ** -0.5

kernel_name = "hybrid_diffattn_shortconv_dit_step"


def rms_norm(x, g):
    xf = x.astype(jnp.float32)
    y = xf * lax.rsqrt(jnp.mean(xf * xf, axis=-1, keepdims=True) + EPS)
    return (y * g.astype(jnp.float32)).astype(x.dtype)


def modulation(cond, w_ada, b_ada):
    m = jax.nn.silu(cond) @ w_ada + b_ada
    return jnp.split(m, 6, axis=-1)


def project(x, shift, scale, g_pre, w_in):
    b, n = x.shape[0], x.shape[1]
    u = rms_norm(x, g_pre) * (1.0 + scale) + shift
    p = u @ w_in
    o = 0
    q = p[..., o:o + QK_WIDTH].reshape(b, n, N_HEADS, 2, HEAD_DIM); o += QK_WIDTH
    k = p[..., o:o + QK_WIDTH].reshape(b, n, N_HEADS, 2, HEAD_DIM); o += QK_WIDTH
    v = p[..., o:o + ATTN_WIDTH].reshape(b, n, N_HEADS, V_DIM); o += ATTN_WIDTH
    bg = p[..., o:o + CONV_WIDTH]; o += CONV_WIDTH
    cg = p[..., o:o + CONV_WIDTH]; o += CONV_WIDTH
    xi = p[..., o:o + CONV_WIDTH]
    return q, k, v, bg, cg, xi


def axial_rotary_tables(n):
    rows = n // GRID_W
    t = jnp.arange(rows * GRID_W)
    row = (t // GRID_W).astype(jnp.float32)
    col = (t % GRID_W).astype(jnp.float32)
    n_freq = HEAD_DIM // 4
    inv = 1.0 / (ROPE_THETA ** (jnp.arange(n_freq, dtype=jnp.float32) / n_freq))
    ar = row[:, None] * inv[None, :]
    ac = col[:, None] * inv[None, :]
    shp = (1, n, 1, 1, n_freq)
    return (jnp.cos(ar).reshape(shp), jnp.sin(ar).reshape(shp),
            jnp.cos(ac).reshape(shp), jnp.sin(ac).reshape(shp))


def _rotate(x, cos, sin):
    h = x.shape[-1] // 2
    x1, x2 = x[..., :h], x[..., h:]
    return jnp.concatenate([x1 * cos - x2 * sin, x2 * cos + x1 * sin], axis=-1)


def apply_axial_rotary(x, tables):
    cr, sr, cc, sc = tables
    xf = x.astype(jnp.float32)
    half = HEAD_DIM // 2
    out = jnp.concatenate([_rotate(xf[..., :half], cr, sr),
                           _rotate(xf[..., half:], cc, sc)], axis=-1)
    return out.astype(x.dtype)


def diff_attention(q, k, v, lam, g_subln, lambda_init):
    b, nq = q.shape[0], q.shape[1]
    nb = nq // Q_BLOCK
    qb = q.reshape(b, nb, Q_BLOCK, N_HEADS, 2, HEAD_DIM).swapaxes(0, 1)
    kf = k.astype(jnp.float32)
    vf = v.astype(jnp.float32)

    def block(qblk):
        s = jnp.einsum('bqhmd,bkhmd->bhmqk', qblk.astype(jnp.float32), kf) * ATTN_SCALE
        p = jax.nn.softmax(s, axis=-1)
        a = p[:, :, 0] - lam * p[:, :, 1]
        return jnp.einsum('bhqk,bkhe->bqhe', a, vf)

    o = lax.map(block, qb)
    o = o.swapaxes(0, 1).reshape(b, nq, N_HEADS, V_DIM)
    o = o * lax.rsqrt(jnp.mean(o * o, axis=-1, keepdims=True) + EPS)
    o = o * g_subln.astype(jnp.float32) * (1.0 - lambda_init)
    return o.reshape(b, nq, ATTN_WIDTH).astype(q.dtype)


def gated_short_conv(bg, cg, xi, conv_w, conv_b):
    z = cg * xi
    zp = jnp.pad(z, ((0, 0), (1, 1), (0, 0)))
    y = conv_w[0] * zp[:, :-2] + conv_w[1] * zp[:, 1:-1] + conv_w[2] * zp[:, 2:] + conv_b
    return bg * y


def finish_layer(x, ao, co, gate_a, shift_f, scale_f, gate_f,
                 w_out, g_attn_post, g_ffn_pre, g_ffn_post, w_ffn_in, w_ffn_out):
    mix = jnp.concatenate([ao, co], axis=-1) @ w_out
    x = x + gate_a * rms_norm(mix, g_attn_post)
    u = rms_norm(x, g_ffn_pre) * (1.0 + scale_f) + shift_f
    gu = u @ w_ffn_in
    h = jax.nn.silu(gu[..., :D_FF]) * gu[..., D_FF:]
    return x + gate_f * rms_norm(h @ w_ffn_out, g_ffn_post)


def setup_inputs(seed: int = 0) -> dict:
    key = jax.random.key(seed)
    ks = jax.random.split(key, 24)
    f32 = jnp.float32
    nrm = lambda k, s, sc: jax.random.normal(k, s, f32) * sc
    gain = lambda k, s: 1.0 + 0.1 * jax.random.normal(k, s, f32)
    return {
        "x_prompt": nrm(ks[0], (BATCH, SEQ, D_MODEL), 1.0),
        "x_sample": nrm(ks[1], (DEC_BATCH, DEC_SEQ, D_MODEL), 1.0),
        "cache_k": nrm(ks[2], (DEC_BATCH, DEPTH, PAST_LEN, N_HEADS, 2 * HEAD_DIM), 1.0),
        "cache_v": nrm(ks[3], (DEC_BATCH, DEPTH, PAST_LEN, N_HEADS, V_DIM), 1.0),
        "c": nrm(ks[4], (DEC_BATCH, D_MODEL), 1.0),
        "c_ctx": nrm(ks[5], (D_MODEL,), 1.0),
        "w_ada": nrm(ks[6], (DEPTH, D_MODEL, 6 * D_MODEL), 0.5 * D_MODEL ** -0.5),
        "b_ada": nrm(ks[7], (DEPTH, 6 * D_MODEL), 0.02),
        "g_attn_pre": gain(ks[8], (DEPTH, D_MODEL)),
        "g_attn_post": gain(ks[9], (DEPTH, D_MODEL)),
        "g_ffn_pre": gain(ks[10], (DEPTH, D_MODEL)),
        "g_ffn_post": gain(ks[11], (DEPTH, D_MODEL)),
        "w_in": nrm(ks[12], (DEPTH, D_MODEL, IN_WIDTH), D_MODEL ** -0.5),
        "conv_w": nrm(ks[13], (DEPTH, CONV_K, CONV_WIDTH), CONV_K ** -0.5),
        "conv_b": nrm(ks[14], (DEPTH, CONV_WIDTH), 0.02),
        "lambda_q1": nrm(ks[15], (DEPTH, HEAD_DIM), 0.1),
        "lambda_k1": nrm(ks[16], (DEPTH, HEAD_DIM), 0.1),
        "lambda_q2": nrm(ks[17], (DEPTH, HEAD_DIM), 0.1),
        "lambda_k2": nrm(ks[18], (DEPTH, HEAD_DIM), 0.1),
        "g_subln": gain(ks[19], (DEPTH, V_DIM)),
        "w_out": nrm(ks[20], (DEPTH, D_MODEL, D_MODEL), D_MODEL ** -0.5),
        "w_ffn_in": nrm(ks[21], (DEPTH, D_MODEL, 2 * D_FF), D_MODEL ** -0.5),
        "w_ffn_out": nrm(ks[22], (DEPTH, D_FF, D_MODEL), D_FF ** -0.5),
    }


def reference(x_prompt, x_sample, cache_k, cache_v, c, c_ctx, w_ada, b_ada,
              g_attn_pre, g_attn_post, g_ffn_pre, g_ffn_post, w_in, conv_w, conv_b,
              lambda_q1, lambda_k1, lambda_q2, lambda_k2, g_subln, w_out,
              w_ffn_in, w_ffn_out):
    bp, sp = x_prompt.shape[0], x_prompt.shape[1]
    bs, ns = x_sample.shape[0], x_sample.shape[1]
    tables = axial_rotary_tables(ns)
    xp, xs = x_prompt, x_sample
    new_k, new_v = [], []
    for l in range(DEPTH):
        lambda_init = 0.8 - 0.6 * math.exp(-0.3 * l)
        lam = (jnp.exp(jnp.sum(lambda_q1[l].astype(jnp.float32) * lambda_k1[l].astype(jnp.float32)))
               - jnp.exp(jnp.sum(lambda_q2[l].astype(jnp.float32) * lambda_k2[l].astype(jnp.float32)))
               + lambda_init)

        sa, ca, ga, sf, cf, gf = modulation(c_ctx, w_ada[l], b_ada[l])
        q, k, v, bg, cg, xi = project(xp, sa, ca, g_attn_pre[l], w_in[l])
        ao = diff_attention(q, k, v, lam, g_subln[l], lambda_init)
        co = gated_short_conv(bg, cg, xi, conv_w[l], conv_b[l])
        xp = finish_layer(xp, ao, co, ga, sf, cf, gf, w_out[l], g_attn_post[l],
                          g_ffn_pre[l], g_ffn_post[l], w_ffn_in[l], w_ffn_out[l])
        new_k.append(k.reshape(bp, sp, N_HEADS, 2 * HEAD_DIM))
        new_v.append(v)

        sa, ca, ga, sf, cf, gf = [m[:, None, :] for m in modulation(c, w_ada[l], b_ada[l])]
        q, k, v, bg, cg, xi = project(xs, sa, ca, g_attn_pre[l], w_in[l])
        q = apply_axial_rotary(q, tables)
        k = apply_axial_rotary(k, tables)
        kc = cache_k[:, l].reshape(bs, cache_k.shape[2], N_HEADS, 2, HEAD_DIM)
        k_all = jnp.concatenate([kc, k], axis=1)
        v_all = jnp.concatenate([cache_v[:, l], v], axis=1)
        ao = diff_attention(q, k_all, v_all, lam, g_subln[l], lambda_init)
        co = gated_short_conv(bg, cg, xi, conv_w[l], conv_b[l])
        xs = finish_layer(xs, ao, co, ga, sf, cf, gf, w_out[l], g_attn_post[l],
                          g_ffn_pre[l], g_ffn_post[l], w_ffn_in[l], w_ffn_out[l])

    state_k = jnp.stack(new_k, axis=1)
    state_v = jnp.stack(new_v, axis=1)
    return (xp, xs, state_k, state_v)
```

```cpp
#include <hip/hip_runtime.h>
#include <hip/hip_cooperative_groups.h>
#include <cstdio>
#include <cstdint>
namespace cg = cooperative_groups;
namespace pg8 {
#define PG8_LAS __attribute__((address_space(3)))
typedef unsigned short bf16_t;
typedef short bf16x8 __attribute__((ext_vector_type(8)));
typedef float f32x4 __attribute__((ext_vector_type(4)));
typedef unsigned u32x4 __attribute__((ext_vector_type(4)));
constexpr int BM = 256, BK = 64, HALF = 128, HTB = HALF * BK * 2  , STAGE_BYTES = 8 * HTB, NXCD = 8, WGM = 8;

__host__ __device__ __forceinline__ int lds_byte(int r, int c) { const int st = (r >> 4) * 2 + (c >> 5), rr = r & 15, cc = c & 31, ob = rr * 64 + cc * 2; return st * 1024 + (ob ^ (((ob >> 9) & 1) << 5)); }
__host__ __device__ __forceinline__ void stage_rc(int b, int& R, int& C) { const int st = b / 1024, sb = b % 1024, swz = sb ^ (((sb >> 9) & 1) << 5); R = (st >> 1) * 16 + swz / 64; C = (st & 1) * 32 + (swz % 64) / 2; }
__host__ __device__ __forceinline__ int perm32(int rho) { const int n = rho >> 4, i = rho & 15; return 8 * (i >> 2) + 4 * n + (i & 3); }

struct Unit { int pm, pn; };
struct Gemm { const bf16_t* A; const bf16_t* Bt; int M, N, K; };

struct StaticOrder {
    int nM, nN, nwg, G, c;
    __host__ __device__ void init(int M, int N, int G_, int c_) { nM = M / BM; nN = N / BM; nwg = nM * nN; G = G_; c = c_; }
    __host__ __device__ bool next(int i, Unit& u) const {
        const long L = (long)i * G + c; if (L >= nwg) return false;
        int wgid = (int)L; { const int q = nwg / NXCD, r = nwg % NXCD, xcd = wgid % NXCD, off = wgid / NXCD; wgid = (xcd < r ? xcd * (q + 1) : r * (q + 1) + (xcd - r) * q) + off; }
        const int nig = WGM * nN, gid = wgid / nig, fm = gid * WGM, gsz = (nM - fm) < WGM ? (nM - fm) : WGM;
        u.pm = fm + ((wgid % nig) % gsz); u.pn = (wgid % nig) / gsz; return true;
    }
    __device__ __forceinline__ void a_ready(const Unit&) const {}
    __device__ __forceinline__ void done(const Unit&) const {}
};

__device__ __forceinline__ unsigned cvt_pk_bf16(float lo, float hi) { unsigned r; asm volatile("v_cvt_pk_bf16_f32 %0, %1, %2" : "=v"(r) : "v"(lo), "v"(hi)); return r; }
template <class Epi, class Sched, bool ALIGN_EPI = false, bool SP2 = false>
__device__ __forceinline__ void gemm_phase(PG8_LAS unsigned char* lds, const Gemm g, const Sched& S, const Epi& E) {
    const int tid = threadIdx.x, wid = __builtin_amdgcn_readfirstlane(tid >> 6), lane = tid & 63, wr = wid >> 2, wc = wid & 3, fr = lane & 15, fq = lane >> 4;
    const int K = g.K, nt = K / BK;
    unsigned voffA[2], voffB[2];
#pragma unroll
    for (int i = 0; i < 2; ++i) { int R, C; stage_rc(tid * 16 + i * 8192, R, C); const int Rb = Epi::PERM ? ((R & ~31) + perm32(R & 31)) : R;
        voffA[i] = (unsigned)(R * K + C) * 2u; voffB[i] = (unsigned)(Rb * K + C) * 2u; }
    const size_t kstep = (size_t)(BK * 2);
    const size_t hstep = (size_t)HALF * K * 2;
    const size_t tstep = 2 * hstep;
    const unsigned lds_u = (unsigned)(uintptr_t)lds;
    const unsigned ldsw = (unsigned)wid * 1024u; const unsigned lds_w = (unsigned)__builtin_amdgcn_readfirstlane(lds_u + ldsw);
    const int aoff = lds_byte(wr * 64 + fr, fq * 8), boff = lds_byte(wc * 32 + fr, fq * 8);
#define PG8_SA(b, h) (((b) * 2 + (h)) * HTB)
#define PG8_SB(b, h) ((4 + (b) * 2 + (h)) * HTB)
#define PG8_STAGE(bufoff, gbase, voff) do { _Pragma("unroll") for (int _i = 0; _i < 2; ++_i) { unsigned keep_; \
        asm volatile("s_mov_b32 %0, m0\n\ts_mov_b32 m0, %3\n\ts_nop 0\n\tglobal_load_lds_dwordx4 %1, %2\n\ts_mov_b32 m0, %0" : "=&s"(keep_) \
                     : "v"((voff)[_i]), "s"((const char*)(gbase)), "s"(lds_w + (unsigned)(bufoff) + (unsigned)_i * 8192u) : "memory"); } } while (0)
#define PG8_LDA(dst, b, h) do { _Pragma("unroll") for (int m = 0; m < 4; ++m) _Pragma("unroll") for (int k = 0; k < 2; ++k) dst[m][k] = *(const PG8_LAS bf16x8*)(lds + PG8_SA(b, h) + aoff + m * 2048 + k * 1024); } while (0)
#define PG8_LDB(dst, b, h) do { _Pragma("unroll") for (int n = 0; n < 2; ++n) _Pragma("unroll") for (int k = 0; k < 2; ++k) dst[n][k] = *(const PG8_LAS bf16x8*)(lds + PG8_SB(b, h) + boff + n * 2048 + k * 1024); } while (0)
#define PG8_MMA(ai, bj, At, Bt) do { __builtin_amdgcn_s_setprio(1); _Pragma("unroll") for (int m = 0; m < 4; ++m) _Pragma("unroll") for (int n = 0; n < 2; ++n) _Pragma("unroll") for (int k = 0; k < 2; ++k) \
        acc[ai][bj][m][n] = __builtin_amdgcn_mfma_f32_16x16x32_bf16(Bt[n][k], At[m][k], acc[ai][bj][m][n], 0, 0, 0); __builtin_amdgcn_s_setprio(0); } while (0)
#define PG8_WAIT_V(n) asm volatile("s_waitcnt vmcnt(" #n ")" ::: "memory")
#define PG8_WAIT_L(n) asm volatile("s_waitcnt lgkmcnt(" #n ")" ::: "memory")
#define PG8_BAR __builtin_amdgcn_s_barrier()
#define PG8_SCHED __builtin_amdgcn_sched_barrier(0)
    Unit cur, nxt; int ui = 0;
    if (!S.next(0, cur)) return;
    f32x4 acc[2][2][4][2];
#pragma unroll
    for (int a = 0; a < 2; ++a)
#pragma unroll
        for (int b = 0; b < 2; ++b)
#pragma unroll
            for (int m = 0; m < 4; ++m)
#pragma unroll
                for (int n = 0; n < 2; ++n) acc[a][b][m][n] = (f32x4){0.f, 0.f, 0.f, 0.f};
    bf16x8 At[4][2], B0[2][2], B1[2][2];
    const char* cA = (const char*)g.A + (size_t)cur.pm * tstep; const char* cB = (const char*)g.Bt + (size_t)cur.pn * tstep;
    S.a_ready(cur);
    if constexpr (SP2) {
        PG8_STAGE(PG8_SB(0, 0), cB, voffB); PG8_STAGE(PG8_SB(0, 1), cB + hstep, voffB); PG8_STAGE(PG8_SA(0, 0), cA, voffA); PG8_STAGE(PG8_SA(0, 1), cA + hstep, voffA);
        if (wr == 1) PG8_BAR;
        PG8_WAIT_V(2); PG8_BAR;
        PG8_STAGE(PG8_SB(1, 0), cB + kstep, voffB); PG8_STAGE(PG8_SA(1, 0), cA + kstep, voffA); PG8_STAGE(PG8_SB(1, 1), cB + hstep + kstep, voffB);
        PG8_WAIT_V(6); PG8_BAR;
    } else {
        PG8_STAGE(PG8_SB(0, 0), cB, voffB); PG8_STAGE(PG8_SA(0, 0), cA, voffA); PG8_STAGE(PG8_SB(0, 1), cB + hstep, voffB); PG8_STAGE(PG8_SA(0, 1), cA + hstep, voffA);
        if (wr == 1) PG8_BAR;
        PG8_WAIT_V(4); PG8_BAR;
        PG8_STAGE(PG8_SB(1, 0), cB + kstep, voffB); PG8_STAGE(PG8_SA(1, 0), cA + kstep, voffA); PG8_STAGE(PG8_SB(1, 1), cB + hstep + kstep, voffB);
        PG8_WAIT_V(6); PG8_BAR;
    }
    for (;;) {
        const bool has_next = S.next(ui + 1, nxt);
        const char* nA = has_next ? (const char*)g.A + (size_t)nxt.pm * tstep : cA; const char* nB = has_next ? (const char*)g.Bt + (size_t)nxt.pn * tstep : cB;
        for (int t = 0; t < nt; t += 2) {
            const bool last = (t == nt - 2);
            const char* a1 = cA + (size_t)(t + 1) * kstep;
            const char* a2 = last ? nA : cA + (size_t)(t + 2) * kstep; const char* b2 = last ? nB : cB + (size_t)(t + 2) * kstep;
            const char* a3 = a2 + kstep; const char* b3 = b2 + kstep;
            if (last && has_next) S.a_ready(nxt);
            if constexpr (SP2) {
            PG8_LDB(B0, 0, 0); PG8_LDB(B1, 0, 1); PG8_SCHED; PG8_LDA(At, 0, 0); PG8_STAGE(PG8_SA(1, 1), a1 + hstep, voffA);
            PG8_WAIT_V(8); PG8_WAIT_L(0); PG8_BAR; PG8_MMA(0, 0, At, B0); PG8_MMA(0, 1, At, B1); PG8_BAR; PG8_SCHED;
            PG8_LDA(At, 0, 1); PG8_STAGE(PG8_SB(0, 0), b2, voffB); PG8_STAGE(PG8_SB(0, 1), b2 + hstep, voffB); PG8_STAGE(PG8_SA(0, 0), a2, voffA);
            PG8_WAIT_V(8); PG8_WAIT_L(0); PG8_BAR; PG8_MMA(1, 0, At, B0); PG8_MMA(1, 1, At, B1); PG8_BAR; PG8_SCHED;
            PG8_LDB(B0, 1, 0); PG8_LDB(B1, 1, 1); PG8_SCHED; PG8_LDA(At, 1, 0); PG8_STAGE(PG8_SA(0, 1), a2 + hstep, voffA);
            PG8_WAIT_V(8); PG8_WAIT_L(0); PG8_BAR; PG8_MMA(0, 0, At, B0); PG8_MMA(0, 1, At, B1); PG8_BAR; PG8_SCHED;
            PG8_LDA(At, 1, 1); PG8_STAGE(PG8_SB(1, 0), b3, voffB); PG8_STAGE(PG8_SB(1, 1), b3 + hstep, voffB); PG8_STAGE(PG8_SA(1, 0), a3, voffA);
            PG8_WAIT_V(8); PG8_WAIT_L(0); PG8_BAR; PG8_MMA(1, 0, At, B0); PG8_MMA(1, 1, At, B1); PG8_BAR; PG8_SCHED;
            } else {
            PG8_LDB(B0, 0, 0); PG8_SCHED; PG8_LDA(At, 0, 0); PG8_STAGE(PG8_SA(1, 1), a1 + hstep, voffA);
            PG8_WAIT_L(8); PG8_BAR; PG8_WAIT_L(0); PG8_MMA(0, 0, At, B0); PG8_BAR; PG8_SCHED;
            PG8_LDB(B1, 0, 1); PG8_STAGE(PG8_SB(0, 0), b2, voffB);
            PG8_BAR; PG8_WAIT_L(0); PG8_MMA(0, 1, At, B1); PG8_BAR;
            PG8_LDA(At, 0, 1); PG8_STAGE(PG8_SA(0, 0), a2, voffA);
            PG8_BAR; PG8_WAIT_L(0); PG8_MMA(1, 0, At, B0); PG8_BAR; PG8_SCHED;
            PG8_STAGE(PG8_SB(0, 1), b2 + hstep, voffB);
            PG8_WAIT_V(6); PG8_BAR; PG8_MMA(1, 1, At, B1); PG8_BAR;
            PG8_LDB(B0, 1, 0); PG8_SCHED; PG8_LDA(At, 1, 0); PG8_STAGE(PG8_SA(0, 1), a2 + hstep, voffA);
            PG8_WAIT_L(8); PG8_BAR; PG8_WAIT_L(0); PG8_MMA(0, 0, At, B0); PG8_BAR; PG8_SCHED;
            PG8_LDB(B1, 1, 1); PG8_STAGE(PG8_SB(1, 0), b3, voffB);
            PG8_BAR; PG8_WAIT_L(0); PG8_MMA(0, 1, At, B1); PG8_BAR;
            PG8_LDA(At, 1, 1); PG8_STAGE(PG8_SA(1, 0), a3, voffA);
            PG8_BAR; PG8_WAIT_L(0); PG8_MMA(1, 0, At, B0); PG8_BAR; PG8_SCHED;
            PG8_STAGE(PG8_SB(1, 1), b3 + hstep, voffB);
            PG8_WAIT_V(6); PG8_BAR; PG8_MMA(1, 1, At, B1); PG8_BAR;
            }
        }
        if constexpr (ALIGN_EPI) { if (wr == 0) PG8_BAR; }
        if constexpr (!Epi::AFTER_DRAIN) { E(acc, cur, wr, wc, fr, fq);
#ifdef PROBE_EPI2
            if constexpr (Epi::PROBE_ID == PROBE_EPI2) { asm volatile("" ::: "memory"); E(acc, cur, wr, wc, fr, fq); }
#endif
            S.done(cur); }
        if (!has_next) break;
#pragma unroll
        for (int a = 0; a < 2; ++a)
#pragma unroll
            for (int b = 0; b < 2; ++b)
#pragma unroll
                for (int m = 0; m < 4; ++m)
#pragma unroll
                    for (int n = 0; n < 2; ++n) acc[a][b][m][n] = (f32x4){0.f, 0.f, 0.f, 0.f};
        cur = nxt; cA = nA; cB = nB; ++ui;
        if constexpr (ALIGN_EPI) { if (wr == 1) PG8_BAR; }
    }
    PG8_WAIT_V(0);
    if constexpr (!ALIGN_EPI) { if (wr == 0) PG8_BAR; }
    PG8_BAR;
    if constexpr (Epi::AFTER_DRAIN) { E.fused(acc, cur, wr, wc, fr, fq, lds, wid, lane); S.done(cur); }
#undef PG8_SA
#undef PG8_SB
#undef PG8_STAGE
#undef PG8_LDA
#undef PG8_LDB
#undef PG8_MMA
#undef PG8_WAIT_V
#undef PG8_WAIT_L
#undef PG8_BAR
#undef PG8_SCHED
}
}
#ifndef PG8_SP2
#define PG8_SP2 true
#endif
#ifndef PG8_ALIGN
#define PG8_ALIGN true
#endif
#ifndef MK_COOP
#define MK_COOP 1
#endif

#define LAS __attribute__((address_space(3)))
typedef unsigned short bf16;
typedef unsigned v4u __attribute__((ext_vector_type(4)));
typedef unsigned v2u __attribute__((ext_vector_type(2)));
typedef float f32x4 __attribute__((ext_vector_type(4)));
typedef float f32x16 __attribute__((ext_vector_type(16)));
typedef short bf16x8 __attribute__((ext_vector_type(8)));
typedef short v4i16_t __attribute__((ext_vector_type(4)));
typedef float f32x2_t __attribute__((ext_vector_type(2)));
typedef __bf16 bf16x2_t __attribute__((ext_vector_type(2)));

constexpr int D = 1024, MP = 4096, MS = 32768, M = MP + MS, NIN = 3072, DFF = 2816, NFI = 2 * DFF;
constexpr int SEQ_P = 256, SEQ_S = 4096, PAST = 256, NB_S = 8, NB_P = 16;
constexpr int KV_PER_B = PAST + SEQ_S;
constexpr int KROWS = MP + NB_S * KV_PER_B;
constexpr float EPS = 1e-6f;
constexpr float QSCALE = 0.125f * 1.4426950408889634f;
constexpr int NWAVES = 8, NTHREADS = 512;

constexpr size_t MiB = 1u << 20;
constexpr size_t WS_MOD = 0;
constexpr size_t WS_ROT = 256 * 1024;
constexpr size_t WS_BAR = 512 * 1024, BAR_BYTES = 16384;
constexpr size_t WS_SS1 = 1 * MiB;
constexpr size_t WS_SS2 = 4 * MiB;
constexpr size_t WS_WIN = 8 * MiB, WS_WO = 14 * MiB, WS_WFI = 16 * MiB, WS_WFO = 27 * MiB;
constexpr size_t WS_U = 34 * MiB;
constexpr size_t WS_MIXO = 106 * MiB;
constexpr size_t WS_Q = 178 * MiB;
constexpr size_t WS_K = 214 * MiB;
constexpr size_t WS_V = 252 * MiB;
constexpr size_t WS_MIX = 290 * MiB;
constexpr size_t WS_BG = 362 * MiB;
constexpr size_t WS_Z = 398 * MiB;
constexpr size_t WS_H = 178 * MiB;
constexpr size_t WS_END = 434 * MiB;
static_assert(WS_H + (size_t)M * DFF * 2 <= WS_Z, "H overlay");
static_assert(WS_K + (size_t)KROWS * 512 * 2 <= WS_V && WS_V + (size_t)KROWS * 512 * 2 <= WS_MIX, "kv map");

constexpr int MISC_OFF = 131072 + 1024;
constexpr int LDS_BYTES = 131072 + 2048;

__device__ __forceinline__ unsigned pk2(float lo, float hi) { f32x2_t v = {lo, hi}; bf16x2_t b = __builtin_convertvector(v, bf16x2_t); return __builtin_bit_cast(unsigned, b); }
__device__ __forceinline__ float bf2f(unsigned short b) { return __uint_as_float((unsigned)b << 16); }
__device__ __forceinline__ float wave_sum(float v) {
#pragma unroll
    for (int o = 1; o < 64; o <<= 1) v += __shfl_xor(v, o);
    return v;
}
__device__ __forceinline__ int krow_of(int r) { return r < MP ? r : MP + ((r - MP) >> 12) * KV_PER_B + PAST + ((r - MP) & 4095); }

#define XB_TMO      128
#define XB_XCNT(j)  (256  + 64 * (j))
#define XB_XSUB(j)  (1280 + 64 * (j))
#define XB_XGEN(j)  (2304 + 64 * (j))
#define XB_TOP      3328
#define XB_TOPGEN   3392
#define XCD_BAR_WORDS 3456
#define XB_SPIN_CAP (1u << 18)

__device__ __forceinline__ unsigned xb_ld(unsigned* p)              { return __hip_atomic_load(p, __ATOMIC_RELAXED, __HIP_MEMORY_SCOPE_AGENT); }
__device__ __forceinline__ unsigned xb_add(unsigned* p, unsigned v) { return __hip_atomic_fetch_add(p, v, __ATOMIC_RELAXED, __HIP_MEMORY_SCOPE_AGENT); }
__device__ __forceinline__ unsigned xb_xcc_id() { return (unsigned)__builtin_amdgcn_s_getreg((3 << 11) | 20) & 0xFu; }
#define XB_SPIN(cond, bar) do { unsigned _sp = 0; while (cond) { __builtin_amdgcn_s_sleep(1); \
    if ((++_sp & 255u) == 0u) { if (xb_ld(&(bar)[XB_TMO])) break; if (_sp > XB_SPIN_CAP) { atomicAdd(&(bar)[XB_TMO], 1u); break; } } } } while (0)

struct XcdBarrier {
    unsigned* bar; unsigned x;
    volatile LAS unsigned* st;
};

__device__ __forceinline__ XcdBarrier xcd_barrier_post(unsigned* bar, volatile LAS unsigned* st) {
    XcdBarrier b; b.bar = bar; b.x = xb_xcc_id(); b.st = st;
    if (threadIdx.x == 0) (void)xb_add(&bar[XB_XCNT(b.x)], 1u);
    return b;
}
__device__ __forceinline__ void xcd_barrier_complete(unsigned* bar, unsigned x, unsigned& nloc, unsigned& nx) {
    const unsigned G = gridDim.x * gridDim.y * gridDim.z;
    unsigned sum, cnt, mine, sp = 0u;
    for (;;) {
        sum = 0u; cnt = 0u; mine = 0u;
#pragma unroll
        for (unsigned j = 0; j < 16; ++j) { const unsigned c = xb_ld(&bar[XB_XCNT(j)]); sum += c; cnt += (c > 0u) ? 1u : 0u; mine = (j == x) ? c : mine; }
        if (sum == G) break;
        __builtin_amdgcn_s_sleep(1);
        if ((++sp & 255u) == 0u) { if (xb_ld(&bar[XB_TMO])) break; if (sp > XB_SPIN_CAP) { atomicAdd(&bar[XB_TMO], 1u); break; } }
    }
    nloc = mine > 0u ? mine : 1u; nx = cnt > 0u ? cnt : 1u;
}

__device__ __forceinline__ void xcd_barrier(const XcdBarrier& b) {
    asm volatile("s_waitcnt vmcnt(0)" ::: "memory");
    __syncthreads();
    if (threadIdx.x == 0) {
        unsigned* bar = b.bar;
        __builtin_amdgcn_s_waitcnt(0);
        unsigned nloc = b.st[0], nx = b.st[1];
        if (nloc == 0u) { xcd_barrier_complete(bar, b.x, nloc, nx); b.st[0] = nloc; b.st[1] = nx; }
        const unsigned old = xb_add(&bar[XB_XSUB(b.x)], 1u);
        const unsigned gen = old / nloc;
        if (old + 1u == (gen + 1u) * nloc) {
            __builtin_amdgcn_fence(__ATOMIC_RELEASE, "agent");
            asm volatile("s_waitcnt vmcnt(0)" ::: "memory");
            const unsigned og = xb_add(&bar[XB_TOP], 1u);
            const unsigned tg = og / nx;
            if (og + 1u == (tg + 1u) * nx) xb_add(&bar[XB_TOPGEN], 1u);
            else XB_SPIN(xb_ld(&bar[XB_TOPGEN]) == tg, bar);
            __builtin_amdgcn_fence(__ATOMIC_ACQUIRE, "agent");
            xb_add(&bar[XB_XGEN(b.x)], 1u);
            asm volatile("s_waitcnt vmcnt(0)" ::: "memory");
        } else {
            XB_SPIN(xb_ld(&bar[XB_XGEN(b.x)]) == gen, bar);
            __builtin_amdgcn_fence(__ATOMIC_ACQUIRE, "agent");
            asm volatile("s_waitcnt vmcnt(0)" ::: "memory");
        }
    }
    __syncthreads();
}

namespace pg8 {
struct EpiIn {
    static constexpr bool PERM = true, AFTER_DRAIN = false; static constexpr int PROBE_ID = 1;
    bf16_t *Q, *Kb, *Vb, *BG, *Z; float *stK, *stV; const float* rot;
    __device__ __forceinline__ void operator()(const f32x4 (&acc)[2][2][4][2], const Unit& u, int wr, int wc, int fr, int fq) const {
        const int pn = u.pn; const bool sample = u.pm >= (MP / 256);
        const int rbase = u.pm * BM + wr * 64 + fr;
        const int cp = wc * 32 + 8 * fq;
        if (pn < 4) {
            const bool isq = pn < 2; const int cbp = (pn & 1) * 256 + cp, cbl = (pn & 1) * 256 + wc * 32 + 4 * fq;
            const float qs = isq ? QSCALE : 1.0f;
#pragma unroll
            for (int ai = 0; ai < 2; ++ai)
#pragma unroll
                for (int m = 0; m < 4; ++m) {
                    const int r = rbase + ai * HALF + m * 16;
                    f32x4 cs = (f32x4){1.f, 1.f, 1.f, 1.f}, sn = (f32x4){0.f, 0.f, 0.f, 0.f};
                    if (sample) { const int t = (r - MP) & 4095; const int pos = (wc & 1) ? (t & 63) : (t >> 6);
                        cs = *(const f32x4*)(rot + pos * 16 + 4 * fq); sn = *(const f32x4*)(rot + 1024 + pos * 16 + 4 * fq); }
                    cs = cs * qs; sn = sn * qs;
                    const size_t kr = (size_t)krow_of(r);
#pragma unroll
                    for (int bj = 0; bj < 2; ++bj) {
                        const f32x4 x1 = acc[ai][bj][m][0], x2 = acc[ai][bj][m][1];
                        const f32x4 o1 = x1 * cs - x2 * sn, o2 = x2 * cs + x1 * sn;
                        u32x4 w; w.x = pk2(o1[0], o1[1]); w.y = pk2(o1[2], o1[3]); w.z = pk2(o2[0], o2[1]); w.w = pk2(o2[2], o2[3]);
                        if (isq) *(u32x4*)(Q + (size_t)r * 512 + cbp + bj * HALF) = w;
                        else { *(u32x4*)(Kb + kr * 512 + cbp + bj * HALF) = w;
                            if (!sample) { float* s = stK + (size_t)r * 512 + cbl + bj * HALF; *(f32x4*)s = x1; *(f32x4*)(s + 16) = x2; } }
                    }
                }
        } else if (pn < 8) {
            const bool isv = pn < 6; const int cb = (pn & 1) * 256 + cp;
#pragma unroll
            for (int ai = 0; ai < 2; ++ai)
#pragma unroll
                for (int m = 0; m < 4; ++m) {
                    const int r = rbase + ai * HALF + m * 16;
                    const size_t orow = isv ? (size_t)krow_of(r) : (size_t)r;
                    bf16_t* base = (isv ? Vb : BG) + orow * 512 + cb;
#pragma unroll
                    for (int bj = 0; bj < 2; ++bj) {
                        const f32x4 x1 = acc[ai][bj][m][0], x2 = acc[ai][bj][m][1];
                        u32x4 w; w.x = pk2(x1[0], x1[1]); w.y = pk2(x1[2], x1[3]); w.z = pk2(x2[0], x2[1]); w.w = pk2(x2[2], x2[3]);
                        *(u32x4*)(base + bj * HALF) = w;
                        if (isv && !sample) { float* s = stV + (size_t)r * 512 + cb + bj * HALF; *(f32x4*)s = x1; *(f32x4*)(s + 4) = x2; }
                    }
                }
        } else {
            const int cb = (pn - 8) * 128 + cp;
#pragma unroll
            for (int ai = 0; ai < 2; ++ai)
#pragma unroll
                for (int m = 0; m < 4; ++m) {
                    const int r = rbase + ai * HALF + m * 16;
                    const f32x4 z1 = acc[ai][0][m][0] * acc[ai][1][m][0], z2 = acc[ai][0][m][1] * acc[ai][1][m][1];
                    u32x4 w; w.x = pk2(z1[0], z1[1]); w.y = pk2(z1[2], z1[3]); w.z = pk2(z2[0], z2[1]); w.w = pk2(z2[2], z2[3]);
                    *(u32x4*)(Z + (size_t)r * 512 + cb) = w;
                }
        }
    }
};
struct EpiSS {
    static constexpr bool PERM = true, AFTER_DRAIN = false; static constexpr int PROBE_ID = 2;
    bf16_t* O; float* SS;
    __device__ __forceinline__ void operator()(const f32x4 (&acc)[2][2][4][2], const Unit& u, int wr, int wc, int fr, int fq) const {
        const int rbase = u.pm * BM + wr * 64 + fr; const int c0 = u.pn * BM + wc * 32 + 8 * fq;
#pragma unroll
        for (int ai = 0; ai < 2; ++ai)
#pragma unroll
            for (int m = 0; m < 4; ++m) {
                const int r = rbase + ai * HALF + m * 16; float s = 0.f;
#pragma unroll
                for (int bj = 0; bj < 2; ++bj) {
                    const f32x4 v0 = acc[ai][bj][m][0], v1 = acc[ai][bj][m][1];
                    s += (v0[0] * v0[0] + v0[1] * v0[1]) + (v0[2] * v0[2] + v0[3] * v0[3]) + (v1[0] * v1[0] + v1[1] * v1[1]) + (v1[2] * v1[2] + v1[3] * v1[3]);
                    u32x4 w; w.x = pk2(v0[0], v0[1]); w.y = pk2(v0[2], v0[3]); w.z = pk2(v1[0], v1[1]); w.w = pk2(v1[2], v1[3]);
                    *(u32x4*)(O + (size_t)r * D + c0 + bj * HALF) = w;
                }
                s += __shfl_xor(s, 16); s += __shfl_xor(s, 32);
                if (fq == 0) SS[(size_t)r * 16 + u.pn * 4 + wc] = s;
            }
    }
};
struct EpiGlu {
    static constexpr bool PERM = true, AFTER_DRAIN = false; static constexpr int PROBE_ID = 3;
    bf16_t* H;
    __device__ __forceinline__ void operator()(const f32x4 (&acc)[2][2][4][2], const Unit& u, int wr, int wc, int fr, int fq) const {
        const int rbase = u.pm * BM + wr * 64 + fr; const int c0 = u.pn * HALF + wc * 32 + 8 * fq;
#pragma unroll
        for (int ai = 0; ai < 2; ++ai)
#pragma unroll
            for (int m = 0; m < 4; ++m) {
                const int r = rbase + ai * HALF + m * 16; f32x4 hv[2];
#pragma unroll
                for (int n = 0; n < 2; ++n) { const f32x4 g = acc[ai][0][m][n], up = acc[ai][1][m][n];
                    f32x4 e; e[0] = __builtin_amdgcn_exp2f(g[0]); e[1] = __builtin_amdgcn_exp2f(g[1]); e[2] = __builtin_amdgcn_exp2f(g[2]); e[3] = __builtin_amdgcn_exp2f(g[3]);
                    const f32x4 d = e + 1.0f;
                    f32x4 rc; rc[0] = __builtin_amdgcn_rcpf(d[0]); rc[1] = __builtin_amdgcn_rcpf(d[1]); rc[2] = __builtin_amdgcn_rcpf(d[2]); rc[3] = __builtin_amdgcn_rcpf(d[3]);
                    hv[n] = (g * up) * rc; }
                u32x4 w; w.x = pk2(hv[0][0], hv[0][1]); w.y = pk2(hv[0][2], hv[0][3]); w.z = pk2(hv[1][0], hv[1][1]); w.w = pk2(hv[1][2], hv[1][3]);
                *(u32x4*)(H + (size_t)r * DFF + c0) = w;
            }
    }
};
}

namespace att {
constexpr int TILEB = 16384, NSLOT = 3, VRING = NSLOT * TILEB, WSF_OFF = 2 * NSLOT * TILEB, LDS_NEED = WSF_OFF + NWAVES * 256;
static_assert(LDS_NEED <= 131072 && 4 * 32 * 128 * 4 <= WSF_OFF, "attention LDS");
constexpr float THR = 8.f;
__device__ __forceinline__ int crow(int r, int hi) { return (r & 3) + 8 * (r >> 2) + 4 * hi; }
__device__ __forceinline__ bf16x8 vfrag(const LAS char* p0, const LAS char* p1) {
    const v4i16_t lo = __builtin_amdgcn_ds_read_tr16_b64_v4i16((LAS v4i16_t*)p0), hi = __builtin_amdgcn_ds_read_tr16_b64_v4i16((LAS v4i16_t*)p1);
    return (bf16x8){lo[0], lo[1], lo[2], lo[3], hi[0], hi[1], hi[2], hi[3]};
}
__device__ __forceinline__ void glds16(const void* gsrc, unsigned lds_dst) { unsigned keep;
    asm volatile("s_mov_b32 %0, m0\n\ts_mov_b32 m0, %2\n\ts_nop 0\n\tglobal_load_lds_dwordx4 %1, off\n\ts_mov_b32 m0, %0" : "=&s"(keep) : "v"(gsrc), "s"(lds_dst) : "memory"); }
__device__ __forceinline__ void glds16s(const void* sbase, unsigned voff, unsigned lds_dst) { unsigned keep;
    asm volatile("s_mov_b32 %0, m0\n\ts_mov_b32 m0, %3\n\ts_nop 0\n\tglobal_load_lds_dwordx4 %1, %2\n\ts_mov_b32 m0, %0" : "=&s"(keep) : "v"(voff), "s"(sbase), "s"(lds_dst) : "memory"); }
__device__ __forceinline__ float swapmax(float m) { auto rr = __builtin_amdgcn_permlane32_swap(__float_as_uint(m), __float_as_uint(m), false, false); return fmaxf(__uint_as_float(rr[0]), __uint_as_float(rr[1])); }
#define ATT_WAIT_BAR(N) asm volatile("s_waitcnt vmcnt(" #N ") lgkmcnt(0)\n\ts_barrier" ::: "memory")
#define ATT_SB() __builtin_amdgcn_sched_barrier(0)
struct AttnCtx {
    LAS char* lds; LAS float* wsf; const char* kg; const char* vg; unsigned soff[2]; unsigned lds0; int ka[4]; int va[2][4]; int r32, hi, NT;
};
__device__ __forceinline__ float max3f(float a, float b, float c) { return fmaxf(fmaxf(a, b), c); }
template <bool LAST, int S0, bool DOMAX>
__device__ __forceinline__ void attn_step(const AttnCtx& C, int t, f32x16& P0, f32x16& P1, f32x16& N0, f32x16& N1, f32x16 (&o)[4], f32x16& negm, const bf16x8 (&qr)[4], float& mhat, float& l, float& rm) {
    constexpr int s0 = S0, s1 = (S0 + 1) % 3, s2 = (S0 + 2) % 3;
    const bool ik = (t + 3 < C.NT), iv = (t + 2 < C.NT);
    const LAS char* kb = C.lds + s1 * TILEB; const LAS char* vb = C.lds + s0 * TILEB;
    bf16x8 kf[8], vf[16];
#define ATT_KF(i) (*(const LAS bf16x8*)(kb + C.ka[(i) >> 1] + ((i) & 1) * 8192))
#define ATT_VF(n) vfrag(vb + C.va[0][(n) & 3] + ((n) >> 2) * 4096, vb + C.va[1][(n) & 3] + ((n) >> 2) * 4096)
    if (!LAST) { kf[0] = ATT_KF(0); kf[1] = ATT_KF(1); }
#ifdef PROBE_DMA2
    if (ik) { const char* p_ = C.kg + (size_t)(t + 3) * 65536; const unsigned d_ = (unsigned)__builtin_amdgcn_readfirstlane(C.lds0 + s0 * TILEB); glds16(p_ + C.soff[0], d_); glds16(p_ + C.soff[1], d_ + 1024); glds16(p_ + C.soff[0], d_); glds16(p_ + C.soff[1], d_ + 1024); }
    if (iv) { const char* p_ = C.vg + (size_t)(t + 2) * 65536; const unsigned d_ = (unsigned)__builtin_amdgcn_readfirstlane(C.lds0 + VRING + s2 * TILEB); glds16(p_ + C.soff[0], d_); glds16(p_ + C.soff[1], d_ + 1024); glds16(p_ + C.soff[0], d_); glds16(p_ + C.soff[1], d_ + 1024); }
#else
    if (ik) { const char* p_ = C.kg + (size_t)(t + 3) * 65536; const unsigned d_ = (unsigned)__builtin_amdgcn_readfirstlane(C.lds0 + s0 * TILEB); glds16s(p_, C.soff[0], d_); glds16s(p_, C.soff[1], d_ + 1024); }
    if (iv) { const char* p_ = C.vg + (size_t)(t + 2) * 65536; const unsigned d_ = (unsigned)__builtin_amdgcn_readfirstlane(C.lds0 + VRING + s2 * TILEB); glds16s(p_, C.soff[0], d_); glds16s(p_, C.soff[1], d_ + 1024); }
#endif
    ATT_SB();
    if (__any(rm > THR)) {
        const float dl = fmaxf(rm, 0.f);
        mhat += dl;
#pragma unroll
        for (int r = 0; r < 16; ++r) { P0[r] -= dl; P1[r] -= dl; negm[r] = -mhat; }
        const float f = __builtin_amdgcn_exp2f(-dl); l *= f;
        C.wsf[C.r32] = f;
#pragma unroll
        for (int r = 0; r < 16; ++r) { const float fr_ = C.wsf[crow(r, C.hi)];
#pragma unroll
            for (int db = 0; db < 4; ++db) o[db][r] *= fr_; }
    }
    ATT_SB();
    float ls = 0.f; v4u pwu[4]; float rn = -INFINITY;
#define ATT_SOFT(g) do { _Pragma("unroll") for (int e_ = (8 * (g)) / 5; e_ < ((8 * ((g) + 1)) / 5 < 32 ? (8 * ((g) + 1)) / 5 : 32); ++e_) { \
        float x_; if (e_ < 16) { x_ = __builtin_amdgcn_exp2f(P0[e_ & 15]); P0[e_ & 15] = x_; } else { x_ = __builtin_amdgcn_exp2f(P1[e_ & 15]); P1[e_ & 15] = x_; } \
        ls += x_; \
        if (e_ & 1) { unsigned w_ = pk2(e_ < 16 ? P0[(e_ - 1) & 15] : P1[(e_ - 1) & 15], x_); asm volatile("" : "+v"(w_)); pwu[e_ >> 3][(e_ >> 1) & 3] = w_; } } \
        asm volatile("" : "+v"(ls)); \
        if (DOMAX && (g) >= 8) { rn = max3f(rn, N0[(g) - 8], N1[(g) - 8]); asm volatile("" : "+v"(rn)); } } while (0)
#pragma unroll
    for (int i = 0; i < 8; ++i) {
        if (!LAST) {
            if (i == 0)      N0 = __builtin_amdgcn_mfma_f32_32x32x16_bf16(kf[i], qr[i >> 1], negm, 0, 0, 0);
            else if (i == 1) N1 = __builtin_amdgcn_mfma_f32_32x32x16_bf16(kf[i], qr[i >> 1], negm, 0, 0, 0);
            else if (i & 1)  N1 = __builtin_amdgcn_mfma_f32_32x32x16_bf16(kf[i], qr[i >> 1], N1, 0, 0, 0);
            else             N0 = __builtin_amdgcn_mfma_f32_32x32x16_bf16(kf[i], qr[i >> 1], N0, 0, 0, 0);
            if (i < 6) kf[i + 2] = ATT_KF(i + 2);
        }
        if (i >= 6) vf[i - 6] = ATT_VF(i - 6);
        ATT_SOFT(i);
        ATT_SB();
    }
#pragma unroll
    for (int j = 0; j < 8; ++j) {
        o[j & 3] = __builtin_amdgcn_mfma_f32_32x32x16_bf16(__builtin_bit_cast(bf16x8, pwu[j >> 2]), vf[j], o[j & 3], 0, 0, 0);
        vf[j + 2] = ATT_VF(j + 2);
        ATT_SOFT(8 + j);
        ATT_SB();
    }
#pragma unroll
    for (int j = 0; j < 8; ++j) {
        o[j & 3] = __builtin_amdgcn_mfma_f32_32x32x16_bf16(__builtin_bit_cast(bf16x8, pwu[2 + (j >> 2)]), vf[8 + j], o[j & 3], 0, 0, 0);
        if (j < 6) vf[8 + j + 2] = ATT_VF(8 + j + 2);
        ATT_SOFT(16 + j);
        ATT_SB();
    }
#undef ATT_SOFT
#undef ATT_KF
#undef ATT_VF
    l += ls;
    if (DOMAX) rm = swapmax(rn); else rm = 0.f;
#ifdef PROBE_DMA2
    if (ik) ATT_WAIT_BAR(8); else if (iv) ATT_WAIT_BAR(4); else ATT_WAIT_BAR(0);
#else
    if (ik) ATT_WAIT_BAR(4); else if (iv) ATT_WAIT_BAR(2); else ATT_WAIT_BAR(0);
#endif
}
__device__ __forceinline__ void attn_unit(LAS char* lds, const bf16* Q, const bf16* Kb, const bf16* Vb, bf16* MIX, int qrow0, int krow0, int NT, int h, float lam, const float* gsub) {
    const int tid = threadIdx.x, lane = tid & 63, r32 = lane & 31, hi = lane >> 5; const int wid = __builtin_amdgcn_readfirstlane(tid >> 6), qg = wid & 3, map = wid >> 2;
    AttnCtx C; C.lds = lds; C.r32 = r32; C.hi = hi; C.NT = NT;
    C.kg = (const char*)Kb + ((size_t)krow0 * 512 + h * 128) * 2;
    C.vg = (const char*)Vb + ((size_t)krow0 * 512 + h * 128) * 2;
    C.wsf = (LAS float*)(lds + WSF_OFF) + wid * 64;
    LAS float* wsf = C.wsf;
#pragma unroll
    for (int j = 0; j < 2; ++j) { const int row = 8 * wid + 4 * j + (lane >> 4); const int sw = (((lane >> 4) & 3) << 2) | ((2 * wid + j) & 3); C.soff[j] = (unsigned)(row * 1024 + (((lane & 15) ^ sw) * 16)); }
    C.lds0 = (unsigned)(uintptr_t)lds + (unsigned)wid * 2048u;
#define ATT_DMAK(t, slot) do { const char* p_ = C.kg + (size_t)(t) * 65536; const unsigned d_ = (unsigned)__builtin_amdgcn_readfirstlane(C.lds0 + (slot) * TILEB); glds16(p_ + C.soff[0], d_); glds16(p_ + C.soff[1], d_ + 1024); } while (0)
#define ATT_DMAV(t, slot) do { const char* p_ = C.vg + (size_t)(t) * 65536; const unsigned d_ = (unsigned)__builtin_amdgcn_readfirstlane(C.lds0 + VRING + (slot) * TILEB); glds16(p_ + C.soff[0], d_); glds16(p_ + C.soff[1], d_ + 1024); } while (0)
    asm volatile("s_waitcnt vmcnt(0)" ::: "memory");
    ATT_DMAK(0, 0); ATT_DMAV(0, 0); ATT_DMAK(1, 1); ATT_DMAV(1, 1);
    if (NT > 2) ATT_DMAK(2, 2);
#undef ATT_DMAK
#undef ATT_DMAV
    bf16x8 qr[4];
    { const bf16* qp = Q + (size_t)(qrow0 + 32 * qg + r32) * 512 + h * 128 + map * 64 + hi * 8;
#pragma unroll
      for (int ds = 0; ds < 4; ++ds) qr[ds] = *(const bf16x8*)(qp + ds * 16); }
    { const int swk = ((r32 & 3) << 2) | ((r32 >> 2) & 3);
#pragma unroll
      for (int ds = 0; ds < 4; ++ds) C.ka[ds] = 256 * r32 + 16 * ((8 * map + 2 * ds + hi) ^ swk);
      const int q = (lane & 15) >> 2, p = lane & 3, blk = (lane >> 4) & 1;
#pragma unroll
      for (int hh = 0; hh < 2; ++hh)
#pragma unroll
          for (int db = 0; db < 4; ++db) { const int row = 4 * hi + q + 8 * hh; const int sw = (q << 2) | ((hi + 2 * hh) & 3); C.va[hh][db] = VRING + 256 * row + 16 * ((4 * db + 2 * blk + (p >> 1)) ^ sw) + 8 * (p & 1); } }
    f32x16 o[4];
#pragma unroll
    for (int i = 0; i < 4; ++i) o[i] = (f32x16){};
    float mhat = 0.f, l = 0.f, rm; f32x16 negm;
    ATT_WAIT_BAR(0);
    f32x16 pA0 = (f32x16){}, pA1 = (f32x16){}, pB0, pB1;
    {
#pragma unroll
        for (int ds = 0; ds < 4; ++ds) {
            const bf16x8 a0 = *(const LAS bf16x8*)(lds + C.ka[ds]), a1 = *(const LAS bf16x8*)(lds + C.ka[ds] + 8192);
            pA0 = __builtin_amdgcn_mfma_f32_32x32x16_bf16(a0, qr[ds], pA0, 0, 0, 0);
            pA1 = __builtin_amdgcn_mfma_f32_32x32x16_bf16(a1, qr[ds], pA1, 0, 0, 0);
        }
        float m0 = fmaxf(pA0[0], pA1[0]);
#pragma unroll
        for (int r = 1; r < 16; ++r) m0 = fmaxf(m0, fmaxf(pA0[r], pA1[r]));
        mhat = swapmax(m0); rm = 0.f;
#pragma unroll
        for (int r = 0; r < 16; ++r) { pA0[r] -= mhat; pA1[r] -= mhat; negm[r] = -mhat; }
    }
    asm volatile("s_waitcnt lgkmcnt(0)\n\ts_barrier" ::: "memory");
    static_assert((KV_PER_B / 64) % 6 == 2 && SEQ_P / 64 == 4, "attention step remainder");
#define ATT_STEP_AB(LASTF, SLOT, tt) attn_step<LASTF, SLOT, false>(C, (tt), pA0, pA1, pB0, pB1, o, negm, qr, mhat, l, rm)
#define ATT_STEP_BA(LASTF, SLOT, tt) attn_step<LASTF, SLOT, !(LASTF)>(C, (tt), pB0, pB1, pA0, pA1, o, negm, qr, mhat, l, rm)
    int t = 0;
    for (; t + 6 < NT; t += 6) {
        ATT_STEP_AB(false, 0, t); ATT_STEP_BA(false, 1, t + 1); ATT_STEP_AB(false, 2, t + 2);
        ATT_STEP_BA(false, 0, t + 3); ATT_STEP_AB(false, 1, t + 4); ATT_STEP_BA(false, 2, t + 5);
    }
    ATT_STEP_AB(false, 0, t);
    if (NT - t == 2) { ATT_STEP_BA(true, 1, t + 1); }
    else { ATT_STEP_BA(false, 1, t + 1); ATT_STEP_AB(false, 2, t + 2); ATT_STEP_BA(true, 0, t + 3); }
#undef ATT_STEP_AB
#undef ATT_STEP_BA
    l += __shfl_xor(l, 32);
    wsf[32 + r32] = l;
    float rl[16];
#pragma unroll
    for (int r = 0; r < 16; ++r) rl[r] = 1.0f / wsf[32 + crow(r, hi)];
    LAS float* X = (LAS float*)lds + qg * 4096;
    if (map == 1) {
#pragma unroll
        for (int r = 0; r < 16; ++r)
#pragma unroll
            for (int db = 0; db < 4; ++db) X[crow(r, hi) * 128 + db * 32 + r32] = o[db][r] * rl[r];
    }
    __syncthreads();
    if (map == 0) {
        float gs[4];
#pragma unroll
        for (int db = 0; db < 4; ++db) gs[db] = gsub[db * 32 + r32] * 0.8f;
#pragma unroll
        for (int r = 0; r < 16; ++r) {
            float ss = 0.f;
#pragma unroll
            for (int db = 0; db < 4; ++db) { const float v = o[db][r] * rl[r] - lam * X[crow(r, hi) * 128 + db * 32 + r32]; o[db][r] = v; ss += v * v; }
#pragma unroll
            for (int of = 1; of < 32; of <<= 1) ss += __shfl_xor(ss, of);
            const float rs = __builtin_amdgcn_rsqf(ss * (1.0f / 128.0f) + EPS);
            bf16* op = MIX + (size_t)(qrow0 + 32 * qg + crow(r, hi)) * D + h * 128 + r32;
#pragma unroll
            for (int db = 0; db < 4; ++db) op[db * 32] = (bf16)(pk2(o[db][r] * rs * gs[db], 0.f) & 0xffffu);
        }
    }
    __syncthreads();
}
}

struct Args { const float* in[23]; float* out; unsigned char* ws; int ph_lo, ph_hi; };
enum { I_XP = 0, I_XS, I_CK, I_CV, I_C, I_CCTX, I_WADA, I_BADA, I_GAPRE, I_GAPOST, I_GFPRE, I_GFPOST, I_WIN, I_CONVW, I_CONVB, I_LQ1, I_LK1, I_LQ2, I_LK2, I_GSUB, I_WOUT, I_WFI, I_WFO };
constexpr int N_PHASES = 9;

#define mod ((float*)(args.ws + WS_MOD))
#define rot ((float*)(args.ws + WS_ROT))
#define SS1 ((float*)(args.ws + WS_SS1))
#define SS2 ((float*)(args.ws + WS_SS2))
#define WinT ((bf16*)(args.ws + WS_WIN))
#define WoT ((bf16*)(args.ws + WS_WO))
#define WfiT ((bf16*)(args.ws + WS_WFI))
#define WfoT ((bf16*)(args.ws + WS_WFO))
#define U ((bf16*)(args.ws + WS_U))
#define MIXO ((bf16*)(args.ws + WS_MIXO))
#define Qb ((bf16*)(args.ws + WS_Q))
#define Kb ((bf16*)(args.ws + WS_K))
#define Vb ((bf16*)(args.ws + WS_V))
#define MIX ((bf16*)(args.ws + WS_MIX))
#define BG ((bf16*)(args.ws + WS_BG))
#define Z ((bf16*)(args.ws + WS_Z))
#define H ((bf16*)(args.ws + WS_H))
#define xp (args.in[I_XP])
#define xs (args.in[I_XS])
#define Y (args.out)
#define stK (args.out + (size_t)M * D)
#define stV (args.out + (size_t)M * D + (size_t)MP * 512)

namespace pg8 {
struct PanelOrder {
    int G, c, lo, hi;
    __device__ __forceinline__ bool next(int i, Unit& u) const { const int L = lo + i * G + c; if (L >= hi) return false; const int xcd = L & 7, w = L >> 3; u.pm = 18 * xcd + (w >> 2); u.pn = w & 3; return true; }
    __device__ __forceinline__ void a_ready(const Unit&) const {}
    __device__ __forceinline__ void done(const Unit&) const {}
};
}
__device__ __forceinline__ int rowmap(int e, bool late) { const int p = e >> 8; const int pm = late ? 18 * (p >> 1) + 16 + (p & 1) : 18 * (p >> 4) + (p & 15); return pm * 256 + (e & 255); }
__device__ __forceinline__ void tail_arrive(unsigned* cnt) {
    asm volatile("s_waitcnt vmcnt(0)" ::: "memory");
    __syncthreads();
    if (threadIdx.x == 0) {
        __builtin_amdgcn_fence(__ATOMIC_RELEASE, "agent");
        asm volatile("s_waitcnt vmcnt(0)" ::: "memory");
        (void)xb_add(cnt, 1u);
    }
}
__device__ __forceinline__ void tail_wait(unsigned* cnt, unsigned expect) {
    if (threadIdx.x == 0) {
        unsigned sp = 0u;
        while (xb_ld(cnt) < expect) { __builtin_amdgcn_s_sleep(1); if (++sp > (1u << 20)) break; }
        __builtin_amdgcn_fence(__ATOMIC_ACQUIRE, "agent");
        asm volatile("s_waitcnt vmcnt(0)" ::: "memory");
    }
    __syncthreads();
}
__device__ __forceinline__ void free_share(int f, int& e0, int& en) { if (f < 128) { e0 = f * 171; en = 171; } else { e0 = 128 * 171 + (f - 128) * 170; en = 170; } }
__device__ __forceinline__ void early_share(int bx, int na, int nb, int& e0, int& en) { if (bx < 64) { e0 = bx * nb; en = nb; } else { e0 = 64 * nb + (bx - 64) * na; en = na; } }
__device__ __forceinline__ void p5_rows(const Args& args, int e0, int en, bool late, int wave, int lane) {
        const float* gpo = args.in[I_GAPOST]; const float* gfp = args.in[I_GFPRE];
        for (int i0 = wave; i0 < en; i0 += 8 * 2) {
            f32x4 v[2][4]; v2u mo[2][4]; float ssp[2];
#pragma unroll
            for (int q = 0; q < 2; ++q) { const int idx = i0 + 8 * q; const int r = rowmap(e0 + idx, late); ssp[q] = 0.f;
                if (idx < en) { const float* xr = r < MP ? xp + (size_t)r * D : xs + (size_t)(r - MP) * D;
                    ssp[q] = SS1[(size_t)r * 16 + (lane & 15)];
#pragma unroll
                    for (int j = 0; j < 4; ++j) { v[q][j] = __builtin_nontemporal_load((const f32x4*)(xr + 4 * lane + 256 * j)); mo[q][j] = *(const v2u*)(MIXO + (size_t)r * D + 4 * lane + 256 * j); } } }
#pragma unroll
            for (int q = 0; q < 2; ++q) { const int idx = i0 + 8 * q; const int r = rowmap(e0 + idx, late);
                if (idx < en) {
                    const float* mp = mod + (r < MP ? 0 : 1 + ((r - MP) >> 12)) * 6144;
                    float sp = ssp[q]; sp += __shfl_xor(sp, 1); sp += __shfl_xor(sp, 2); sp += __shfl_xor(sp, 4); sp += __shfl_xor(sp, 8);
                    const float rstd1 = __builtin_amdgcn_rsqf(sp * (1.f / D) + EPS); float s = 0.f;
#pragma unroll
                    for (int j = 0; j < 4; ++j) { const int c = 4 * lane + 256 * j;
                        const f32x4 mf = (f32x4){__uint_as_float(mo[q][j][0] << 16), __uint_as_float(mo[q][j][0] & 0xffff0000u), __uint_as_float(mo[q][j][1] << 16), __uint_as_float(mo[q][j][1] & 0xffff0000u)};
                        const f32x4 gg = *(const f32x4*)(gpo + c), ga = *(const f32x4*)(mp + 2048 + c);
                        v[q][j] = v[q][j] + ga * (mf * rstd1 * gg);
                        s += (v[q][j][0] * v[q][j][0] + v[q][j][1] * v[q][j][1]) + (v[q][j][2] * v[q][j][2] + v[q][j][3] * v[q][j][3]); }
                    const float rstd = __builtin_amdgcn_rsqf(wave_sum(s) * (1.f / D) + EPS);
#pragma unroll
                    for (int j = 0; j < 4; ++j) { const int c = 4 * lane + 256 * j; const f32x4 gg = *(const f32x4*)(gfp + c), sh = *(const f32x4*)(mp + 3072 + c), sc = *(const f32x4*)(mp + 4096 + c);
                        const f32x4 u = v[q][j] * rstd * gg * (sc + 1.f) + sh;
                        *(v2u*)(U + (size_t)r * D + c) = (v2u){pk2(u[0], u[1]), pk2(u[2], u[3])}; } } }
        }
}
__device__ __forceinline__ void p8_rows(const Args& args, int e0, int en, bool late, int wave, int lane) {
        const float* gpo = args.in[I_GAPOST]; const float* gfo = args.in[I_GFPOST];
        for (int i0 = wave; i0 < en; i0 += 8 * 2) {
            f32x4 v[2][4]; v2u mo[2][4], fo[2][4]; float ssp1[2], ssp2[2];
#pragma unroll
            for (int q = 0; q < 2; ++q) { const int idx = i0 + 8 * q; const int r = rowmap(e0 + idx, late); ssp1[q] = 0.f; ssp2[q] = 0.f;
                if (idx < en) { const float* xr = r < MP ? xp + (size_t)r * D : xs + (size_t)(r - MP) * D;
                    ssp1[q] = SS1[(size_t)r * 16 + (lane & 15)]; ssp2[q] = SS2[(size_t)r * 16 + (lane & 15)];
#pragma unroll
                    for (int j = 0; j < 4; ++j) { v[q][j] = __builtin_nontemporal_load((const f32x4*)(xr + 4 * lane + 256 * j)); mo[q][j] = *(const v2u*)(MIXO + (size_t)r * D + 4 * lane + 256 * j); fo[q][j] = *(const v2u*)(U + (size_t)r * D + 4 * lane + 256 * j); } } }
#pragma unroll
            for (int q = 0; q < 2; ++q) { const int idx = i0 + 8 * q; const int r = rowmap(e0 + idx, late);
                if (idx < en) {
                    const float* mp = mod + (r < MP ? 0 : 1 + ((r - MP) >> 12)) * 6144;
                    float sp = ssp1[q]; sp += __shfl_xor(sp, 1); sp += __shfl_xor(sp, 2); sp += __shfl_xor(sp, 4); sp += __shfl_xor(sp, 8);
                    const float rstd1 = __builtin_amdgcn_rsqf(sp * (1.f / D) + EPS);
                    float sq = ssp2[q]; sq += __shfl_xor(sq, 1); sq += __shfl_xor(sq, 2); sq += __shfl_xor(sq, 4); sq += __shfl_xor(sq, 8);
                    const float rstd2 = __builtin_amdgcn_rsqf(sq * (1.f / D) + EPS);
#pragma unroll
                    for (int j = 0; j < 4; ++j) { const int c = 4 * lane + 256 * j;
                        const f32x4 mf = (f32x4){__uint_as_float(mo[q][j][0] << 16), __uint_as_float(mo[q][j][0] & 0xffff0000u), __uint_as_float(mo[q][j][1] << 16), __uint_as_float(mo[q][j][1] & 0xffff0000u)};
                        const f32x4 ff = (f32x4){__uint_as_float(fo[q][j][0] << 16), __uint_as_float(fo[q][j][0] & 0xffff0000u), __uint_as_float(fo[q][j][1] << 16), __uint_as_float(fo[q][j][1] & 0xffff0000u)};
                        const f32x4 gg = *(const f32x4*)(gpo + c), ga = *(const f32x4*)(mp + 2048 + c);
                        const f32x4 x1 = v[q][j] + ga * (mf * rstd1 * gg);
                        const f32x4 g2 = *(const f32x4*)(gfo + c), gf = *(const f32x4*)(mp + 5120 + c);
                        __builtin_nontemporal_store(x1 + gf * (ff * rstd2 * g2), (f32x4*)(Y + (size_t)r * D + c)); } } }
        }
}
struct P0Item { const float* W; bf16* WT; int K, N, dst_row0, src_col0, k0; bool rperm; float scale; };
__device__ __forceinline__ P0Item p0_item(const Args& args, int it) {
    constexpr int I_1 = 16 * 96, I_2 = 16 * 32, I_3 = 16 * 176;
    P0Item q; int r = it; q.rperm = false; q.scale = 1.0f;
    if (r < I_1) { const int kb = r / 96, nb = r % 96, n0 = 32 * nb; int src = n0;
        if (n0 >= 2048) { const int j = (n0 - 2048) >> 8, c = (n0 - 2048) & 255; src = c < 128 ? 2048 + 128 * j + c : 2560 + 128 * j + (c - 128); }
        q.W = args.in[I_WIN]; q.WT = WinT; q.K = D; q.N = NIN; q.dst_row0 = n0; q.src_col0 = src; q.k0 = 64 * kb; q.rperm = n0 < 1024; return q; }
    r -= I_1;
    if (r < I_2) { const int kb = r / 32, nb = r % 32; q.W = args.in[I_WOUT]; q.WT = WoT; q.K = D; q.N = D; q.dst_row0 = 32 * nb; q.src_col0 = 32 * nb; q.k0 = 64 * kb; return q; }
    r -= I_2;
    if (r < I_3) { const int kb = r / 176, nb = r % 176, n0 = 32 * nb; const int j = n0 >> 8, c = n0 & 255; const int src = c < 128 ? 128 * j + c : DFF + 128 * j + (c - 128);
        q.W = args.in[I_WFI]; q.WT = WfiT; q.K = D; q.N = NFI; q.dst_row0 = n0; q.src_col0 = src; q.k0 = 64 * kb;
        q.scale = c < 128 ? -1.4426950408889634f : -0.6931471805599453f; return q; }
    r -= I_3;
    { const int kb = r / 32, nb = r % 32; q.W = args.in[I_WFO]; q.WT = WfoT; q.K = DFF; q.N = D; q.dst_row0 = 32 * nb; q.src_col0 = 32 * nb; q.k0 = 64 * kb; return q; }
}
__device__ __forceinline__ void p0_item_load(const P0Item& q, float (&tv)[32], int lane) {
#pragma unroll
    for (int i = 0; i < 32; ++i) { const int kk = 2 * i + (lane >> 5); tv[i] = __builtin_nontemporal_load(q.W + (size_t)(q.k0 + kk) * q.N + q.src_col0 + (lane & 31)); }
}
__device__ __forceinline__ void p0_item_finish(const P0Item& q, const float (&tv)[32], LAS float* scr, int lane) {
#pragma unroll
    for (int i = 0; i < 32; ++i) { const int kk = 2 * i + (lane >> 5); scr[kk * 33 + (lane & 31)] = tv[i] * q.scale; }
    asm volatile("s_waitcnt lgkmcnt(0)" ::: "memory");
    const int c = lane & 7;
#pragma unroll
    for (int j = 0; j < 4; ++j) { const int n = (lane >> 3) + 8 * j; const int ns = q.rperm ? (16 * ((n >> 2) & 1) + 4 * (n >> 3) + (n & 3)) : n; const LAS float* s = scr + (8 * c) * 33 + ns;
        v4u o; o.x = pk2(s[0 * 33], s[1 * 33]); o.y = pk2(s[2 * 33], s[3 * 33]); o.z = pk2(s[4 * 33], s[5 * 33]); o.w = pk2(s[6 * 33], s[7 * 33]);
        *(v4u*)(q.WT + (size_t)(q.dst_row0 + n) * q.K + q.k0 + 8 * c) = o; }
    asm volatile("s_waitcnt lgkmcnt(0)" ::: "memory");
}

__device__ __forceinline__ void p0_transposes(const Args& args, int it0, int it1, int widx, int nw, LAS float* scr, int lane) {
    int it = it0 + widx;
    if (it < it1) {
        P0Item cur = p0_item(args, it); float ta[32], tb[32];
        p0_item_load(cur, ta, lane);
        for (;;) {
            const int nx = it + nw; const bool more = nx < it1; P0Item nxt = cur;
            if (more) { nxt = p0_item(args, nx); p0_item_load(nxt, tb, lane); }
            p0_item_finish(cur, ta, scr, lane);
            if (!more) break;
#pragma unroll
            for (int i = 0; i < 32; ++i) ta[i] = tb[i];
            cur = nxt; it = nx;
        }
    }
}
constexpr int IT_WIN = 16 * 96, IT_WO = IT_WIN + 16 * 32, IT_WFI = IT_WO + 16 * 176, IT_WFO = IT_WFI + 44 * 32;

__global__ void __launch_bounds__(NTHREADS, 2) fwd_megakernel(Args args) {
    extern __shared__ __attribute__((aligned(16))) unsigned char lds_raw[];
    LAS unsigned char* lds = (LAS unsigned char*)lds_raw;
    cg::grid_group grid = cg::this_grid();
    const int tid = threadIdx.x, lane = tid & 63; const int wave = __builtin_amdgcn_readfirstlane(tid >> 6);
    const int G = gridDim.x, bx = blockIdx.x;
    const int vcu = (G % 8 == 0) ? (bx % 8) * (G / 8) + bx / 8 : bx;
    const int gw = vcu * NWAVES + wave, NGW = G * NWAVES;
    unsigned char* ws = args.ws;
    const int lo = args.ph_lo, hi_ph = args.ph_hi;
#define IN(k) (lo <= (k) && (k) < hi_ph)
    if (tid < 16) ((LAS unsigned*)(lds + MISC_OFF))[tid] = 0u;
    __syncthreads();
    XcdBarrier bar = xcd_barrier_post((unsigned*)(ws + WS_BAR), (volatile LAS unsigned*)(lds + MISC_OFF));
    if (lo < 0) grid.sync();
#ifdef PROBE_BAR2
#define SEAM(k) do { if (IN(k) && IN((k) + 1)) { xcd_barrier(bar); xcd_barrier(bar); } } while (0)
#else
#define SEAM(k) do { if (IN(k) && IN((k) + 1)) xcd_barrier(bar); } while (0)
#endif

    if (IN(0)) {
#ifdef PROBE_P0
      for (int rep_ = 0; rep_ < 3; ++rep_) {
#endif
        if (bx < 192) {
            LAS float* S = (LAS float*)lds; LAS float* red = (LAS float*)(lds + 9 * 1024 * 4);
            { float cv[18];
#pragma unroll
              for (int u = 0; u < 18; ++u) { const int e = tid + u * NTHREADS, i = e >> 10, k = e & 1023; cv[u] = (i == 0) ? args.in[I_CCTX][k] : args.in[I_C][(i - 1) * 1024 + k]; }
#pragma unroll
              for (int u = 0; u < 18; ++u) S[tid + u * NTHREADS] = cv[u] / (1.f + __expf(-cv[u])); }
            __syncthreads();
            const int kgp = tid >> 5, cl = tid & 31, j0 = 32 * bx;
            float a[9];
#pragma unroll
            for (int i = 0; i < 9; ++i) a[i] = 0.f;
            const float* wp = args.in[I_WADA] + (size_t)(kgp * 64) * 6144 + j0 + cl;
            float wv[64];
#pragma unroll
            for (int k = 0; k < 64; ++k) wv[k] = __builtin_nontemporal_load(wp + (size_t)k * 6144);
#pragma unroll
            for (int k = 0; k < 64; ++k) {
#pragma unroll
                for (int i = 0; i < 9; ++i) a[i] += S[i * 1024 + kgp * 64 + k] * wv[k]; }
#pragma unroll
            for (int i = 0; i < 9; ++i) red[(kgp * 9 + i) * 32 + cl] = a[i];
            __syncthreads();
            if (tid < 288) { const int i = tid >> 5; float s = args.in[I_BADA][j0 + cl];
#pragma unroll
                for (int g = 0; g < 16; ++g) s += red[(g * 9 + i) * 32 + cl];
                mod[i * 6144 + j0 + cl] = s; }
            tail_arrive((unsigned*)(args.ws + WS_BAR) + 3712);
        }
        p0_transposes(args, 0, IT_WIN, gw, NGW, (LAS float*)(lds + wave * 16384), lane);
        {
            f32x4 cv0[2], cv1[2];
#pragma unroll
            for (int u = 0; u < 2; ++u) { const int ir = gw + u * NGW;
                if (ir < 2 * NB_S * PAST) { const int which = ir / (NB_S * PAST), rr = ir % (NB_S * PAST);
                    const float* src_ = args.in[which ? I_CV : I_CK] + (size_t)rr * 512 + lane * 8; cv0[u] = *(const f32x4*)src_; cv1[u] = *(const f32x4*)(src_ + 4); } }
#pragma unroll
            for (int u = 0; u < 2; ++u) { const int ir = gw + u * NGW;
                if (ir < 2 * NB_S * PAST) { const int which = ir / (NB_S * PAST), rr = ir % (NB_S * PAST), b = rr / PAST, j = rr % PAST;
                    bf16* drow = (which ? Vb : Kb) + (size_t)(MP + b * KV_PER_B + j) * 512;
                    if (which) *(v4u*)(drow + lane * 8) = (v4u){pk2(cv0[u][0], cv0[u][1]), pk2(cv0[u][2], cv0[u][3]), pk2(cv1[u][0], cv1[u][1]), pk2(cv1[u][2], cv1[u][3])};
                    else { const int l0 = lane * 8, g32 = l0 & ~31, la = l0 & 31, lb = la + 4;
                        *(v2u*)(drow + g32 + 8 * ((la >> 2) & 3) + 4 * (la >> 4)) = (v2u){pk2(cv0[u][0], cv0[u][1]), pk2(cv0[u][2], cv0[u][3])};
                        *(v2u*)(drow + g32 + 8 * ((lb >> 2) & 3) + 4 * (lb >> 4)) = (v2u){pk2(cv1[u][0], cv1[u][1]), pk2(cv1[u][2], cv1[u][3])}; } } }
            for (int ir = gw + 2 * NGW; ir < 2 * NB_S * PAST; ir += NGW) {
                const int which = ir / (NB_S * PAST), rr = ir % (NB_S * PAST), b = rr / PAST, j = rr % PAST;
                const float* src_ = args.in[which ? I_CV : I_CK] + (size_t)rr * 512 + lane * 8;
                const f32x4 v0 = *(const f32x4*)src_, v1 = *(const f32x4*)(src_ + 4);
                bf16* drow = (which ? Vb : Kb) + (size_t)(MP + b * KV_PER_B + j) * 512;
                if (which) *(v4u*)(drow + lane * 8) = (v4u){pk2(v0[0], v0[1]), pk2(v0[2], v0[3]), pk2(v1[0], v1[1]), pk2(v1[2], v1[3])};
                else { const int l0 = lane * 8, g32 = l0 & ~31, la = l0 & 31, lb = la + 4;
                    *(v2u*)(drow + g32 + 8 * ((la >> 2) & 3) + 4 * (la >> 4)) = (v2u){pk2(v0[0], v0[1]), pk2(v0[2], v0[3])};
                    *(v2u*)(drow + g32 + 8 * ((lb >> 2) & 3) + 4 * (lb >> 4)) = (v2u){pk2(v1[0], v1[1]), pk2(v1[2], v1[3])}; }
            }
        }
        if (bx == 255 || (G < 256 && bx == 0)) {
            for (int e = tid; e < 1024; e += NTHREADS) { const int pos = e >> 4, i = e & 15; const float inv = 1.0f / powf(10000.0f, (float)i / 16.0f); const float ang = (float)pos * inv; rot[e] = cosf(ang); rot[1024 + e] = sinf(ang); }
        }
#ifdef PROBE_P0
      __syncthreads(); }
#endif
    }
    if (IN(0) && IN(1)) tail_wait((unsigned*)(args.ws + WS_BAR) + 3712, 192u);

    if (IN(1)) {
        const float* g = args.in[I_GAPRE];
#ifdef PROBE_ROWS
        for (int rep_ = 0; rep_ < 2; ++rep_)
#endif
        for (int r0 = gw; r0 < M; r0 += 3 * NGW) {
            f32x4 v[3][4]; float s[3];
#pragma unroll
            for (int q = 0; q < 3; ++q) { const int r = r0 + q * NGW; s[q] = 0.f;
                if (r < M) { const float* xr = r < MP ? xp + (size_t)r * D : xs + (size_t)(r - MP) * D;
#pragma unroll
                    for (int j = 0; j < 4; ++j) v[q][j] = __builtin_nontemporal_load((const f32x4*)(xr + 4 * lane + 256 * j)); } }
#pragma unroll
            for (int q = 0; q < 3; ++q) { const int r = r0 + q * NGW;
                if (r < M) {
#pragma unroll
                    for (int j = 0; j < 4; ++j) s[q] += (v[q][j][0] * v[q][j][0] + v[q][j][1] * v[q][j][1]) + (v[q][j][2] * v[q][j][2] + v[q][j][3] * v[q][j][3]);
                    const float rstd = __builtin_amdgcn_rsqf(wave_sum(s[q]) * (1.f / D) + EPS);
                    const float* mp = mod + (r < MP ? 0 : 1 + ((r - MP) >> 12)) * 6144;
#pragma unroll
                    for (int j = 0; j < 4; ++j) { const int c = 4 * lane + 256 * j; const f32x4 gg = *(const f32x4*)(g + c), sh = *(const f32x4*)(mp + c), sc = *(const f32x4*)(mp + 1024 + c);
                        const f32x4 u = v[q][j] * rstd * gg * (sc + 1.f) + sh;
                        *(v2u*)(U + (size_t)r * D + c) = (v2u){pk2(u[0], u[1]), pk2(u[2], u[3])}; } } }
        }
    }
    SEAM(1);

    if (IN(2)) {
        pg8::Gemm g{U, WinT, M, NIN, D}; pg8::StaticOrder S; S.init(M, NIN, G, bx);
        pg8::EpiIn E{Qb, Kb, Vb, BG, Z, stK, stV, rot};
        pg8::gemm_phase<pg8::EpiIn, pg8::StaticOrder, PG8_ALIGN, PG8_SP2>(lds, g, S, E);
        if (G == 256 && bx >= 192) p0_transposes(args, IT_WIN, IT_WFI, (bx - 192) * NWAVES + wave, 64 * NWAVES, (LAS float*)(lds + wave * 16384), lane);
        else if (G != 256) p0_transposes(args, IT_WIN, IT_WFI, gw, NGW, (LAS float*)(lds + wave * 16384), lane);
#ifdef PROBE_GEMM2
        __syncthreads(); pg8::gemm_phase<pg8::EpiIn, pg8::StaticOrder, PG8_ALIGN, PG8_SP2>(lds, g, S, E);
#endif
    }
    SEAM(2);

    if (IN(3)) {
        {
            const float* cw = args.in[I_CONVW]; const float* cb = args.in[I_CONVB];
            const int c8 = (tid & 63) * 8;
            float w0[8], w1[8], w2[8], bb[8];
#pragma unroll
            for (int e = 0; e < 8; ++e) { w0[e] = cw[c8 + e]; w1[e] = cw[512 + c8 + e]; w2[e] = cw[1024 + c8 + e]; bb[e] = cb[c8 + e]; }
            const bool hasp = (G == 256) && (vcu < NB_P * 4 * 2); const int cn = (G == 256) ? (hasp ? 112 : 176) : (M + G - 1) / G; const int cbase = (G == 256) ? (hasp ? vcu * 112 : 128 * 112 + (vcu - 128) * 176) : vcu * cn;
#ifdef PROBE_CONV
            for (int rep_ = 0; rep_ < 3; ++rep_)
#endif
            for (int i0 = wave; i0 < cn; i0 += 24) {
                v4u zc[3], zp[3], zn[3], bg[3];
#pragma unroll
                for (int q = 0; q < 3; ++q) { const int idx = i0 + 8 * q; const int r = cbase + idx;
                    zp[q] = (v4u){0u, 0u, 0u, 0u}; zn[q] = (v4u){0u, 0u, 0u, 0u}; zc[q] = zp[q]; bg[q] = zp[q];
                    if (idx < cn && r < M) { const int t = r < MP ? (r & (SEQ_P - 1)) : ((r - MP) & (SEQ_S - 1)); const int L = r < MP ? SEQ_P : SEQ_S;
                        zc[q] = *(const v4u*)(Z + (size_t)r * 512 + c8); bg[q] = *(const v4u*)(BG + (size_t)r * 512 + c8);
                        if (t > 0) zp[q] = *(const v4u*)(Z + (size_t)(r - 1) * 512 + c8);
                        if (t < L - 1) zn[q] = *(const v4u*)(Z + (size_t)(r + 1) * 512 + c8); } }
#pragma unroll
                for (int q = 0; q < 3; ++q) { const int idx = i0 + 8 * q; const int r = cbase + idx;
                    if (idx < cn && r < M) { float o[8];
#pragma unroll
                        for (int e = 0; e < 4; ++e) {
                            const float zc0 = __uint_as_float(zc[q][e] << 16), zc1 = __uint_as_float(zc[q][e] & 0xffff0000u), zp0 = __uint_as_float(zp[q][e] << 16), zp1 = __uint_as_float(zp[q][e] & 0xffff0000u);
                            const float zn0 = __uint_as_float(zn[q][e] << 16), zn1 = __uint_as_float(zn[q][e] & 0xffff0000u), b0 = __uint_as_float(bg[q][e] << 16), b1 = __uint_as_float(bg[q][e] & 0xffff0000u);
                            o[2 * e] = b0 * (w0[2 * e] * zp0 + w1[2 * e] * zc0 + w2[2 * e] * zn0 + bb[2 * e]);
                            o[2 * e + 1] = b1 * (w0[2 * e + 1] * zp1 + w1[2 * e + 1] * zc1 + w2[2 * e + 1] * zn1 + bb[2 * e + 1]); }
                        *(v4u*)(MIX + (size_t)r * D + 512 + c8) = (v4u){pk2(o[0], o[1]), pk2(o[2], o[3]), pk2(o[4], o[5]), pk2(o[6], o[7])}; } }
            }
        }
        float lam;
        { const float a = args.in[I_LQ1][lane] * args.in[I_LK1][lane], b = args.in[I_LQ2][lane] * args.in[I_LK2][lane];
          lam = __expf(wave_sum(a)) - __expf(wave_sum(b)) + 0.2f; }
        __syncthreads();
        const float* gsub = args.in[I_GSUB];
        for (int i = vcu; i < NB_S * 4 * 32; i += G) {
            const int bh = (i >> 5) & 31, qb = i & 31; const int b = bh >> 2, h = bh & 3;
            att::attn_unit((LAS char*)lds, Qb, Kb, Vb, MIX, MP + b * SEQ_S + qb * 128, MP + b * KV_PER_B, KV_PER_B / 64, h, lam, gsub);
        }
#ifdef PROBE_ATT2
        for (int i = vcu; i < NB_S * 4 * 32; i += G) {
            const int bh = (i >> 5) & 31, qb = i & 31; const int b = bh >> 2, h = bh & 3;
            att::attn_unit((LAS char*)lds, Qb, Kb, Vb, MIX, MP + b * SEQ_S + qb * 128, MP + b * KV_PER_B, KV_PER_B / 64, h, lam, gsub);
        }
#endif
        for (int i = vcu; i < NB_P * 4 * 2; i += G) {
            const int b = i >> 3, h = (i >> 1) & 3, qb = i & 1;
            att::attn_unit((LAS char*)lds, Qb, Kb, Vb, MIX, b * SEQ_P + qb * 128, b * SEQ_P, SEQ_P / 64, h, lam, gsub);
        }
    }
    SEAM(3);

    if (IN(4)) {
        pg8::Gemm g{MIX, WoT, M, D, D}; pg8::PanelOrder S{G, bx, 0, 512}; pg8::EpiSS E{MIXO, SS1};
        pg8::gemm_phase<pg8::EpiSS, pg8::PanelOrder, PG8_ALIGN, PG8_SP2>(lds, g, S, E);
    }
    SEAM(4);
    if (IN(5)) {
        unsigned* cnt = (unsigned*)(args.ws + WS_BAR) + 3584;
        if (bx < 64) { pg8::Gemm g{MIX, WoT, M, D, D}; pg8::PanelOrder S{G, bx, 512, 576}; pg8::EpiSS E{MIXO, SS1};
            pg8::gemm_phase<pg8::EpiSS, pg8::PanelOrder, PG8_ALIGN, PG8_SP2>(lds, g, S, E);
            tail_arrive(cnt); }
        int e0, en; early_share(bx, 144, 80, e0, en);
        p5_rows(args, e0, en, false, wave, lane);
        tail_wait(cnt, 64u);
        p5_rows(args, bx * 16, 16, true, wave, lane);
    }
    SEAM(5);
    if (IN(6)) {
        pg8::Gemm g{U, WfiT, M, NFI, D}; pg8::StaticOrder S; S.init(M, NFI, G, bx);
        pg8::EpiGlu E{H};
        pg8::gemm_phase<pg8::EpiGlu, pg8::StaticOrder, PG8_ALIGN, PG8_SP2>(lds, g, S, E);
        if (G == 256 && bx >= 96) p0_transposes(args, IT_WFI, IT_WFO, (bx - 96) * NWAVES + wave, 160 * NWAVES, (LAS float*)(lds + wave * 16384), lane);
        else if (G != 256) p0_transposes(args, IT_WFI, IT_WFO, gw, NGW, (LAS float*)(lds + wave * 16384), lane);
    }
    SEAM(6);
    if (IN(7)) {
        pg8::Gemm g{H, WfoT, M, D, DFF}; pg8::PanelOrder S{G, bx, 0, 512}; pg8::EpiSS E{U, SS2};
        pg8::gemm_phase<pg8::EpiSS, pg8::PanelOrder, PG8_ALIGN, PG8_SP2>(lds, g, S, E);
    }
    SEAM(7);
    if (IN(8)) {
        unsigned* cnt = (unsigned*)(args.ws + WS_BAR) + 3648;
        if (bx < 64) { pg8::Gemm g{H, WfoT, M, D, DFF}; pg8::PanelOrder S{G, bx, 512, 576}; pg8::EpiSS E{U, SS2};
            pg8::gemm_phase<pg8::EpiSS, pg8::PanelOrder, PG8_ALIGN, PG8_SP2>(lds, g, S, E);
            tail_arrive(cnt); }
        if (bx >= 64) { int e0, en; free_share(bx - 64, e0, en); p8_rows(args, e0, en, false, wave, lane); }
        tail_wait(cnt, 64u);
        p8_rows(args, bx * 16, 16, true, wave, lane);
    }
#undef IN
#undef SEAM
#undef mod
#undef rot
#undef SS1
#undef SS2
#undef WinT
#undef WoT
#undef WfiT
#undef WfoT
#undef U
#undef MIXO
#undef Qb
#undef Kb
#undef Vb
#undef MIX
#undef BG
#undef Z
#undef H
#undef xp
#undef xs
#undef Y
#undef stK
#undef stV
}

extern "C" void kernel_launch(void* const* d_in, const int* in_sizes, int n_in, void* d_out, int out_size, void* d_ws, size_t ws_size, hipStream_t stream) {
    static int grid = 0;
    if (grid == 0) {
        if (n_in != 23 || ws_size < WS_END || out_size != M * D + 2 * MP * 512) { fprintf(stderr, "kernel_launch: unexpected problem (n_in %d, ws %zu, out %d)\n", n_in, ws_size, out_size); grid = -1; return; }
        int dev = 0, cus = 0, per_cu = 0;
        hipGetDevice(&dev); hipDeviceGetAttribute(&cus, hipDeviceAttributeMultiprocessorCount, dev);
        if (hipFuncSetAttribute((const void*)fwd_megakernel, hipFuncAttributeMaxDynamicSharedMemorySize, LDS_BYTES) != hipSuccess) { fprintf(stderr, "kernel_launch: hipFuncSetAttribute failed\n"); grid = -1; return; }
        if (hipOccupancyMaxActiveBlocksPerMultiprocessor(&per_cu, (const void*)fwd_megakernel, NTHREADS, LDS_BYTES) != hipSuccess || per_cu < 1) { fprintf(stderr, "kernel_launch: occupancy query failed (%d)\n", per_cu); (void)hipGetLastError(); per_cu = 1; }
        grid = cus * 1;
        if (grid > cus * per_cu) grid = cus * per_cu;
    }
    if (grid < 0) return;
    Args a{};
    for (int i = 0; i < 23; ++i) a.in[i] = (const float*)d_in[i];
    a.out = (float*)d_out; a.ws = (unsigned char*)d_ws;
    if (hipMemsetAsync((char*)d_ws + WS_BAR, 0, BAR_BYTES, stream) != hipSuccess) { fprintf(stderr, "kernel_launch: memset failed\n"); return; }
#if MK_COOP
    a.ph_lo = 0; a.ph_hi = N_PHASES;
    void* kargs[] = {&a};
    hipError_t e = hipLaunchCooperativeKernel((const void*)fwd_megakernel, dim3(grid), dim3(NTHREADS), kargs, LDS_BYTES, stream);
    if (e != hipSuccess) fprintf(stderr, "cooperative launch failed: %s (grid %d)\n", hipGetErrorString(e), grid);
#else
    for (int p = 0; p < N_PHASES; ++p) { a.ph_lo = p; a.ph_hi = p + 1; hipLaunchKernelGGL(fwd_megakernel, dim3(grid), dim3(NTHREADS), LDS_BYTES, stream, a); }
#endif
}
```

```cpp
#include <hip/hip_runtime.h>
#include <hip/hip_cooperative_groups.h>
#include <cstdio>
#include <cstdint>
namespace cg = cooperative_groups;
namespace pg8 {
#define PG8_LAS __attribute__((address_space(3)))
typedef unsigned short bf16_t;
typedef short bf16x8 __attribute__((ext_vector_type(8)));
typedef float f32x4 __attribute__((ext_vector_type(4)));
typedef unsigned u32x4 __attribute__((ext_vector_type(4)));
constexpr int BM = 256, BK = 64, HALF = 128, HTB = HALF * BK * 2  , STAGE_BYTES = 8 * HTB, NXCD = 8, WGM = 8;

__host__ __device__ __forceinline__ int lds_byte(int r, int c) { const int st = (r >> 4) * 2 + (c >> 5), rr = r & 15, cc = c & 31, ob = rr * 64 + cc * 2; return st * 1024 + (ob ^ (((ob >> 9) & 1) << 5)); }
__host__ __device__ __forceinline__ void stage_rc(int b, int& R, int& C) { const int st = b / 1024, sb = b % 1024, swz = sb ^ (((sb >> 9) & 1) << 5); R = (st >> 1) * 16 + swz / 64; C = (st & 1) * 32 + (swz % 64) / 2; }
__host__ __device__ __forceinline__ int perm32(int rho) { const int n = rho >> 4, i = rho & 15; return 8 * (i >> 2) + 4 * n + (i & 3); }

struct Unit { int pm, pn; };
struct Gemm { const bf16_t* A; const bf16_t* Bt; int M, N, K; };

struct StaticOrder {
    int nM, nN, nwg, G, c;
    __host__ __device__ void init(int M, int N, int G_, int c_) { nM = M / BM; nN = N / BM; nwg = nM * nN; G = G_; c = c_; }
    __host__ __device__ bool next(int i, Unit& u) const {
        const long L = (long)i * G + c; if (L >= nwg) return false;
        int wgid = (int)L; { const int q = nwg / NXCD, r = nwg % NXCD, xcd = wgid % NXCD, off = wgid / NXCD; wgid = (xcd < r ? xcd * (q + 1) : r * (q + 1) + (xcd - r) * q) + off; }
        const int nig = WGM * nN, gid = wgid / nig, fm = gid * WGM, gsz = (nM - fm) < WGM ? (nM - fm) : WGM;
        u.pm = fm + ((wgid % nig) % gsz); u.pn = (wgid % nig) / gsz; return true;
    }
    __device__ __forceinline__ void a_ready(const Unit&) const {}
    __device__ __forceinline__ void done(const Unit&) const {}
};

__device__ __forceinline__ unsigned cvt_pk_bf16(float lo, float hi) { unsigned r; asm volatile("v_cvt_pk_bf16_f32 %0, %1, %2" : "=v"(r) : "v"(lo), "v"(hi)); return r; }
template <class Epi, class Sched, bool ALIGN_EPI = false, bool SP2 = false>
__device__ __forceinline__ void gemm_phase(PG8_LAS unsigned char* lds, const Gemm g, const Sched& S, const Epi& E) {
    const int tid = threadIdx.x, wid = __builtin_amdgcn_readfirstlane(tid >> 6), lane = tid & 63, wr = wid >> 2, wc = wid & 3, fr = lane & 15, fq = lane >> 4;
    const int K = g.K, nt = K / BK;
    unsigned voffA[2], voffB[2];
#pragma unroll
    for (int i = 0; i < 2; ++i) { int R, C; stage_rc(tid * 16 + i * 8192, R, C); const int Rb = Epi::PERM ? ((R & ~31) + perm32(R & 31)) : R;
        voffA[i] = (unsigned)(R * K + C) * 2u; voffB[i] = (unsigned)(Rb * K + C) * 2u; }
    const size_t kstep = (size_t)(BK * 2);
    const size_t hstep = (size_t)HALF * K * 2;
    const size_t tstep = 2 * hstep;
    const unsigned ldsw = (unsigned)wid * 1024u;
    const int aoff = lds_byte(wr * 64 + fr, fq * 8), boff = lds_byte(wc * 32 + fr, fq * 8);
#define PG8_SA(b, h) (((b) * 2 + (h)) * HTB)
#define PG8_SB(b, h) ((4 + (b) * 2 + (h)) * HTB)
#define PG8_STAGE(bufoff, gbase, voff) do { _Pragma("unroll") for (int _i = 0; _i < 2; ++_i) \
        __builtin_amdgcn_global_load_lds((const unsigned*)((const char*)(gbase) + (voff)[_i]), (PG8_LAS unsigned*)(lds + (bufoff) + ldsw + _i * 8192), 16, 0, 0); } while (0)
#define PG8_LDA(dst, b, h) do { _Pragma("unroll") for (int m = 0; m < 4; ++m) _Pragma("unroll") for (int k = 0; k < 2; ++k) dst[m][k] = *(const PG8_LAS bf16x8*)(lds + PG8_SA(b, h) + aoff + m * 2048 + k * 1024); } while (0)
#define PG8_LDB(dst, b, h) do { _Pragma("unroll") for (int n = 0; n < 2; ++n) _Pragma("unroll") for (int k = 0; k < 2; ++k) dst[n][k] = *(const PG8_LAS bf16x8*)(lds + PG8_SB(b, h) + boff + n * 2048 + k * 1024); } while (0)
#define PG8_MMA(ai, bj, At, Bt) do { __builtin_amdgcn_s_setprio(1); _Pragma("unroll") for (int m = 0; m < 4; ++m) _Pragma("unroll") for (int n = 0; n < 2; ++n) _Pragma("unroll") for (int k = 0; k < 2; ++k) \
        acc[ai][bj][m][n] = __builtin_amdgcn_mfma_f32_16x16x32_bf16(Bt[n][k], At[m][k], acc[ai][bj][m][n], 0, 0, 0); __builtin_amdgcn_s_setprio(0); } while (0)
#define PG8_WAIT_V(n) asm volatile("s_waitcnt vmcnt(" #n ")" ::: "memory")
#define PG8_WAIT_L(n) asm volatile("s_waitcnt lgkmcnt(" #n ")" ::: "memory")
#define PG8_BAR __builtin_amdgcn_s_barrier()
#define PG8_SCHED __builtin_amdgcn_sched_barrier(0)
    Unit cur, nxt; int ui = 0;
    if (!S.next(0, cur)) return;
    f32x4 acc[2][2][4][2];
#pragma unroll
    for (int a = 0; a < 2; ++a)
#pragma unroll
        for (int b = 0; b < 2; ++b)
#pragma unroll
            for (int m = 0; m < 4; ++m)
#pragma unroll
                for (int n = 0; n < 2; ++n) acc[a][b][m][n] = (f32x4){0.f, 0.f, 0.f, 0.f};
    bf16x8 At[4][2], B0[2][2], B1[2][2];
    const char* cA = (const char*)g.A + (size_t)cur.pm * tstep; const char* cB = (const char*)g.Bt + (size_t)cur.pn * tstep;
    S.a_ready(cur);
    if constexpr (SP2) {
        PG8_STAGE(PG8_SB(0, 0), cB, voffB); PG8_STAGE(PG8_SB(0, 1), cB + hstep, voffB); PG8_STAGE(PG8_SA(0, 0), cA, voffA); PG8_STAGE(PG8_SA(0, 1), cA + hstep, voffA);
        if (wr == 1) PG8_BAR;
        PG8_WAIT_V(2); PG8_BAR;
        PG8_STAGE(PG8_SB(1, 0), cB + kstep, voffB); PG8_STAGE(PG8_SA(1, 0), cA + kstep, voffA); PG8_STAGE(PG8_SB(1, 1), cB + hstep + kstep, voffB);
        PG8_WAIT_V(6); PG8_BAR;
    } else {
        PG8_STAGE(PG8_SB(0, 0), cB, voffB); PG8_STAGE(PG8_SA(0, 0), cA, voffA); PG8_STAGE(PG8_SB(0, 1), cB + hstep, voffB); PG8_STAGE(PG8_SA(0, 1), cA + hstep, voffA);
        if (wr == 1) PG8_BAR;
        PG8_WAIT_V(4); PG8_BAR;
        PG8_STAGE(PG8_SB(1, 0), cB + kstep, voffB); PG8_STAGE(PG8_SA(1, 0), cA + kstep, voffA); PG8_STAGE(PG8_SB(1, 1), cB + hstep + kstep, voffB);
        PG8_WAIT_V(6); PG8_BAR;
    }
    for (;;) {
        const bool has_next = S.next(ui + 1, nxt);
        const char* nA = has_next ? (const char*)g.A + (size_t)nxt.pm * tstep : cA; const char* nB = has_next ? (const char*)g.Bt + (size_t)nxt.pn * tstep : cB;
        for (int t = 0; t < nt; t += 2) {
            const bool last = (t == nt - 2);
            const char* a1 = cA + (size_t)(t + 1) * kstep;
            const char* a2 = last ? nA : cA + (size_t)(t + 2) * kstep; const char* b2 = last ? nB : cB + (size_t)(t + 2) * kstep;
            const char* a3 = a2 + kstep; const char* b3 = b2 + kstep;
            if (last && has_next) S.a_ready(nxt);
            if constexpr (SP2) {
            PG8_LDB(B0, 0, 0); PG8_LDB(B1, 0, 1); PG8_SCHED; PG8_LDA(At, 0, 0); PG8_STAGE(PG8_SA(1, 1), a1 + hstep, voffA);
            PG8_WAIT_V(8); PG8_WAIT_L(0); PG8_BAR; PG8_MMA(0, 0, At, B0); PG8_MMA(0, 1, At, B1); PG8_BAR; PG8_SCHED;
            PG8_LDA(At, 0, 1); PG8_STAGE(PG8_SB(0, 0), b2, voffB); PG8_STAGE(PG8_SB(0, 1), b2 + hstep, voffB); PG8_STAGE(PG8_SA(0, 0), a2, voffA);
            PG8_WAIT_V(8); PG8_WAIT_L(0); PG8_BAR; PG8_MMA(1, 0, At, B0); PG8_MMA(1, 1, At, B1); PG8_BAR; PG8_SCHED;
            PG8_LDB(B0, 1, 0); PG8_LDB(B1, 1, 1); PG8_SCHED; PG8_LDA(At, 1, 0); PG8_STAGE(PG8_SA(0, 1), a2 + hstep, voffA);
            PG8_WAIT_V(8); PG8_WAIT_L(0); PG8_BAR; PG8_MMA(0, 0, At, B0); PG8_MMA(0, 1, At, B1); PG8_BAR; PG8_SCHED;
            PG8_LDA(At, 1, 1); PG8_STAGE(PG8_SB(1, 0), b3, voffB); PG8_STAGE(PG8_SB(1, 1), b3 + hstep, voffB); PG8_STAGE(PG8_SA(1, 0), a3, voffA);
            PG8_WAIT_V(8); PG8_WAIT_L(0); PG8_BAR; PG8_MMA(1, 0, At, B0); PG8_MMA(1, 1, At, B1); PG8_BAR; PG8_SCHED;
            } else {
            PG8_LDB(B0, 0, 0); PG8_SCHED; PG8_LDA(At, 0, 0); PG8_STAGE(PG8_SA(1, 1), a1 + hstep, voffA);
            PG8_WAIT_L(8); PG8_BAR; PG8_WAIT_L(0); PG8_MMA(0, 0, At, B0); PG8_BAR; PG8_SCHED;
            PG8_LDB(B1, 0, 1); PG8_STAGE(PG8_SB(0, 0), b2, voffB);
            PG8_BAR; PG8_WAIT_L(0); PG8_MMA(0, 1, At, B1); PG8_BAR;
            PG8_LDA(At, 0, 1); PG8_STAGE(PG8_SA(0, 0), a2, voffA);
            PG8_BAR; PG8_WAIT_L(0); PG8_MMA(1, 0, At, B0); PG8_BAR; PG8_SCHED;
            PG8_STAGE(PG8_SB(0, 1), b2 + hstep, voffB);
            PG8_WAIT_V(6); PG8_BAR; PG8_MMA(1, 1, At, B1); PG8_BAR;
            PG8_LDB(B0, 1, 0); PG8_SCHED; PG8_LDA(At, 1, 0); PG8_STAGE(PG8_SA(0, 1), a2 + hstep, voffA);
            PG8_WAIT_L(8); PG8_BAR; PG8_WAIT_L(0); PG8_MMA(0, 0, At, B0); PG8_BAR; PG8_SCHED;
            PG8_LDB(B1, 1, 1); PG8_STAGE(PG8_SB(1, 0), b3, voffB);
            PG8_BAR; PG8_WAIT_L(0); PG8_MMA(0, 1, At, B1); PG8_BAR;
            PG8_LDA(At, 1, 1); PG8_STAGE(PG8_SA(1, 0), a3, voffA);
            PG8_BAR; PG8_WAIT_L(0); PG8_MMA(1, 0, At, B0); PG8_BAR; PG8_SCHED;
            PG8_STAGE(PG8_SB(1, 1), b3 + hstep, voffB);
            PG8_WAIT_V(6); PG8_BAR; PG8_MMA(1, 1, At, B1); PG8_BAR;
            }
        }
        if constexpr (ALIGN_EPI) { if (wr == 0) PG8_BAR; }
        if constexpr (!Epi::AFTER_DRAIN) { E(acc, cur, wr, wc, fr, fq);
#ifdef PROBE_EPI2
            if constexpr (Epi::PROBE_ID == PROBE_EPI2) { asm volatile("" ::: "memory"); E(acc, cur, wr, wc, fr, fq); }
#endif
            S.done(cur); }
        if (!has_next) break;
#pragma unroll
        for (int a = 0; a < 2; ++a)
#pragma unroll
            for (int b = 0; b < 2; ++b)
#pragma unroll
                for (int m = 0; m < 4; ++m)
#pragma unroll
                    for (int n = 0; n < 2; ++n) acc[a][b][m][n] = (f32x4){0.f, 0.f, 0.f, 0.f};
        cur = nxt; cA = nA; cB = nB; ++ui;
        if constexpr (ALIGN_EPI) { if (wr == 1) PG8_BAR; }
    }
    PG8_WAIT_V(0);
    if constexpr (!ALIGN_EPI) { if (wr == 0) PG8_BAR; }
    PG8_BAR;
    if constexpr (Epi::AFTER_DRAIN) { E.fused(acc, cur, wr, wc, fr, fq, lds, wid, lane); S.done(cur); }
#undef PG8_SA
#undef PG8_SB
#undef PG8_STAGE
#undef PG8_LDA
#undef PG8_LDB
#undef PG8_MMA
#undef PG8_WAIT_V
#undef PG8_WAIT_L
#undef PG8_BAR
#undef PG8_SCHED
}
}
#ifndef PG8_SP2
#define PG8_SP2 true
#endif
#ifndef PG8_ALIGN
#define PG8_ALIGN true
#endif
#ifndef MK_COOP
#define MK_COOP 1
#endif

#define LAS __attribute__((address_space(3)))
typedef unsigned short bf16;
typedef unsigned v4u __attribute__((ext_vector_type(4)));
typedef unsigned v2u __attribute__((ext_vector_type(2)));
typedef float f32x4 __attribute__((ext_vector_type(4)));
typedef float f32x16 __attribute__((ext_vector_type(16)));
typedef short bf16x8 __attribute__((ext_vector_type(8)));
typedef short v4i16_t __attribute__((ext_vector_type(4)));
typedef float f32x2_t __attribute__((ext_vector_type(2)));
typedef __bf16 bf16x2_t __attribute__((ext_vector_type(2)));

constexpr int D = 1024, MP = 4096, MS = 32768, M = MP + MS, NIN = 3072, DFF = 2816, NFI = 2 * DFF;
constexpr int SEQ_P = 256, SEQ_S = 4096, PAST = 256, NB_S = 8, NB_P = 16;
constexpr int KV_PER_B = PAST + SEQ_S;
constexpr int KROWS = MP + NB_S * KV_PER_B;
constexpr float EPS = 1e-6f;
constexpr float QSCALE = 0.125f * 1.4426950408889634f;
constexpr int NWAVES = 8, NTHREADS = 512;

constexpr size_t MiB = 1u << 20;
constexpr size_t WS_MOD = 0;
constexpr size_t WS_ROT = 256 * 1024;
constexpr size_t WS_BAR = 512 * 1024, BAR_BYTES = 16384;
constexpr size_t WS_SS1 = 1 * MiB;
constexpr size_t WS_SS2 = 4 * MiB;
constexpr size_t WS_WIN = 8 * MiB, WS_WO = 14 * MiB, WS_WFI = 16 * MiB, WS_WFO = 27 * MiB;
constexpr size_t WS_U = 34 * MiB;
constexpr size_t WS_MIXO = 106 * MiB;
constexpr size_t WS_Q = 178 * MiB;
constexpr size_t WS_K = 214 * MiB;
constexpr size_t WS_V = 252 * MiB;
constexpr size_t WS_MIX = 290 * MiB;
constexpr size_t WS_BG = 362 * MiB;
constexpr size_t WS_Z = 398 * MiB;
constexpr size_t WS_H = 178 * MiB;
constexpr size_t WS_END = 434 * MiB;
static_assert(WS_H + (size_t)M * DFF * 2 <= WS_Z, "H overlay");
static_assert(WS_K + (size_t)KROWS * 512 * 2 <= WS_V && WS_V + (size_t)KROWS * 512 * 2 <= WS_MIX, "kv map");

constexpr int MISC_OFF = 131072 + 1024;
constexpr int LDS_BYTES = 131072 + 2048;

__device__ __forceinline__ unsigned pk2(float lo, float hi) { f32x2_t v = {lo, hi}; bf16x2_t b = __builtin_convertvector(v, bf16x2_t); return __builtin_bit_cast(unsigned, b); }
__device__ __forceinline__ float bf2f(unsigned short b) { return __uint_as_float((unsigned)b << 16); }
__device__ __forceinline__ float wave_sum(float v) {
#pragma unroll
    for (int o = 1; o < 64; o <<= 1) v += __shfl_xor(v, o);
    return v;
}
__device__ __forceinline__ int krow_of(int r) { return r < MP ? r : MP + ((r - MP) >> 12) * KV_PER_B + PAST + ((r - MP) & 4095); }

#define XB_TMO      128
#define XB_XCNT(j)  (256  + 64 * (j))
#define XB_XSUB(j)  (1280 + 64 * (j))
#define XB_XGEN(j)  (2304 + 64 * (j))
#define XB_TOP      3328
#define XB_TOPGEN   3392
#define XCD_BAR_WORDS 3456
#define XB_SPIN_CAP (1u << 18)

__device__ __forceinline__ unsigned xb_ld(unsigned* p)              { return __hip_atomic_load(p, __ATOMIC_RELAXED, __HIP_MEMORY_SCOPE_AGENT); }
__device__ __forceinline__ unsigned xb_add(unsigned* p, unsigned v) { return __hip_atomic_fetch_add(p, v, __ATOMIC_RELAXED, __HIP_MEMORY_SCOPE_AGENT); }
__device__ __forceinline__ unsigned xb_xcc_id() { return (unsigned)__builtin_amdgcn_s_getreg((3 << 11) | 20) & 0xFu; }
#define XB_SPIN(cond, bar) do { unsigned _sp = 0; while (cond) { __builtin_amdgcn_s_sleep(1); \
    if ((++_sp & 255u) == 0u) { if (xb_ld(&(bar)[XB_TMO])) break; if (_sp > XB_SPIN_CAP) { atomicAdd(&(bar)[XB_TMO], 1u); break; } } } } while (0)

struct XcdBarrier {
    unsigned* bar; unsigned x;
    volatile LAS unsigned* st;
};

__device__ __forceinline__ XcdBarrier xcd_barrier_post(unsigned* bar, volatile LAS unsigned* st) {
    XcdBarrier b; b.bar = bar; b.x = xb_xcc_id(); b.st = st;
    if (threadIdx.x == 0) (void)xb_add(&bar[XB_XCNT(b.x)], 1u);
    return b;
}
__device__ __forceinline__ void xcd_barrier_complete(unsigned* bar, unsigned x, unsigned& nloc, unsigned& nx) {
    const unsigned G = gridDim.x * gridDim.y * gridDim.z;
    unsigned sum, cnt, mine, sp = 0u;
    for (;;) {
        sum = 0u; cnt = 0u; mine = 0u;
#pragma unroll
        for (unsigned j = 0; j < 16; ++j) { const unsigned c = xb_ld(&bar[XB_XCNT(j)]); sum += c; cnt += (c > 0u) ? 1u : 0u; mine = (j == x) ? c : mine; }
        if (sum == G) break;
        __builtin_amdgcn_s_sleep(1);
        if ((++sp & 255u) == 0u) { if (xb_ld(&bar[XB_TMO])) break; if (sp > XB_SPIN_CAP) { atomicAdd(&bar[XB_TMO], 1u); break; } }
    }
    nloc = mine > 0u ? mine : 1u; nx = cnt > 0u ? cnt : 1u;
}

__device__ __forceinline__ void xcd_barrier(const XcdBarrier& b) {
    asm volatile("s_waitcnt vmcnt(0)" ::: "memory");
    __syncthreads();
    if (threadIdx.x == 0) {
        unsigned* bar = b.bar;
        __builtin_amdgcn_s_waitcnt(0);
        unsigned nloc = b.st[0], nx = b.st[1];
        if (nloc == 0u) { xcd_barrier_complete(bar, b.x, nloc, nx); b.st[0] = nloc; b.st[1] = nx; }
        const unsigned old = xb_add(&bar[XB_XSUB(b.x)], 1u);
        const unsigned gen = old / nloc;
        if (old + 1u == (gen + 1u) * nloc) {
            __builtin_amdgcn_fence(__ATOMIC_RELEASE, "agent");
            asm volatile("s_waitcnt vmcnt(0)" ::: "memory");
            const unsigned og = xb_add(&bar[XB_TOP], 1u);
            const unsigned tg = og / nx;
            if (og + 1u == (tg + 1u) * nx) xb_add(&bar[XB_TOPGEN], 1u);
            else XB_SPIN(xb_ld(&bar[XB_TOPGEN]) == tg, bar);
            __builtin_amdgcn_fence(__ATOMIC_ACQUIRE, "agent");
            xb_add(&bar[XB_XGEN(b.x)], 1u);
            asm volatile("s_waitcnt vmcnt(0)" ::: "memory");
        } else {
            XB_SPIN(xb_ld(&bar[XB_XGEN(b.x)]) == gen, bar);
            __builtin_amdgcn_fence(__ATOMIC_ACQUIRE, "agent");
            asm volatile("s_waitcnt vmcnt(0)" ::: "memory");
        }
    }
    __syncthreads();
}

namespace pg8 {
struct EpiIn {
    static constexpr bool PERM = true, AFTER_DRAIN = false; static constexpr int PROBE_ID = 1;
    bf16_t *Q, *Kb, *Vb, *BG, *Z; float *stK, *stV; const float* rot;
    __device__ __forceinline__ void operator()(const f32x4 (&acc)[2][2][4][2], const Unit& u, int wr, int wc, int fr, int fq) const {
        const int pn = u.pn; const bool sample = u.pm >= (MP / 256);
        const int rbase = u.pm * BM + wr * 64 + fr;
        const int cp = wc * 32 + 8 * fq;
        if (pn < 4) {
            const bool isq = pn < 2; const int cbp = (pn & 1) * 256 + cp, cbl = (pn & 1) * 256 + wc * 32 + 4 * fq;
            const float qs = isq ? QSCALE : 1.0f;
#pragma unroll
            for (int ai = 0; ai < 2; ++ai)
#pragma unroll
                for (int m = 0; m < 4; ++m) {
                    const int r = rbase + ai * HALF + m * 16;
                    f32x4 cs = (f32x4){1.f, 1.f, 1.f, 1.f}, sn = (f32x4){0.f, 0.f, 0.f, 0.f};
                    if (sample) { const int t = (r - MP) & 4095; const int pos = (wc & 1) ? (t & 63) : (t >> 6);
                        cs = *(const f32x4*)(rot + pos * 16 + 4 * fq); sn = *(const f32x4*)(rot + 1024 + pos * 16 + 4 * fq); }
                    cs = cs * qs; sn = sn * qs;
                    const size_t kr = (size_t)krow_of(r);
#pragma unroll
                    for (int bj = 0; bj < 2; ++bj) {
                        const f32x4 x1 = acc[ai][bj][m][0], x2 = acc[ai][bj][m][1];
                        const f32x4 o1 = x1 * cs - x2 * sn, o2 = x2 * cs + x1 * sn;
                        u32x4 w; w.x = pk2(o1[0], o1[1]); w.y = pk2(o1[2], o1[3]); w.z = pk2(o2[0], o2[1]); w.w = pk2(o2[2], o2[3]);
                        if (isq) *(u32x4*)(Q + (size_t)r * 512 + cbp + bj * HALF) = w;
                        else { *(u32x4*)(Kb + kr * 512 + cbp + bj * HALF) = w;
                            if (!sample) { float* s = stK + (size_t)r * 512 + cbl + bj * HALF; *(f32x4*)s = x1; *(f32x4*)(s + 16) = x2; } }
                    }
                }
        } else if (pn < 8) {
            const bool isv = pn < 6; const int cb = (pn & 1) * 256 + cp;
#pragma unroll
            for (int ai = 0; ai < 2; ++ai)
#pragma unroll
                for (int m = 0; m < 4; ++m) {
                    const int r = rbase + ai * HALF + m * 16;
                    const size_t orow = isv ? (size_t)krow_of(r) : (size_t)r;
                    bf16_t* base = (isv ? Vb : BG) + orow * 512 + cb;
#pragma unroll
                    for (int bj = 0; bj < 2; ++bj) {
                        const f32x4 x1 = acc[ai][bj][m][0], x2 = acc[ai][bj][m][1];
                        u32x4 w; w.x = pk2(x1[0], x1[1]); w.y = pk2(x1[2], x1[3]); w.z = pk2(x2[0], x2[1]); w.w = pk2(x2[2], x2[3]);
                        *(u32x4*)(base + bj * HALF) = w;
                        if (isv && !sample) { float* s = stV + (size_t)r * 512 + cb + bj * HALF; *(f32x4*)s = x1; *(f32x4*)(s + 4) = x2; }
                    }
                }
        } else {
            const int cb = (pn - 8) * 128 + cp;
#pragma unroll
            for (int ai = 0; ai < 2; ++ai)
#pragma unroll
                for (int m = 0; m < 4; ++m) {
                    const int r = rbase + ai * HALF + m * 16;
                    const f32x4 z1 = acc[ai][0][m][0] * acc[ai][1][m][0], z2 = acc[ai][0][m][1] * acc[ai][1][m][1];
                    u32x4 w; w.x = pk2(z1[0], z1[1]); w.y = pk2(z1[2], z1[3]); w.z = pk2(z2[0], z2[1]); w.w = pk2(z2[2], z2[3]);
                    *(u32x4*)(Z + (size_t)r * 512 + cb) = w;
                }
        }
    }
};
struct EpiSS {
    static constexpr bool PERM = true, AFTER_DRAIN = false; static constexpr int PROBE_ID = 2;
    bf16_t* O; float* SS;
    __device__ __forceinline__ void operator()(const f32x4 (&acc)[2][2][4][2], const Unit& u, int wr, int wc, int fr, int fq) const {
        const int rbase = u.pm * BM + wr * 64 + fr; const int c0 = u.pn * BM + wc * 32 + 8 * fq;
#pragma unroll
        for (int ai = 0; ai < 2; ++ai)
#pragma unroll
            for (int m = 0; m < 4; ++m) {
                const int r = rbase + ai * HALF + m * 16; float s = 0.f;
#pragma unroll
                for (int bj = 0; bj < 2; ++bj) {
                    const f32x4 v0 = acc[ai][bj][m][0], v1 = acc[ai][bj][m][1];
                    s += (v0[0] * v0[0] + v0[1] * v0[1]) + (v0[2] * v0[2] + v0[3] * v0[3]) + (v1[0] * v1[0] + v1[1] * v1[1]) + (v1[2] * v1[2] + v1[3] * v1[3]);
                    u32x4 w; w.x = pk2(v0[0], v0[1]); w.y = pk2(v0[2], v0[3]); w.z = pk2(v1[0], v1[1]); w.w = pk2(v1[2], v1[3]);
                    *(u32x4*)(O + (size_t)r * D + c0 + bj * HALF) = w;
                }
                s += __shfl_xor(s, 16); s += __shfl_xor(s, 32);
                if (fq == 0) SS[(size_t)r * 16 + u.pn * 4 + wc] = s;
            }
    }
};
struct EpiGlu {
    static constexpr bool PERM = true, AFTER_DRAIN = false; static constexpr int PROBE_ID = 3;
    bf16_t* H;
    __device__ __forceinline__ void operator()(const f32x4 (&acc)[2][2][4][2], const Unit& u, int wr, int wc, int fr, int fq) const {
        const int rbase = u.pm * BM + wr * 64 + fr; const int c0 = u.pn * HALF + wc * 32 + 8 * fq;
#pragma unroll
        for (int ai = 0; ai < 2; ++ai)
#pragma unroll
            for (int m = 0; m < 4; ++m) {
                const int r = rbase + ai * HALF + m * 16; f32x4 hv[2];
#pragma unroll
                for (int n = 0; n < 2; ++n) { const f32x4 g = acc[ai][0][m][n], up = acc[ai][1][m][n];
                    f32x4 e; e[0] = __builtin_amdgcn_exp2f(g[0]); e[1] = __builtin_amdgcn_exp2f(g[1]); e[2] = __builtin_amdgcn_exp2f(g[2]); e[3] = __builtin_amdgcn_exp2f(g[3]);
                    const f32x4 d = e + 1.0f;
                    f32x4 rc; rc[0] = __builtin_amdgcn_rcpf(d[0]); rc[1] = __builtin_amdgcn_rcpf(d[1]); rc[2] = __builtin_amdgcn_rcpf(d[2]); rc[3] = __builtin_amdgcn_rcpf(d[3]);
                    hv[n] = (g * up) * rc; }
                u32x4 w; w.x = pk2(hv[0][0], hv[0][1]); w.y = pk2(hv[0][2], hv[0][3]); w.z = pk2(hv[1][0], hv[1][1]); w.w = pk2(hv[1][2], hv[1][3]);
                *(u32x4*)(H + (size_t)r * DFF + c0) = w;
            }
    }
};
}

namespace att {
constexpr int TILEB = 16384, NSLOT = 3, VRING = NSLOT * TILEB, WSF_OFF = 2 * NSLOT * TILEB, LDS_NEED = WSF_OFF + NWAVES * 256;
static_assert(LDS_NEED <= 131072 && 4 * 32 * 128 * 4 <= WSF_OFF, "attention LDS");
constexpr float THR = 8.f;
__device__ __forceinline__ int crow(int r, int hi) { return (r & 3) + 8 * (r >> 2) + 4 * hi; }
__device__ __forceinline__ bf16x8 vfrag(const LAS char* p0, const LAS char* p1) {
    const v4i16_t lo = __builtin_amdgcn_ds_read_tr16_b64_v4i16((LAS v4i16_t*)p0), hi = __builtin_amdgcn_ds_read_tr16_b64_v4i16((LAS v4i16_t*)p1);
    return (bf16x8){lo[0], lo[1], lo[2], lo[3], hi[0], hi[1], hi[2], hi[3]};
}
__device__ __forceinline__ void glds16(const void* gsrc, unsigned lds_dst) { unsigned keep;
    asm volatile("s_mov_b32 %0, m0\n\ts_mov_b32 m0, %2\n\ts_nop 0\n\tglobal_load_lds_dwordx4 %1, off\n\ts_mov_b32 m0, %0" : "=&s"(keep) : "v"(gsrc), "s"(lds_dst) : "memory"); }
__device__ __forceinline__ void glds16s(const void* sbase, unsigned voff, unsigned lds_dst) { unsigned keep;
    asm volatile("s_mov_b32 %0, m0\n\ts_mov_b32 m0, %3\n\ts_nop 0\n\tglobal_load_lds_dwordx4 %1, %2\n\ts_mov_b32 m0, %0" : "=&s"(keep) : "v"(voff), "s"(sbase), "s"(lds_dst) : "memory"); }
__device__ __forceinline__ float swapmax(float m) { auto rr = __builtin_amdgcn_permlane32_swap(__float_as_uint(m), __float_as_uint(m), false, false); return fmaxf(__uint_as_float(rr[0]), __uint_as_float(rr[1])); }
#define ATT_WAIT_BAR(N) asm volatile("s_waitcnt vmcnt(" #N ") lgkmcnt(0)\n\ts_barrier" ::: "memory")
#define ATT_SB() __builtin_amdgcn_sched_barrier(0)
struct AttnCtx {
    LAS char* lds; LAS float* wsf; const char* kg; const char* vg; unsigned soff[2]; unsigned lds0; int ka[4]; int va[2][4]; int r32, hi, NT;
};
__device__ __forceinline__ float max3f(float a, float b, float c) { return fmaxf(fmaxf(a, b), c); }
template <bool LAST, int S0, bool DOMAX>
__device__ __forceinline__ void attn_step(const AttnCtx& C, int t, f32x16& P0, f32x16& P1, f32x16& N0, f32x16& N1, f32x16 (&o)[4], f32x16& negm, const bf16x8 (&qr)[4], float& mhat, float& l, float& rm) {
    constexpr int s0 = S0, s1 = (S0 + 1) % 3, s2 = (S0 + 2) % 3;
    const bool ik = (t + 3 < C.NT), iv = (t + 2 < C.NT);
    const LAS char* kb = C.lds + s1 * TILEB; const LAS char* vb = C.lds + s0 * TILEB;
    bf16x8 kf[8], vf[16];
#define ATT_KF(i) (*(const LAS bf16x8*)(kb + C.ka[(i) >> 1] + ((i) & 1) * 8192))
#define ATT_VF(n) vfrag(vb + C.va[0][(n) & 3] + ((n) >> 2) * 4096, vb + C.va[1][(n) & 3] + ((n) >> 2) * 4096)
    if (!LAST) { kf[0] = ATT_KF(0); kf[1] = ATT_KF(1); }
#ifdef PROBE_DMA2
    if (ik) { const char* p_ = C.kg + (size_t)(t + 3) * 65536; const unsigned d_ = (unsigned)__builtin_amdgcn_readfirstlane(C.lds0 + s0 * TILEB); glds16(p_ + C.soff[0], d_); glds16(p_ + C.soff[1], d_ + 1024); glds16(p_ + C.soff[0], d_); glds16(p_ + C.soff[1], d_ + 1024); }
    if (iv) { const char* p_ = C.vg + (size_t)(t + 2) * 65536; const unsigned d_ = (unsigned)__builtin_amdgcn_readfirstlane(C.lds0 + VRING + s2 * TILEB); glds16(p_ + C.soff[0], d_); glds16(p_ + C.soff[1], d_ + 1024); glds16(p_ + C.soff[0], d_); glds16(p_ + C.soff[1], d_ + 1024); }
#else
    if (ik) { const char* p_ = C.kg + (size_t)(t + 3) * 65536; const unsigned d_ = (unsigned)__builtin_amdgcn_readfirstlane(C.lds0 + s0 * TILEB); glds16s(p_, C.soff[0], d_); glds16s(p_, C.soff[1], d_ + 1024); }
    if (iv) { const char* p_ = C.vg + (size_t)(t + 2) * 65536; const unsigned d_ = (unsigned)__builtin_amdgcn_readfirstlane(C.lds0 + VRING + s2 * TILEB); glds16s(p_, C.soff[0], d_); glds16s(p_, C.soff[1], d_ + 1024); }
#endif
    ATT_SB();
    if (__any(rm > THR)) {
        const float dl = fmaxf(rm, 0.f);
        mhat += dl;
#pragma unroll
        for (int r = 0; r < 16; ++r) { P0[r] -= dl; P1[r] -= dl; negm[r] = -mhat; }
        const float f = __builtin_amdgcn_exp2f(-dl); l *= f;
        C.wsf[C.r32] = f;
#pragma unroll
        for (int r = 0; r < 16; ++r) { const float fr_ = C.wsf[crow(r, C.hi)];
#pragma unroll
            for (int db = 0; db < 4; ++db) o[db][r] *= fr_; }
    }
    ATT_SB();
    float ls = 0.f; v4u pwu[4]; float rn = -INFINITY;
#define ATT_SOFT(g) do { _Pragma("unroll") for (int e_ = (8 * (g)) / 5; e_ < ((8 * ((g) + 1)) / 5 < 32 ? (8 * ((g) + 1)) / 5 : 32); ++e_) { \
        float x_; if (e_ < 16) { x_ = __builtin_amdgcn_exp2f(P0[e_ & 15]); P0[e_ & 15] = x_; } else { x_ = __builtin_amdgcn_exp2f(P1[e_ & 15]); P1[e_ & 15] = x_; } \
        ls += x_; \
        if (e_ & 1) { unsigned w_ = pk2(e_ < 16 ? P0[(e_ - 1) & 15] : P1[(e_ - 1) & 15], x_); asm volatile("" : "+v"(w_)); pwu[e_ >> 3][(e_ >> 1) & 3] = w_; } } \
        asm volatile("" : "+v"(ls)); \
        if (DOMAX && (g) >= 20) { _Pragma("unroll") for (int k_ = 4 * ((g) - 20); k_ < 4 * ((g) - 20) + 4; ++k_) rn = max3f(rn, N0[k_ & 15], N1[k_ & 15]); asm volatile("" : "+v"(rn)); } } while (0)
#pragma unroll
    for (int i = 0; i < 8; ++i) {
        if (!LAST) {
            if (i == 0)      N0 = __builtin_amdgcn_mfma_f32_32x32x16_bf16(kf[i], qr[i >> 1], negm, 0, 0, 0);
            else if (i == 1) N1 = __builtin_amdgcn_mfma_f32_32x32x16_bf16(kf[i], qr[i >> 1], negm, 0, 0, 0);
            else if (i & 1)  N1 = __builtin_amdgcn_mfma_f32_32x32x16_bf16(kf[i], qr[i >> 1], N1, 0, 0, 0);
            else             N0 = __builtin_amdgcn_mfma_f32_32x32x16_bf16(kf[i], qr[i >> 1], N0, 0, 0, 0);
            if (i < 6) kf[i + 2] = ATT_KF(i + 2);
        }
        if (i >= 6) vf[i - 6] = ATT_VF(i - 6);
        ATT_SOFT(i);
        ATT_SB();
    }
#pragma unroll
    for (int j = 0; j < 8; ++j) {
        o[j & 3] = __builtin_amdgcn_mfma_f32_32x32x16_bf16(__builtin_bit_cast(bf16x8, pwu[j >> 2]), vf[j], o[j & 3], 0, 0, 0);
        vf[j + 2] = ATT_VF(j + 2);
        ATT_SOFT(8 + j);
        ATT_SB();
    }
#pragma unroll
    for (int j = 0; j < 8; ++j) {
        o[j & 3] = __builtin_amdgcn_mfma_f32_32x32x16_bf16(__builtin_bit_cast(bf16x8, pwu[2 + (j >> 2)]), vf[8 + j], o[j & 3], 0, 0, 0);
        if (j < 6) vf[8 + j + 2] = ATT_VF(8 + j + 2);
        ATT_SOFT(16 + j);
        ATT_SB();
    }
#undef ATT_SOFT
#undef ATT_KF
#undef ATT_VF
    l += ls;
    if (DOMAX) rm = swapmax(rn); else rm = 0.f;
#ifdef PROBE_DMA2
    if (ik) ATT_WAIT_BAR(8); else if (iv) ATT_WAIT_BAR(4); else ATT_WAIT_BAR(0);
#else
    if (ik) ATT_WAIT_BAR(4); else if (iv) ATT_WAIT_BAR(2); else ATT_WAIT_BAR(0);
#endif
}
__device__ __forceinline__ void attn_unit(LAS char* lds, const bf16* Q, const bf16* Kb, const bf16* Vb, bf16* MIX, int qrow0, int krow0, int NT, int h, float lam, const float* gsub) {
    const int tid = threadIdx.x, lane = tid & 63, r32 = lane & 31, hi = lane >> 5; const int wid = __builtin_amdgcn_readfirstlane(tid >> 6), qg = wid & 3, map = wid >> 2;
    AttnCtx C; C.lds = lds; C.r32 = r32; C.hi = hi; C.NT = NT;
    C.kg = (const char*)Kb + ((size_t)krow0 * 512 + h * 128) * 2;
    C.vg = (const char*)Vb + ((size_t)krow0 * 512 + h * 128) * 2;
    C.wsf = (LAS float*)(lds + WSF_OFF) + wid * 64;
    LAS float* wsf = C.wsf;
#pragma unroll
    for (int j = 0; j < 2; ++j) { const int row = 8 * wid + 4 * j + (lane >> 4); const int sw = (((lane >> 4) & 3) << 2) | ((2 * wid + j) & 3); C.soff[j] = (unsigned)(row * 1024 + (((lane & 15) ^ sw) * 16)); }
    C.lds0 = (unsigned)(uintptr_t)lds + (unsigned)wid * 2048u;
#define ATT_DMAK(t, slot) do { const char* p_ = C.kg + (size_t)(t) * 65536; const unsigned d_ = (unsigned)__builtin_amdgcn_readfirstlane(C.lds0 + (slot) * TILEB); glds16(p_ + C.soff[0], d_); glds16(p_ + C.soff[1], d_ + 1024); } while (0)
#define ATT_DMAV(t, slot) do { const char* p_ = C.vg + (size_t)(t) * 65536; const unsigned d_ = (unsigned)__builtin_amdgcn_readfirstlane(C.lds0 + VRING + (slot) * TILEB); glds16(p_ + C.soff[0], d_); glds16(p_ + C.soff[1], d_ + 1024); } while (0)
    asm volatile("s_waitcnt vmcnt(0)" ::: "memory");
    ATT_DMAK(0, 0); ATT_DMAV(0, 0); ATT_DMAK(1, 1); ATT_DMAV(1, 1);
    if (NT > 2) ATT_DMAK(2, 2);
#undef ATT_DMAK
#undef ATT_DMAV
    bf16x8 qr[4];
    { const bf16* qp = Q + (size_t)(qrow0 + 32 * qg + r32) * 512 + h * 128 + map * 64 + hi * 8;
#pragma unroll
      for (int ds = 0; ds < 4; ++ds) qr[ds] = *(const bf16x8*)(qp + ds * 16); }
    { const int swk = ((r32 & 3) << 2) | ((r32 >> 2) & 3);
#pragma unroll
      for (int ds = 0; ds < 4; ++ds) C.ka[ds] = 256 * r32 + 16 * ((8 * map + 2 * ds + hi) ^ swk);
      const int q = (lane & 15) >> 2, p = lane & 3, blk = (lane >> 4) & 1;
#pragma unroll
      for (int hh = 0; hh < 2; ++hh)
#pragma unroll
          for (int db = 0; db < 4; ++db) { const int row = 4 * hi + q + 8 * hh; const int sw = (q << 2) | ((hi + 2 * hh) & 3); C.va[hh][db] = VRING + 256 * row + 16 * ((4 * db + 2 * blk + (p >> 1)) ^ sw) + 8 * (p & 1); } }
    f32x16 o[4];
#pragma unroll
    for (int i = 0; i < 4; ++i) o[i] = (f32x16){};
    float mhat = 0.f, l = 0.f, rm; f32x16 negm;
    ATT_WAIT_BAR(0);
    f32x16 pA0 = (f32x16){}, pA1 = (f32x16){}, pB0, pB1;
    {
#pragma unroll
        for (int ds = 0; ds < 4; ++ds) {
            const bf16x8 a0 = *(const LAS bf16x8*)(lds + C.ka[ds]), a1 = *(const LAS bf16x8*)(lds + C.ka[ds] + 8192);
            pA0 = __builtin_amdgcn_mfma_f32_32x32x16_bf16(a0, qr[ds], pA0, 0, 0, 0);
            pA1 = __builtin_amdgcn_mfma_f32_32x32x16_bf16(a1, qr[ds], pA1, 0, 0, 0);
        }
        float m0 = fmaxf(pA0[0], pA1[0]);
#pragma unroll
        for (int r = 1; r < 16; ++r) m0 = fmaxf(m0, fmaxf(pA0[r], pA1[r]));
        mhat = swapmax(m0); rm = 0.f;
#pragma unroll
        for (int r = 0; r < 16; ++r) { pA0[r] -= mhat; pA1[r] -= mhat; negm[r] = -mhat; }
    }
    asm volatile("s_waitcnt lgkmcnt(0)\n\ts_barrier" ::: "memory");
    static_assert((KV_PER_B / 64) % 6 == 2 && SEQ_P / 64 == 4, "attention step remainder");
#define ATT_STEP_AB(LASTF, SLOT, tt) attn_step<LASTF, SLOT, false>(C, (tt), pA0, pA1, pB0, pB1, o, negm, qr, mhat, l, rm)
#define ATT_STEP_BA(LASTF, SLOT, tt) attn_step<LASTF, SLOT, !(LASTF)>(C, (tt), pB0, pB1, pA0, pA1, o, negm, qr, mhat, l, rm)
    int t = 0;
    for (; t + 6 < NT; t += 6) {
        ATT_STEP_AB(false, 0, t); ATT_STEP_BA(false, 1, t + 1); ATT_STEP_AB(false, 2, t + 2);
        ATT_STEP_BA(false, 0, t + 3); ATT_STEP_AB(false, 1, t + 4); ATT_STEP_BA(false, 2, t + 5);
    }
    ATT_STEP_AB(false, 0, t);
    if (NT - t == 2) { ATT_STEP_BA(true, 1, t + 1); }
    else { ATT_STEP_BA(false, 1, t + 1); ATT_STEP_AB(false, 2, t + 2); ATT_STEP_BA(true, 0, t + 3); }
#undef ATT_STEP_AB
#undef ATT_STEP_BA
    l += __shfl_xor(l, 32);
    wsf[32 + r32] = l;
    float rl[16];
#pragma unroll
    for (int r = 0; r < 16; ++r) rl[r] = 1.0f / wsf[32 + crow(r, hi)];
    LAS float* X = (LAS float*)lds + qg * 4096;
    if (map == 1) {
#pragma unroll
        for (int r = 0; r < 16; ++r)
#pragma unroll
            for (int db = 0; db < 4; ++db) X[crow(r, hi) * 128 + db * 32 + r32] = o[db][r] * rl[r];
    }
    __syncthreads();
    if (map == 0) {
        float gs[4];
#pragma unroll
        for (int db = 0; db < 4; ++db) gs[db] = gsub[db * 32 + r32] * 0.8f;
#pragma unroll
        for (int r = 0; r < 16; ++r) {
            float ss = 0.f;
#pragma unroll
            for (int db = 0; db < 4; ++db) { const float v = o[db][r] * rl[r] - lam * X[crow(r, hi) * 128 + db * 32 + r32]; o[db][r] = v; ss += v * v; }
#pragma unroll
            for (int of = 1; of < 32; of <<= 1) ss += __shfl_xor(ss, of);
            const float rs = __builtin_amdgcn_rsqf(ss * (1.0f / 128.0f) + EPS);
            bf16* op = MIX + (size_t)(qrow0 + 32 * qg + crow(r, hi)) * D + h * 128 + r32;
#pragma unroll
            for (int db = 0; db < 4; ++db) op[db * 32] = (bf16)(pk2(o[db][r] * rs * gs[db], 0.f) & 0xffffu);
        }
    }
    __syncthreads();
}
}

struct Args { const float* in[23]; float* out; unsigned char* ws; int ph_lo, ph_hi; };
enum { I_XP = 0, I_XS, I_CK, I_CV, I_C, I_CCTX, I_WADA, I_BADA, I_GAPRE, I_GAPOST, I_GFPRE, I_GFPOST, I_WIN, I_CONVW, I_CONVB, I_LQ1, I_LK1, I_LQ2, I_LK2, I_GSUB, I_WOUT, I_WFI, I_WFO };
constexpr int N_PHASES = 9;

#define mod ((float*)(args.ws + WS_MOD))
#define rot ((float*)(args.ws + WS_ROT))
#define SS1 ((float*)(args.ws + WS_SS1))
#define SS2 ((float*)(args.ws + WS_SS2))
#define WinT ((bf16*)(args.ws + WS_WIN))
#define WoT ((bf16*)(args.ws + WS_WO))
#define WfiT ((bf16*)(args.ws + WS_WFI))
#define WfoT ((bf16*)(args.ws + WS_WFO))
#define U ((bf16*)(args.ws + WS_U))
#define MIXO ((bf16*)(args.ws + WS_MIXO))
#define Qb ((bf16*)(args.ws + WS_Q))
#define Kb ((bf16*)(args.ws + WS_K))
#define Vb ((bf16*)(args.ws + WS_V))
#define MIX ((bf16*)(args.ws + WS_MIX))
#define BG ((bf16*)(args.ws + WS_BG))
#define Z ((bf16*)(args.ws + WS_Z))
#define H ((bf16*)(args.ws + WS_H))
#define xp (args.in[I_XP])
#define xs (args.in[I_XS])
#define Y (args.out)
#define stK (args.out + (size_t)M * D)
#define stV (args.out + (size_t)M * D + (size_t)MP * 512)

namespace pg8 {
struct PanelOrder {
    int G, c, lo, hi;
    __device__ __forceinline__ bool next(int i, Unit& u) const { const int L = lo + i * G + c; if (L >= hi) return false; const int xcd = L & 7, w = L >> 3; u.pm = 18 * xcd + (w >> 2); u.pn = w & 3; return true; }
    __device__ __forceinline__ void a_ready(const Unit&) const {}
    __device__ __forceinline__ void done(const Unit&) const {}
};
}
__device__ __forceinline__ int rowmap(int e, bool late) { const int p = e >> 8; const int pm = late ? 18 * (p >> 1) + 16 + (p & 1) : 18 * (p >> 4) + (p & 15); return pm * 256 + (e & 255); }
__device__ __forceinline__ void tail_arrive(unsigned* cnt) {
    asm volatile("s_waitcnt vmcnt(0)" ::: "memory");
    __syncthreads();
    if (threadIdx.x == 0) {
        __builtin_amdgcn_fence(__ATOMIC_RELEASE, "agent");
        asm volatile("s_waitcnt vmcnt(0)" ::: "memory");
        (void)xb_add(cnt, 1u);
    }
}
__device__ __forceinline__ void tail_wait(unsigned* cnt, unsigned expect) {
    if (threadIdx.x == 0) {
        unsigned sp = 0u;
        while (xb_ld(cnt) < expect) { __builtin_amdgcn_s_sleep(1); if (++sp > (1u << 20)) break; }
        __builtin_amdgcn_fence(__ATOMIC_ACQUIRE, "agent");
        asm volatile("s_waitcnt vmcnt(0)" ::: "memory");
    }
    __syncthreads();
}
__device__ __forceinline__ void free_share(int f, int& e0, int& en) { if (f < 128) { e0 = f * 171; en = 171; } else { e0 = 128 * 171 + (f - 128) * 170; en = 170; } }
__device__ __forceinline__ void early_share(int bx, int na, int nb, int& e0, int& en) { if (bx < 64) { e0 = bx * nb; en = nb; } else { e0 = 64 * nb + (bx - 64) * na; en = na; } }
__device__ __forceinline__ void p5_rows(const Args& args, int e0, int en, bool late, int wave, int lane) {
        const float* gpo = args.in[I_GAPOST]; const float* gfp = args.in[I_GFPRE];
        for (int i0 = wave; i0 < en; i0 += 8 * 2) {
            f32x4 v[2][4]; v2u mo[2][4]; float ssp[2];
#pragma unroll
            for (int q = 0; q < 2; ++q) { const int idx = i0 + 8 * q; const int r = rowmap(e0 + idx, late); ssp[q] = 0.f;
                if (idx < en) { const float* xr = r < MP ? xp + (size_t)r * D : xs + (size_t)(r - MP) * D;
                    ssp[q] = SS1[(size_t)r * 16 + (lane & 15)];
#pragma unroll
                    for (int j = 0; j < 4; ++j) { v[q][j] = __builtin_nontemporal_load((const f32x4*)(xr + 4 * lane + 256 * j)); mo[q][j] = *(const v2u*)(MIXO + (size_t)r * D + 4 * lane + 256 * j); } } }
#pragma unroll
            for (int q = 0; q < 2; ++q) { const int idx = i0 + 8 * q; const int r = rowmap(e0 + idx, late);
                if (idx < en) {
                    const float* mp = mod + (r < MP ? 0 : 1 + ((r - MP) >> 12)) * 6144;
                    float sp = ssp[q]; sp += __shfl_xor(sp, 1); sp += __shfl_xor(sp, 2); sp += __shfl_xor(sp, 4); sp += __shfl_xor(sp, 8);
                    const float rstd1 = __builtin_amdgcn_rsqf(sp * (1.f / D) + EPS); float s = 0.f;
#pragma unroll
                    for (int j = 0; j < 4; ++j) { const int c = 4 * lane + 256 * j;
                        const f32x4 mf = (f32x4){__uint_as_float(mo[q][j][0] << 16), __uint_as_float(mo[q][j][0] & 0xffff0000u), __uint_as_float(mo[q][j][1] << 16), __uint_as_float(mo[q][j][1] & 0xffff0000u)};
                        const f32x4 gg = *(const f32x4*)(gpo + c), ga = *(const f32x4*)(mp + 2048 + c);
                        v[q][j] = v[q][j] + ga * (mf * rstd1 * gg);
                        s += (v[q][j][0] * v[q][j][0] + v[q][j][1] * v[q][j][1]) + (v[q][j][2] * v[q][j][2] + v[q][j][3] * v[q][j][3]); }
                    const float rstd = __builtin_amdgcn_rsqf(wave_sum(s) * (1.f / D) + EPS);
#pragma unroll
                    for (int j = 0; j < 4; ++j) { const int c = 4 * lane + 256 * j; const f32x4 gg = *(const f32x4*)(gfp + c), sh = *(const f32x4*)(mp + 3072 + c), sc = *(const f32x4*)(mp + 4096 + c);
                        const f32x4 u = v[q][j] * rstd * gg * (sc + 1.f) + sh;
                        *(v2u*)(U + (size_t)r * D + c) = (v2u){pk2(u[0], u[1]), pk2(u[2], u[3])}; } } }
        }
}
__device__ __forceinline__ void p8_rows(const Args& args, int e0, int en, bool late, int wave, int lane) {
        const float* gpo = args.in[I_GAPOST]; const float* gfo = args.in[I_GFPOST];
        for (int i0 = wave; i0 < en; i0 += 8 * 2) {
            f32x4 v[2][4]; v2u mo[2][4], fo[2][4]; float ssp1[2], ssp2[2];
#pragma unroll
            for (int q = 0; q < 2; ++q) { const int idx = i0 + 8 * q; const int r = rowmap(e0 + idx, late); ssp1[q] = 0.f; ssp2[q] = 0.f;
                if (idx < en) { const float* xr = r < MP ? xp + (size_t)r * D : xs + (size_t)(r - MP) * D;
                    ssp1[q] = SS1[(size_t)r * 16 + (lane & 15)]; ssp2[q] = SS2[(size_t)r * 16 + (lane & 15)];
#pragma unroll
                    for (int j = 0; j < 4; ++j) { v[q][j] = __builtin_nontemporal_load((const f32x4*)(xr + 4 * lane + 256 * j)); mo[q][j] = *(const v2u*)(MIXO + (size_t)r * D + 4 * lane + 256 * j); fo[q][j] = *(const v2u*)(U + (size_t)r * D + 4 * lane + 256 * j); } } }
#pragma unroll
            for (int q = 0; q < 2; ++q) { const int idx = i0 + 8 * q; const int r = rowmap(e0 + idx, late);
                if (idx < en) {
                    const float* mp = mod + (r < MP ? 0 : 1 + ((r - MP) >> 12)) * 6144;
                    float sp = ssp1[q]; sp += __shfl_xor(sp, 1); sp += __shfl_xor(sp, 2); sp += __shfl_xor(sp, 4); sp += __shfl_xor(sp, 8);
                    const float rstd1 = __builtin_amdgcn_rsqf(sp * (1.f / D) + EPS);
                    float sq = ssp2[q]; sq += __shfl_xor(sq, 1); sq += __shfl_xor(sq, 2); sq += __shfl_xor(sq, 4); sq += __shfl_xor(sq, 8);
                    const float rstd2 = __builtin_amdgcn_rsqf(sq * (1.f / D) + EPS);
#pragma unroll
                    for (int j = 0; j < 4; ++j) { const int c = 4 * lane + 256 * j;
                        const f32x4 mf = (f32x4){__uint_as_float(mo[q][j][0] << 16), __uint_as_float(mo[q][j][0] & 0xffff0000u), __uint_as_float(mo[q][j][1] << 16), __uint_as_float(mo[q][j][1] & 0xffff0000u)};
                        const f32x4 ff = (f32x4){__uint_as_float(fo[q][j][0] << 16), __uint_as_float(fo[q][j][0] & 0xffff0000u), __uint_as_float(fo[q][j][1] << 16), __uint_as_float(fo[q][j][1] & 0xffff0000u)};
                        const f32x4 gg = *(const f32x4*)(gpo + c), ga = *(const f32x4*)(mp + 2048 + c);
                        const f32x4 x1 = v[q][j] + ga * (mf * rstd1 * gg);
                        const f32x4 g2 = *(const f32x4*)(gfo + c), gf = *(const f32x4*)(mp + 5120 + c);
                        __builtin_nontemporal_store(x1 + gf * (ff * rstd2 * g2), (f32x4*)(Y + (size_t)r * D + c)); } } }
        }
}
struct P0Item { const float* W; bf16* WT; int K, N, dst_row0, src_col0, k0; bool rperm; float scale; };
__device__ __forceinline__ P0Item p0_item(const Args& args, int it) {
    constexpr int I_1 = 16 * 96, I_2 = 16 * 32, I_3 = 16 * 176;
    P0Item q; int r = it; q.rperm = false; q.scale = 1.0f;
    if (r < I_1) { const int kb = r / 96, nb = r % 96, n0 = 32 * nb; int src = n0;
        if (n0 >= 2048) { const int j = (n0 - 2048) >> 8, c = (n0 - 2048) & 255; src = c < 128 ? 2048 + 128 * j + c : 2560 + 128 * j + (c - 128); }
        q.W = args.in[I_WIN]; q.WT = WinT; q.K = D; q.N = NIN; q.dst_row0 = n0; q.src_col0 = src; q.k0 = 64 * kb; q.rperm = n0 < 1024; return q; }
    r -= I_1;
    if (r < I_2) { const int kb = r / 32, nb = r % 32; q.W = args.in[I_WOUT]; q.WT = WoT; q.K = D; q.N = D; q.dst_row0 = 32 * nb; q.src_col0 = 32 * nb; q.k0 = 64 * kb; return q; }
    r -= I_2;
    if (r < I_3) { const int kb = r / 176, nb = r % 176, n0 = 32 * nb; const int j = n0 >> 8, c = n0 & 255; const int src = c < 128 ? 128 * j + c : DFF + 128 * j + (c - 128);
        q.W = args.in[I_WFI]; q.WT = WfiT; q.K = D; q.N = NFI; q.dst_row0 = n0; q.src_col0 = src; q.k0 = 64 * kb;
        q.scale = c < 128 ? -1.4426950408889634f : -0.6931471805599453f; return q; }
    r -= I_3;
    { const int kb = r / 32, nb = r % 32; q.W = args.in[I_WFO]; q.WT = WfoT; q.K = DFF; q.N = D; q.dst_row0 = 32 * nb; q.src_col0 = 32 * nb; q.k0 = 64 * kb; return q; }
}
__device__ __forceinline__ void p0_item_load(const P0Item& q, float (&tv)[32], int lane) {
#pragma unroll
    for (int i = 0; i < 32; ++i) { const int kk = 2 * i + (lane >> 5); tv[i] = __builtin_nontemporal_load(q.W + (size_t)(q.k0 + kk) * q.N + q.src_col0 + (lane & 31)); }
}
__device__ __forceinline__ void p0_item_finish(const P0Item& q, const float (&tv)[32], LAS float* scr, int lane) {
#pragma unroll
    for (int i = 0; i < 32; ++i) { const int kk = 2 * i + (lane >> 5); scr[kk * 33 + (lane & 31)] = tv[i] * q.scale; }
    asm volatile("s_waitcnt lgkmcnt(0)" ::: "memory");
    const int c = lane & 7;
#pragma unroll
    for (int j = 0; j < 4; ++j) { const int n = (lane >> 3) + 8 * j; const int ns = q.rperm ? (16 * ((n >> 2) & 1) + 4 * (n >> 3) + (n & 3)) : n; const LAS float* s = scr + (8 * c) * 33 + ns;
        v4u o; o.x = pk2(s[0 * 33], s[1 * 33]); o.y = pk2(s[2 * 33], s[3 * 33]); o.z = pk2(s[4 * 33], s[5 * 33]); o.w = pk2(s[6 * 33], s[7 * 33]);
        *(v4u*)(q.WT + (size_t)(q.dst_row0 + n) * q.K + q.k0 + 8 * c) = o; }
    asm volatile("s_waitcnt lgkmcnt(0)" ::: "memory");
}

__device__ __forceinline__ void p0_transposes(const Args& args, int it0, int it1, int widx, int nw, LAS float* scr, int lane) {
    int it = it0 + widx;
    if (it < it1) {
        P0Item cur = p0_item(args, it); float ta[32], tb[32];
        p0_item_load(cur, ta, lane);
        for (;;) {
            const int nx = it + nw; const bool more = nx < it1; P0Item nxt = cur;
            if (more) { nxt = p0_item(args, nx); p0_item_load(nxt, tb, lane); }
            p0_item_finish(cur, ta, scr, lane);
            if (!more) break;
#pragma unroll
            for (int i = 0; i < 32; ++i) ta[i] = tb[i];
            cur = nxt; it = nx;
        }
    }
}
constexpr int IT_WIN = 16 * 96, IT_WO = IT_WIN + 16 * 32, IT_WFI = IT_WO + 16 * 176, IT_WFO = IT_WFI + 44 * 32;

__global__ void __launch_bounds__(NTHREADS, 2) fwd_megakernel(Args args) {
    extern __shared__ __attribute__((aligned(16))) unsigned char lds_raw[];
    LAS unsigned char* lds = (LAS unsigned char*)lds_raw;
    cg::grid_group grid = cg::this_grid();
    const int tid = threadIdx.x, lane = tid & 63; const int wave = __builtin_amdgcn_readfirstlane(tid >> 6);
    const int G = gridDim.x, bx = blockIdx.x;
    const int vcu = (G % 8 == 0) ? (bx % 8) * (G / 8) + bx / 8 : bx;
    const int gw = vcu * NWAVES + wave, NGW = G * NWAVES;
    unsigned char* ws = args.ws;
    const int lo = args.ph_lo, hi_ph = args.ph_hi;
#define IN(k) (lo <= (k) && (k) < hi_ph)
    if (tid < 16) ((LAS unsigned*)(lds + MISC_OFF))[tid] = 0u;
    __syncthreads();
    XcdBarrier bar = xcd_barrier_post((unsigned*)(ws + WS_BAR), (volatile LAS unsigned*)(lds + MISC_OFF));
    if (lo < 0) grid.sync();
#ifdef PROBE_BAR2
#define SEAM(k) do { if (IN(k) && IN((k) + 1)) { xcd_barrier(bar); xcd_barrier(bar); } } while (0)
#else
#define SEAM(k) do { if (IN(k) && IN((k) + 1)) xcd_barrier(bar); } while (0)
#endif

    if (IN(0)) {
#ifdef PROBE_P0
      for (int rep_ = 0; rep_ < 3; ++rep_) {
#endif
        if (bx < 192) {
            LAS float* S = (LAS float*)lds; LAS float* red = (LAS float*)(lds + 9 * 1024 * 4);
            { float cv[18];
#pragma unroll
              for (int u = 0; u < 18; ++u) { const int e = tid + u * NTHREADS, i = e >> 10, k = e & 1023; cv[u] = (i == 0) ? args.in[I_CCTX][k] : args.in[I_C][(i - 1) * 1024 + k]; }
#pragma unroll
              for (int u = 0; u < 18; ++u) S[tid + u * NTHREADS] = cv[u] / (1.f + __expf(-cv[u])); }
            __syncthreads();
            const int kgp = tid >> 5, cl = tid & 31, j0 = 32 * bx;
            float a[9];
#pragma unroll
            for (int i = 0; i < 9; ++i) a[i] = 0.f;
            const float* wp = args.in[I_WADA] + (size_t)(kgp * 64) * 6144 + j0 + cl;
            float wv[64];
#pragma unroll
            for (int k = 0; k < 64; ++k) wv[k] = __builtin_nontemporal_load(wp + (size_t)k * 6144);
#pragma unroll
            for (int k = 0; k < 64; ++k) {
#pragma unroll
                for (int i = 0; i < 9; ++i) a[i] += S[i * 1024 + kgp * 64 + k] * wv[k]; }
#pragma unroll
            for (int i = 0; i < 9; ++i) red[(kgp * 9 + i) * 32 + cl] = a[i];
            __syncthreads();
            if (tid < 288) { const int i = tid >> 5; float s = args.in[I_BADA][j0 + cl];
#pragma unroll
                for (int g = 0; g < 16; ++g) s += red[(g * 9 + i) * 32 + cl];
                mod[i * 6144 + j0 + cl] = s; }
            tail_arrive((unsigned*)(args.ws + WS_BAR) + 3712);
        }
        p0_transposes(args, 0, IT_WIN, gw, NGW, (LAS float*)(lds + wave * 16384), lane);
        {
            f32x4 cv0[2], cv1[2];
#pragma unroll
            for (int u = 0; u < 2; ++u) { const int ir = gw + u * NGW;
                if (ir < 2 * NB_S * PAST) { const int which = ir / (NB_S * PAST), rr = ir % (NB_S * PAST);
                    const float* src_ = args.in[which ? I_CV : I_CK] + (size_t)rr * 512 + lane * 8; cv0[u] = *(const f32x4*)src_; cv1[u] = *(const f32x4*)(src_ + 4); } }
#pragma unroll
            for (int u = 0; u < 2; ++u) { const int ir = gw + u * NGW;
                if (ir < 2 * NB_S * PAST) { const int which = ir / (NB_S * PAST), rr = ir % (NB_S * PAST), b = rr / PAST, j = rr % PAST;
                    bf16* drow = (which ? Vb : Kb) + (size_t)(MP + b * KV_PER_B + j) * 512;
                    if (which) *(v4u*)(drow + lane * 8) = (v4u){pk2(cv0[u][0], cv0[u][1]), pk2(cv0[u][2], cv0[u][3]), pk2(cv1[u][0], cv1[u][1]), pk2(cv1[u][2], cv1[u][3])};
                    else { const int l0 = lane * 8, g32 = l0 & ~31, la = l0 & 31, lb = la + 4;
                        *(v2u*)(drow + g32 + 8 * ((la >> 2) & 3) + 4 * (la >> 4)) = (v2u){pk2(cv0[u][0], cv0[u][1]), pk2(cv0[u][2], cv0[u][3])};
                        *(v2u*)(drow + g32 + 8 * ((lb >> 2) & 3) + 4 * (lb >> 4)) = (v2u){pk2(cv1[u][0], cv1[u][1]), pk2(cv1[u][2], cv1[u][3])}; } } }
            for (int ir = gw + 2 * NGW; ir < 2 * NB_S * PAST; ir += NGW) {
                const int which = ir / (NB_S * PAST), rr = ir % (NB_S * PAST), b = rr / PAST, j = rr % PAST;
                const float* src_ = args.in[which ? I_CV : I_CK] + (size_t)rr * 512 + lane * 8;
                const f32x4 v0 = *(const f32x4*)src_, v1 = *(const f32x4*)(src_ + 4);
                bf16* drow = (which ? Vb : Kb) + (size_t)(MP + b * KV_PER_B + j) * 512;
                if (which) *(v4u*)(drow + lane * 8) = (v4u){pk2(v0[0], v0[1]), pk2(v0[2], v0[3]), pk2(v1[0], v1[1]), pk2(v1[2], v1[3])};
                else { const int l0 = lane * 8, g32 = l0 & ~31, la = l0 & 31, lb = la + 4;
                    *(v2u*)(drow + g32 + 8 * ((la >> 2) & 3) + 4 * (la >> 4)) = (v2u){pk2(v0[0], v0[1]), pk2(v0[2], v0[3])};
                    *(v2u*)(drow + g32 + 8 * ((lb >> 2) & 3) + 4 * (lb >> 4)) = (v2u){pk2(v1[0], v1[1]), pk2(v1[2], v1[3])}; }
            }
        }
        if (bx == 255 || (G < 256 && bx == 0)) {
            for (int e = tid; e < 1024; e += NTHREADS) { const int pos = e >> 4, i = e & 15; const float inv = 1.0f / powf(10000.0f, (float)i / 16.0f); const float ang = (float)pos * inv; rot[e] = cosf(ang); rot[1024 + e] = sinf(ang); }
        }
#ifdef PROBE_P0
      __syncthreads(); }
#endif
    }
    if (IN(0) && IN(1)) tail_wait((unsigned*)(args.ws + WS_BAR) + 3712, 192u);

    if (IN(1)) {
        const float* g = args.in[I_GAPRE];
#ifdef PROBE_ROWS
        for (int rep_ = 0; rep_ < 2; ++rep_)
#endif
        for (int r0 = gw; r0 < M; r0 += 3 * NGW) {
            f32x4 v[3][4]; float s[3];
#pragma unroll
            for (int q = 0; q < 3; ++q) { const int r = r0 + q * NGW; s[q] = 0.f;
                if (r < M) { const float* xr = r < MP ? xp + (size_t)r * D : xs + (size_t)(r - MP) * D;
#pragma unroll
                    for (int j = 0; j < 4; ++j) v[q][j] = __builtin_nontemporal_load((const f32x4*)(xr + 4 * lane + 256 * j)); } }
#pragma unroll
            for (int q = 0; q < 3; ++q) { const int r = r0 + q * NGW;
                if (r < M) {
#pragma unroll
                    for (int j = 0; j < 4; ++j) s[q] += (v[q][j][0] * v[q][j][0] + v[q][j][1] * v[q][j][1]) + (v[q][j][2] * v[q][j][2] + v[q][j][3] * v[q][j][3]);
                    const float rstd = __builtin_amdgcn_rsqf(wave_sum(s[q]) * (1.f / D) + EPS);
                    const float* mp = mod + (r < MP ? 0 : 1 + ((r - MP) >> 12)) * 6144;
#pragma unroll
                    for (int j = 0; j < 4; ++j) { const int c = 4 * lane + 256 * j; const f32x4 gg = *(const f32x4*)(g + c), sh = *(const f32x4*)(mp + c), sc = *(const f32x4*)(mp + 1024 + c);
                        const f32x4 u = v[q][j] * rstd * gg * (sc + 1.f) + sh;
                        *(v2u*)(U + (size_t)r * D + c) = (v2u){pk2(u[0], u[1]), pk2(u[2], u[3])}; } } }
        }
    }
    SEAM(1);

    if (IN(2)) {
        pg8::Gemm g{U, WinT, M, NIN, D}; pg8::StaticOrder S; S.init(M, NIN, G, bx);
        pg8::EpiIn E{Qb, Kb, Vb, BG, Z, stK, stV, rot};
        pg8::gemm_phase<pg8::EpiIn, pg8::StaticOrder, PG8_ALIGN, PG8_SP2>(lds, g, S, E);
        if (G == 256 && bx >= 192) p0_transposes(args, IT_WIN, IT_WFI, (bx - 192) * NWAVES + wave, 64 * NWAVES, (LAS float*)(lds + wave * 16384), lane);
        else if (G != 256) p0_transposes(args, IT_WIN, IT_WFI, gw, NGW, (LAS float*)(lds + wave * 16384), lane);
#ifdef PROBE_GEMM2
        __syncthreads(); pg8::gemm_phase<pg8::EpiIn, pg8::StaticOrder, PG8_ALIGN, PG8_SP2>(lds, g, S, E);
#endif
    }
    SEAM(2);

    if (IN(3)) {
        {
            const float* cw = args.in[I_CONVW]; const float* cb = args.in[I_CONVB];
            const int c8 = (tid & 63) * 8;
            float w0[8], w1[8], w2[8], bb[8];
#pragma unroll
            for (int e = 0; e < 8; ++e) { w0[e] = cw[c8 + e]; w1[e] = cw[512 + c8 + e]; w2[e] = cw[1024 + c8 + e]; bb[e] = cb[c8 + e]; }
            const bool hasp = (G == 256) && (vcu < NB_P * 4 * 2); const int cn = (G == 256) ? (hasp ? 112 : 176) : (M + G - 1) / G; const int cbase = (G == 256) ? (hasp ? vcu * 112 : 128 * 112 + (vcu - 128) * 176) : vcu * cn;
#ifdef PROBE_CONV
            for (int rep_ = 0; rep_ < 3; ++rep_)
#endif
            for (int i0 = wave; i0 < cn; i0 += 24) {
                v4u zc[3], zp[3], zn[3], bg[3];
#pragma unroll
                for (int q = 0; q < 3; ++q) { const int idx = i0 + 8 * q; const int r = cbase + idx;
                    zp[q] = (v4u){0u, 0u, 0u, 0u}; zn[q] = (v4u){0u, 0u, 0u, 0u}; zc[q] = zp[q]; bg[q] = zp[q];
                    if (idx < cn && r < M) { const int t = r < MP ? (r & (SEQ_P - 1)) : ((r - MP) & (SEQ_S - 1)); const int L = r < MP ? SEQ_P : SEQ_S;
                        zc[q] = *(const v4u*)(Z + (size_t)r * 512 + c8); bg[q] = *(const v4u*)(BG + (size_t)r * 512 + c8);
                        if (t > 0) zp[q] = *(const v4u*)(Z + (size_t)(r - 1) * 512 + c8);
                        if (t < L - 1) zn[q] = *(const v4u*)(Z + (size_t)(r + 1) * 512 + c8); } }
#pragma unroll
                for (int q = 0; q < 3; ++q) { const int idx = i0 + 8 * q; const int r = cbase + idx;
                    if (idx < cn && r < M) { float o[8];
#pragma unroll
                        for (int e = 0; e < 4; ++e) {
                            const float zc0 = __uint_as_float(zc[q][e] << 16), zc1 = __uint_as_float(zc[q][e] & 0xffff0000u), zp0 = __uint_as_float(zp[q][e] << 16), zp1 = __uint_as_float(zp[q][e] & 0xffff0000u);
                            const float zn0 = __uint_as_float(zn[q][e] << 16), zn1 = __uint_as_float(zn[q][e] & 0xffff0000u), b0 = __uint_as_float(bg[q][e] << 16), b1 = __uint_as_float(bg[q][e] & 0xffff0000u);
                            o[2 * e] = b0 * (w0[2 * e] * zp0 + w1[2 * e] * zc0 + w2[2 * e] * zn0 + bb[2 * e]);
                            o[2 * e + 1] = b1 * (w0[2 * e + 1] * zp1 + w1[2 * e + 1] * zc1 + w2[2 * e + 1] * zn1 + bb[2 * e + 1]); }
                        *(v4u*)(MIX + (size_t)r * D + 512 + c8) = (v4u){pk2(o[0], o[1]), pk2(o[2], o[3]), pk2(o[4], o[5]), pk2(o[6], o[7])}; } }
            }
        }
        float lam;
        { const float a = args.in[I_LQ1][lane] * args.in[I_LK1][lane], b = args.in[I_LQ2][lane] * args.in[I_LK2][lane];
          lam = __expf(wave_sum(a)) - __expf(wave_sum(b)) + 0.2f; }
        __syncthreads();
        const float* gsub = args.in[I_GSUB];
        for (int i = vcu; i < NB_S * 4 * 32; i += G) {
            const int bh = (i >> 5) & 31, qb = i & 31; const int b = bh >> 2, h = bh & 3;
            att::attn_unit((LAS char*)lds, Qb, Kb, Vb, MIX, MP + b * SEQ_S + qb * 128, MP + b * KV_PER_B, KV_PER_B / 64, h, lam, gsub);
        }
#ifdef PROBE_ATT2
        for (int i = vcu; i < NB_S * 4 * 32; i += G) {
            const int bh = (i >> 5) & 31, qb = i & 31; const int b = bh >> 2, h = bh & 3;
            att::attn_unit((LAS char*)lds, Qb, Kb, Vb, MIX, MP + b * SEQ_S + qb * 128, MP + b * KV_PER_B, KV_PER_B / 64, h, lam, gsub);
        }
#endif
        for (int i = vcu; i < NB_P * 4 * 2; i += G) {
            const int b = i >> 3, h = (i >> 1) & 3, qb = i & 1;
            att::attn_unit((LAS char*)lds, Qb, Kb, Vb, MIX, b * SEQ_P + qb * 128, b * SEQ_P, SEQ_P / 64, h, lam, gsub);
        }
    }
    SEAM(3);

    if (IN(4)) {
        pg8::Gemm g{MIX, WoT, M, D, D}; pg8::PanelOrder S{G, bx, 0, 512}; pg8::EpiSS E{MIXO, SS1};
        pg8::gemm_phase<pg8::EpiSS, pg8::PanelOrder, PG8_ALIGN, PG8_SP2>(lds, g, S, E);
    }
    SEAM(4);
    if (IN(5)) {
        unsigned* cnt = (unsigned*)(args.ws + WS_BAR) + 3584;
        if (bx < 64) { pg8::Gemm g{MIX, WoT, M, D, D}; pg8::PanelOrder S{G, bx, 512, 576}; pg8::EpiSS E{MIXO, SS1};
            pg8::gemm_phase<pg8::EpiSS, pg8::PanelOrder, PG8_ALIGN, PG8_SP2>(lds, g, S, E);
            tail_arrive(cnt); }
        int e0, en; early_share(bx, 144, 80, e0, en);
        p5_rows(args, e0, en, false, wave, lane);
        tail_wait(cnt, 64u);
        p5_rows(args, bx * 16, 16, true, wave, lane);
    }
    SEAM(5);
    if (IN(6)) {
        pg8::Gemm g{U, WfiT, M, NFI, D}; pg8::StaticOrder S; S.init(M, NFI, G, bx);
        pg8::EpiGlu E{H};
        pg8::gemm_phase<pg8::EpiGlu, pg8::StaticOrder, PG8_ALIGN, PG8_SP2>(lds, g, S, E);
        if (G == 256 && bx >= 96) p0_transposes(args, IT_WFI, IT_WFO, (bx - 96) * NWAVES + wave, 160 * NWAVES, (LAS float*)(lds + wave * 16384), lane);
        else if (G != 256) p0_transposes(args, IT_WFI, IT_WFO, gw, NGW, (LAS float*)(lds + wave * 16384), lane);
    }
    SEAM(6);
    if (IN(7)) {
        pg8::Gemm g{H, WfoT, M, D, DFF}; pg8::PanelOrder S{G, bx, 0, 512}; pg8::EpiSS E{U, SS2};
        pg8::gemm_phase<pg8::EpiSS, pg8::PanelOrder, PG8_ALIGN, PG8_SP2>(lds, g, S, E);
    }
    SEAM(7);
    if (IN(8)) {
        unsigned* cnt = (unsigned*)(args.ws + WS_BAR) + 3648;
        if (bx < 64) { pg8::Gemm g{H, WfoT, M, D, DFF}; pg8::PanelOrder S{G, bx, 512, 576}; pg8::EpiSS E{U, SS2};
            pg8::gemm_phase<pg8::EpiSS, pg8::PanelOrder, PG8_ALIGN, PG8_SP2>(lds, g, S, E);
            tail_arrive(cnt); }
        if (bx >= 64) { int e0, en; free_share(bx - 64, e0, en); p8_rows(args, e0, en, false, wave, lane); }
        tail_wait(cnt, 64u);
        p8_rows(args, bx * 16, 16, true, wave, lane);
    }
#undef IN
#undef SEAM
#undef mod
#undef rot
#undef SS1
#undef SS2
#undef WinT
#undef WoT
#undef WfiT
#undef WfoT
#undef U
#undef MIXO
#undef Qb
#undef Kb
#undef Vb
#undef MIX
#undef BG
#undef Z
#undef H
#undef xp
#undef xs
#undef Y
#undef stK
#undef stV
}

extern "C" void kernel_launch(void* const* d_in, const int* in_sizes, int n_in, void* d_out, int out_size, void* d_ws, size_t ws_size, hipStream_t stream) {
    static int grid = 0;
    if (grid == 0) {
        if (n_in != 23 || ws_size < WS_END || out_size != M * D + 2 * MP * 512) { fprintf(stderr, "kernel_launch: unexpected problem (n_in %d, ws %zu, out %d)\n", n_in, ws_size, out_size); grid = -1; return; }
        int dev = 0, cus = 0, per_cu = 0;
        hipGetDevice(&dev); hipDeviceGetAttribute(&cus, hipDeviceAttributeMultiprocessorCount, dev);
        if (hipFuncSetAttribute((const void*)fwd_megakernel, hipFuncAttributeMaxDynamicSharedMemorySize, LDS_BYTES) != hipSuccess) { fprintf(stderr, "kernel_launch: hipFuncSetAttribute failed\n"); grid = -1; return; }
        if (hipOccupancyMaxActiveBlocksPerMultiprocessor(&per_cu, (const void*)fwd_megakernel, NTHREADS, LDS_BYTES) != hipSuccess || per_cu < 1) { fprintf(stderr, "kernel_launch: occupancy query failed (%d)\n", per_cu); (void)hipGetLastError(); per_cu = 1; }
        grid = cus * 1;
        if (grid > cus * per_cu) grid = cus * per_cu;
    }
    if (grid < 0) return;
    Args a{};
    for (int i = 0; i < 23; ++i) a.in[i] = (const float*)d_in[i];
    a.out = (float*)d_out; a.ws = (unsigned char*)d_ws;
    if (hipMemsetAsync((char*)d_ws + WS_BAR, 0, BAR_BYTES, stream) != hipSuccess) { fprintf(stderr, "kernel_launch: memset failed\n"); return; }
#if MK_COOP
    a.ph_lo = 0; a.ph_hi = N_PHASES;
    void* kargs[] = {&a};
    hipError_t e = hipLaunchCooperativeKernel((const void*)fwd_megakernel, dim3(grid), dim3(NTHREADS), kargs, LDS_BYTES, stream);
    if (e != hipSuccess) fprintf(stderr, "cooperative launch failed: %s (grid %d)\n", hipGetErrorString(e), grid);
#else
    for (int p = 0; p < N_PHASES; ++p) { a.ph_lo = p; a.ph_hi = p + 1; hipLaunchKernelGGL(fwd_megakernel, dim3(grid), dim3(NTHREADS), LDS_BYTES, stream, a); }
#endif
}
```

```cpp
#include <hip/hip_runtime.h>
#include <hip/hip_cooperative_groups.h>
#include <cstdio>
#include <cstdint>
namespace cg = cooperative_groups;
namespace pg8 {
#define PG8_LAS __attribute__((address_space(3)))
typedef unsigned short bf16_t;
typedef short bf16x8 __attribute__((ext_vector_type(8)));
typedef float f32x4 __attribute__((ext_vector_type(4)));
typedef unsigned u32x4 __attribute__((ext_vector_type(4)));
constexpr int BM = 256, BK = 64, HALF = 128, HTB = HALF * BK * 2  , STAGE_BYTES = 8 * HTB, NXCD = 8, WGM = 8;

__host__ __device__ __forceinline__ int lds_byte(int r, int c) { const int st = (r >> 4) * 2 + (c >> 5), rr = r & 15, cc = c & 31, ob = rr * 64 + cc * 2; return st * 1024 + (ob ^ (((ob >> 9) & 1) << 5)); }
__host__ __device__ __forceinline__ void stage_rc(int b, int& R, int& C) { const int st = b / 1024, sb = b % 1024, swz = sb ^ (((sb >> 9) & 1) << 5); R = (st >> 1) * 16 + swz / 64; C = (st & 1) * 32 + (swz % 64) / 2; }
__host__ __device__ __forceinline__ int perm32(int rho) { const int n = rho >> 4, i = rho & 15; return 8 * (i >> 2) + 4 * n + (i & 3); }

struct Unit { int pm, pn; };
struct Gemm { const bf16_t* A; const bf16_t* Bt; int M, N, K; };

struct StaticOrder {
    int nM, nN, nwg, G, c;
    __host__ __device__ void init(int M, int N, int G_, int c_) { nM = M / BM; nN = N / BM; nwg = nM * nN; G = G_; c = c_; }
    __host__ __device__ bool next(int i, Unit& u) const {
        const long L = (long)i * G + c; if (L >= nwg) return false;
        int wgid = (int)L; { const int q = nwg / NXCD, r = nwg % NXCD, xcd = wgid % NXCD, off = wgid / NXCD; wgid = (xcd < r ? xcd * (q + 1) : r * (q + 1) + (xcd - r) * q) + off; }
        const int nig = WGM * nN, gid = wgid / nig, fm = gid * WGM, gsz = (nM - fm) < WGM ? (nM - fm) : WGM;
        u.pm = fm + ((wgid % nig) % gsz); u.pn = (wgid % nig) / gsz; return true;
    }
    __device__ __forceinline__ void a_ready(const Unit&) const {}
    __device__ __forceinline__ void done(const Unit&) const {}
};

__device__ __forceinline__ unsigned cvt_pk_bf16(float lo, float hi) { unsigned r; asm volatile("v_cvt_pk_bf16_f32 %0, %1, %2" : "=v"(r) : "v"(lo), "v"(hi)); return r; }
template <class Epi, class Sched, bool ALIGN_EPI = false, bool SP2 = false>
__device__ __forceinline__ void gemm_phase(PG8_LAS unsigned char* lds, const Gemm g, const Sched& S, const Epi& E) {
    const int tid = threadIdx.x, wid = __builtin_amdgcn_readfirstlane(tid >> 6), lane = tid & 63, wr = wid >> 2, wc = wid & 3, fr = lane & 15, fq = lane >> 4;
    const int K = g.K, nt = K / BK;
    unsigned voffA[2], voffB[2];
#pragma unroll
    for (int i = 0; i < 2; ++i) { int R, C; stage_rc(tid * 16 + i * 8192, R, C); const int Rb = Epi::PERM ? ((R & ~31) + perm32(R & 31)) : R;
        voffA[i] = (unsigned)(R * K + C) * 2u; voffB[i] = (unsigned)(Rb * K + C) * 2u; }
    const size_t kstep = (size_t)(BK * 2);
    const size_t hstep = (size_t)HALF * K * 2;
    const size_t tstep = 2 * hstep;
    const unsigned ldsw = (unsigned)wid * 1024u;
    const int aoff = lds_byte(wr * 64 + fr, fq * 8), boff = lds_byte(wc * 32 + fr, fq * 8);
#define PG8_SA(b, h) (((b) * 2 + (h)) * HTB)
#define PG8_SB(b, h) ((4 + (b) * 2 + (h)) * HTB)
#define PG8_STAGE(bufoff, gbase, voff) do { _Pragma("unroll") for (int _i = 0; _i < 2; ++_i) \
        __builtin_amdgcn_global_load_lds((const unsigned*)((const char*)(gbase) + (voff)[_i]), (PG8_LAS unsigned*)(lds + (bufoff) + ldsw + _i * 8192), 16, 0, 0); } while (0)
#define PG8_LDA(dst, b, h) do { _Pragma("unroll") for (int m = 0; m < 4; ++m) _Pragma("unroll") for (int k = 0; k < 2; ++k) dst[m][k] = *(const PG8_LAS bf16x8*)(lds + PG8_SA(b, h) + aoff + m * 2048 + k * 1024); } while (0)
#define PG8_LDB(dst, b, h) do { _Pragma("unroll") for (int n = 0; n < 2; ++n) _Pragma("unroll") for (int k = 0; k < 2; ++k) dst[n][k] = *(const PG8_LAS bf16x8*)(lds + PG8_SB(b, h) + boff + n * 2048 + k * 1024); } while (0)
#define PG8_MMA(ai, bj, At, Bt) do { __builtin_amdgcn_s_setprio(1); _Pragma("unroll") for (int m = 0; m < 4; ++m) _Pragma("unroll") for (int n = 0; n < 2; ++n) _Pragma("unroll") for (int k = 0; k < 2; ++k) \
        acc[ai][bj][m][n] = __builtin_amdgcn_mfma_f32_16x16x32_bf16(Bt[n][k], At[m][k], acc[ai][bj][m][n], 0, 0, 0); __builtin_amdgcn_s_setprio(0); } while (0)
#define PG8_WAIT_V(n) asm volatile("s_waitcnt vmcnt(" #n ")" ::: "memory")
#define PG8_WAIT_L(n) asm volatile("s_waitcnt lgkmcnt(" #n ")" ::: "memory")
#define PG8_BAR __builtin_amdgcn_s_barrier()
#define PG8_SCHED __builtin_amdgcn_sched_barrier(0)
    Unit cur, nxt; int ui = 0;
    if (!S.next(0, cur)) return;
    f32x4 acc[2][2][4][2];
#pragma unroll
    for (int a = 0; a < 2; ++a)
#pragma unroll
        for (int b = 0; b < 2; ++b)
#pragma unroll
            for (int m = 0; m < 4; ++m)
#pragma unroll
                for (int n = 0; n < 2; ++n) acc[a][b][m][n] = (f32x4){0.f, 0.f, 0.f, 0.f};
    bf16x8 At[4][2], B0[2][2], B1[2][2];
    const char* cA = (const char*)g.A + (size_t)cur.pm * tstep; const char* cB = (const char*)g.Bt + (size_t)cur.pn * tstep;
    S.a_ready(cur);
    if constexpr (SP2) {
        PG8_STAGE(PG8_SB(0, 0), cB, voffB); PG8_STAGE(PG8_SB(0, 1), cB + hstep, voffB); PG8_STAGE(PG8_SA(0, 0), cA, voffA); PG8_STAGE(PG8_SA(0, 1), cA + hstep, voffA);
        if (wr == 1) PG8_BAR;
        PG8_WAIT_V(2); PG8_BAR;
        PG8_STAGE(PG8_SB(1, 0), cB + kstep, voffB); PG8_STAGE(PG8_SA(1, 0), cA + kstep, voffA); PG8_STAGE(PG8_SB(1, 1), cB + hstep + kstep, voffB);
        PG8_WAIT_V(6); PG8_BAR;
    } else {
        PG8_STAGE(PG8_SB(0, 0), cB, voffB); PG8_STAGE(PG8_SA(0, 0), cA, voffA); PG8_STAGE(PG8_SB(0, 1), cB + hstep, voffB); PG8_STAGE(PG8_SA(0, 1), cA + hstep, voffA);
        if (wr == 1) PG8_BAR;
        PG8_WAIT_V(4); PG8_BAR;
        PG8_STAGE(PG8_SB(1, 0), cB + kstep, voffB); PG8_STAGE(PG8_SA(1, 0), cA + kstep, voffA); PG8_STAGE(PG8_SB(1, 1), cB + hstep + kstep, voffB);
        PG8_WAIT_V(6); PG8_BAR;
    }
    for (;;) {
        const bool has_next = S.next(ui + 1, nxt);
        const char* nA = has_next ? (const char*)g.A + (size_t)nxt.pm * tstep : cA; const char* nB = has_next ? (const char*)g.Bt + (size_t)nxt.pn * tstep : cB;
        for (int t = 0; t < nt; t += 2) {
            const bool last = (t == nt - 2);
            const char* a1 = cA + (size_t)(t + 1) * kstep;
            const char* a2 = last ? nA : cA + (size_t)(t + 2) * kstep; const char* b2 = last ? nB : cB + (size_t)(t + 2) * kstep;
            const char* a3 = a2 + kstep; const char* b3 = b2 + kstep;
            if (last && has_next) S.a_ready(nxt);
            if constexpr (SP2) {
            PG8_LDB(B0, 0, 0); PG8_LDB(B1, 0, 1); PG8_SCHED; PG8_LDA(At, 0, 0); PG8_STAGE(PG8_SA(1, 1), a1 + hstep, voffA);
            PG8_WAIT_V(8); PG8_WAIT_L(0); PG8_BAR; PG8_MMA(0, 0, At, B0); PG8_MMA(0, 1, At, B1); PG8_BAR; PG8_SCHED;
            PG8_LDA(At, 0, 1); PG8_STAGE(PG8_SB(0, 0), b2, voffB); PG8_STAGE(PG8_SB(0, 1), b2 + hstep, voffB); PG8_STAGE(PG8_SA(0, 0), a2, voffA);
            PG8_WAIT_V(8); PG8_WAIT_L(0); PG8_BAR; PG8_MMA(1, 0, At, B0); PG8_MMA(1, 1, At, B1); PG8_BAR; PG8_SCHED;
            PG8_LDB(B0, 1, 0); PG8_LDB(B1, 1, 1); PG8_SCHED; PG8_LDA(At, 1, 0); PG8_STAGE(PG8_SA(0, 1), a2 + hstep, voffA);
            PG8_WAIT_V(8); PG8_WAIT_L(0); PG8_BAR; PG8_MMA(0, 0, At, B0); PG8_MMA(0, 1, At, B1); PG8_BAR; PG8_SCHED;
            PG8_LDA(At, 1, 1); PG8_STAGE(PG8_SB(1, 0), b3, voffB); PG8_STAGE(PG8_SB(1, 1), b3 + hstep, voffB); PG8_STAGE(PG8_SA(1, 0), a3, voffA);
            PG8_WAIT_V(8); PG8_WAIT_L(0); PG8_BAR; PG8_MMA(1, 0, At, B0); PG8_MMA(1, 1, At, B1); PG8_BAR; PG8_SCHED;
            } else {
            PG8_LDB(B0, 0, 0); PG8_SCHED; PG8_LDA(At, 0, 0); PG8_STAGE(PG8_SA(1, 1), a1 + hstep, voffA);
            PG8_WAIT_L(8); PG8_BAR; PG8_WAIT_L(0); PG8_MMA(0, 0, At, B0); PG8_BAR; PG8_SCHED;
            PG8_LDB(B1, 0, 1); PG8_STAGE(PG8_SB(0, 0), b2, voffB);
            PG8_BAR; PG8_WAIT_L(0); PG8_MMA(0, 1, At, B1); PG8_BAR;
            PG8_LDA(At, 0, 1); PG8_STAGE(PG8_SA(0, 0), a2, voffA);
            PG8_BAR; PG8_WAIT_L(0); PG8_MMA(1, 0, At, B0); PG8_BAR; PG8_SCHED;
            PG8_STAGE(PG8_SB(0, 1), b2 + hstep, voffB);
            PG8_WAIT_V(6); PG8_BAR; PG8_MMA(1, 1, At, B1); PG8_BAR;
            PG8_LDB(B0, 1, 0); PG8_SCHED; PG8_LDA(At, 1, 0); PG8_STAGE(PG8_SA(0, 1), a2 + hstep, voffA);
            PG8_WAIT_L(8); PG8_BAR; PG8_WAIT_L(0); PG8_MMA(0, 0, At, B0); PG8_BAR; PG8_SCHED;
            PG8_LDB(B1, 1, 1); PG8_STAGE(PG8_SB(1, 0), b3, voffB);
            PG8_BAR; PG8_WAIT_L(0); PG8_MMA(0, 1, At, B1); PG8_BAR;
            PG8_LDA(At, 1, 1); PG8_STAGE(PG8_SA(1, 0), a3, voffA);
            PG8_BAR; PG8_WAIT_L(0); PG8_MMA(1, 0, At, B0); PG8_BAR; PG8_SCHED;
            PG8_STAGE(PG8_SB(1, 1), b3 + hstep, voffB);
            PG8_WAIT_V(6); PG8_BAR; PG8_MMA(1, 1, At, B1); PG8_BAR;
            }
        }
        if constexpr (ALIGN_EPI) { if (wr == 0) PG8_BAR; }
        if constexpr (!Epi::AFTER_DRAIN) { E(acc, cur, wr, wc, fr, fq);
#ifdef PROBE_EPI2
            if constexpr (Epi::PROBE_ID == PROBE_EPI2) { asm volatile("" ::: "memory"); E(acc, cur, wr, wc, fr, fq); }
#endif
            S.done(cur); }
        if (!has_next) break;
#pragma unroll
        for (int a = 0; a < 2; ++a)
#pragma unroll
            for (int b = 0; b < 2; ++b)
#pragma unroll
                for (int m = 0; m < 4; ++m)
#pragma unroll
                    for (int n = 0; n < 2; ++n) acc[a][b][m][n] = (f32x4){0.f, 0.f, 0.f, 0.f};
        cur = nxt; cA = nA; cB = nB; ++ui;
        if constexpr (ALIGN_EPI) { if (wr == 1) PG8_BAR; }
    }
    PG8_WAIT_V(0);
    if constexpr (!ALIGN_EPI) { if (wr == 0) PG8_BAR; }
    PG8_BAR;
    if constexpr (Epi::AFTER_DRAIN) { E.fused(acc, cur, wr, wc, fr, fq, lds, wid, lane); S.done(cur); }
#undef PG8_SA
#undef PG8_SB
#undef PG8_STAGE
#undef PG8_LDA
#undef PG8_LDB
#undef PG8_MMA
#undef PG8_WAIT_V
#undef PG8_WAIT_L
#undef PG8_BAR
#undef PG8_SCHED
}
}
#ifndef PG8_SP2
#define PG8_SP2 true
#endif
#ifndef PG8_ALIGN
#define PG8_ALIGN true
#endif
#ifndef MK_COOP
#define MK_COOP 1
#endif

#define LAS __attribute__((address_space(3)))
typedef unsigned short bf16;
typedef unsigned v4u __attribute__((ext_vector_type(4)));
typedef unsigned v2u __attribute__((ext_vector_type(2)));
typedef float f32x4 __attribute__((ext_vector_type(4)));
typedef float f32x16 __attribute__((ext_vector_type(16)));
typedef short bf16x8 __attribute__((ext_vector_type(8)));
typedef short v4i16_t __attribute__((ext_vector_type(4)));
typedef float f32x2_t __attribute__((ext_vector_type(2)));
typedef __bf16 bf16x2_t __attribute__((ext_vector_type(2)));

constexpr int D = 1024, MP = 4096, MS = 32768, M = MP + MS, NIN = 3072, DFF = 2816, NFI = 2 * DFF;
constexpr int SEQ_P = 256, SEQ_S = 4096, PAST = 256, NB_S = 8, NB_P = 16;
constexpr int KV_PER_B = PAST + SEQ_S;
constexpr int KROWS = MP + NB_S * KV_PER_B;
constexpr float EPS = 1e-6f;
constexpr float QSCALE = 0.125f * 1.4426950408889634f;
constexpr int NWAVES = 8, NTHREADS = 512;

constexpr size_t MiB = 1u << 20;
constexpr size_t WS_MOD = 0;
constexpr size_t WS_ROT = 256 * 1024;
constexpr size_t WS_BAR = 512 * 1024, BAR_BYTES = 16384;
constexpr size_t WS_SS1 = 1 * MiB;
constexpr size_t WS_SS2 = 4 * MiB;
constexpr size_t WS_WIN = 8 * MiB, WS_WO = 14 * MiB, WS_WFI = 16 * MiB, WS_WFO = 27 * MiB;
constexpr size_t WS_U = 34 * MiB;
constexpr size_t WS_MIXO = 106 * MiB;
constexpr size_t WS_Q = 178 * MiB;
constexpr size_t WS_K = 214 * MiB;
constexpr size_t WS_V = 252 * MiB;
constexpr size_t WS_MIX = 290 * MiB;
constexpr size_t WS_BG = 362 * MiB;
constexpr size_t WS_Z = 398 * MiB;
constexpr size_t WS_H = 178 * MiB;
constexpr size_t WS_END = 434 * MiB;
static_assert(WS_H + (size_t)M * DFF * 2 <= WS_Z, "H overlay");
static_assert(WS_K + (size_t)KROWS * 512 * 2 <= WS_V && WS_V + (size_t)KROWS * 512 * 2 <= WS_MIX, "kv map");

constexpr int MISC_OFF = 131072 + 1024;
constexpr int LDS_BYTES = 131072 + 2048;

__device__ __forceinline__ unsigned pk2(float lo, float hi) { f32x2_t v = {lo, hi}; bf16x2_t b = __builtin_convertvector(v, bf16x2_t); return __builtin_bit_cast(unsigned, b); }
__device__ __forceinline__ float bf2f(unsigned short b) { return __uint_as_float((unsigned)b << 16); }
__device__ __forceinline__ float wave_sum(float v) {
#pragma unroll
    for (int o = 1; o < 64; o <<= 1) v += __shfl_xor(v, o);
    return v;
}
__device__ __forceinline__ int krow_of(int r) { return r < MP ? r : MP + ((r - MP) >> 12) * KV_PER_B + PAST + ((r - MP) & 4095); }

#define XB_TMO      128
#define XB_XCNT(j)  (256  + 64 * (j))
#define XB_XSUB(j)  (1280 + 64 * (j))
#define XB_XGEN(j)  (2304 + 64 * (j))
#define XB_TOP      3328
#define XB_TOPGEN   3392
#define XCD_BAR_WORDS 3456
#define XB_SPIN_CAP (1u << 18)

__device__ __forceinline__ unsigned xb_ld(unsigned* p)              { return __hip_atomic_load(p, __ATOMIC_RELAXED, __HIP_MEMORY_SCOPE_AGENT); }
__device__ __forceinline__ unsigned xb_add(unsigned* p, unsigned v) { return __hip_atomic_fetch_add(p, v, __ATOMIC_RELAXED, __HIP_MEMORY_SCOPE_AGENT); }
__device__ __forceinline__ unsigned xb_xcc_id() { return (unsigned)__builtin_amdgcn_s_getreg((3 << 11) | 20) & 0xFu; }
#define XB_SPIN(cond, bar) do { unsigned _sp = 0; while (cond) { __builtin_amdgcn_s_sleep(1); \
    if ((++_sp & 255u) == 0u) { if (xb_ld(&(bar)[XB_TMO])) break; if (_sp > XB_SPIN_CAP) { atomicAdd(&(bar)[XB_TMO], 1u); break; } } } } while (0)

struct XcdBarrier {
    unsigned* bar; unsigned x;
    volatile LAS unsigned* st;
};

__device__ __forceinline__ XcdBarrier xcd_barrier_post(unsigned* bar, volatile LAS unsigned* st) {
    XcdBarrier b; b.bar = bar; b.x = xb_xcc_id(); b.st = st;
    if (threadIdx.x == 0) (void)xb_add(&bar[XB_XCNT(b.x)], 1u);
    return b;
}
__device__ __forceinline__ void xcd_barrier_complete(unsigned* bar, unsigned x, unsigned& nloc, unsigned& nx) {
    const unsigned G = gridDim.x * gridDim.y * gridDim.z;
    unsigned sum, cnt, mine, sp = 0u;
    for (;;) {
        sum = 0u; cnt = 0u; mine = 0u;
#pragma unroll
        for (unsigned j = 0; j < 16; ++j) { const unsigned c = xb_ld(&bar[XB_XCNT(j)]); sum += c; cnt += (c > 0u) ? 1u : 0u; mine = (j == x) ? c : mine; }
        if (sum == G) break;
        __builtin_amdgcn_s_sleep(1);
        if ((++sp & 255u) == 0u) { if (xb_ld(&bar[XB_TMO])) break; if (sp > XB_SPIN_CAP) { atomicAdd(&bar[XB_TMO], 1u); break; } }
    }
    nloc = mine > 0u ? mine : 1u; nx = cnt > 0u ? cnt : 1u;
}

__device__ __forceinline__ void xcd_barrier(const XcdBarrier& b) {
    asm volatile("s_waitcnt vmcnt(0)" ::: "memory");
    __syncthreads();
    if (threadIdx.x == 0) {
        unsigned* bar = b.bar;
        __builtin_amdgcn_s_waitcnt(0);
        unsigned nloc = b.st[0], nx = b.st[1];
        if (nloc == 0u) { xcd_barrier_complete(bar, b.x, nloc, nx); b.st[0] = nloc; b.st[1] = nx; }
        const unsigned old = xb_add(&bar[XB_XSUB(b.x)], 1u);
        const unsigned gen = old / nloc;
        if (old + 1u == (gen + 1u) * nloc) {
            __builtin_amdgcn_fence(__ATOMIC_RELEASE, "agent");
            asm volatile("s_waitcnt vmcnt(0)" ::: "memory");
            const unsigned og = xb_add(&bar[XB_TOP], 1u);
            const unsigned tg = og / nx;
            if (og + 1u == (tg + 1u) * nx) xb_add(&bar[XB_TOPGEN], 1u);
            else XB_SPIN(xb_ld(&bar[XB_TOPGEN]) == tg, bar);
            __builtin_amdgcn_fence(__ATOMIC_ACQUIRE, "agent");
            xb_add(&bar[XB_XGEN(b.x)], 1u);
            asm volatile("s_waitcnt vmcnt(0)" ::: "memory");
        } else {
            XB_SPIN(xb_ld(&bar[XB_XGEN(b.x)]) == gen, bar);
            __builtin_amdgcn_fence(__ATOMIC_ACQUIRE, "agent");
            asm volatile("s_waitcnt vmcnt(0)" ::: "memory");
        }
    }
    __syncthreads();
}

namespace pg8 {
struct EpiIn {
    static constexpr bool PERM = true, AFTER_DRAIN = false; static constexpr int PROBE_ID = 1;
    bf16_t *Q, *Kb, *Vb, *BG, *Z; float *stK, *stV; const float* rot;
    __device__ __forceinline__ void operator()(const f32x4 (&acc)[2][2][4][2], const Unit& u, int wr, int wc, int fr, int fq) const {
        const int pn = u.pn; const bool sample = u.pm >= (MP / 256);
        const int rbase = u.pm * BM + wr * 64 + fr;
        const int cp = wc * 32 + 8 * fq;
        if (pn < 4) {
            const bool isq = pn < 2; const int cbp = (pn & 1) * 256 + cp, cbl = (pn & 1) * 256 + wc * 32 + 4 * fq;
            const float qs = isq ? QSCALE : 1.0f;
#pragma unroll
            for (int ai = 0; ai < 2; ++ai)
#pragma unroll
                for (int m = 0; m < 4; ++m) {
                    const int r = rbase + ai * HALF + m * 16;
                    f32x4 cs = (f32x4){1.f, 1.f, 1.f, 1.f}, sn = (f32x4){0.f, 0.f, 0.f, 0.f};
                    if (sample) { const int t = (r - MP) & 4095; const int pos = (wc & 1) ? (t & 63) : (t >> 6);
                        cs = *(const f32x4*)(rot + pos * 16 + 4 * fq); sn = *(const f32x4*)(rot + 1024 + pos * 16 + 4 * fq); }
                    cs = cs * qs; sn = sn * qs;
                    const size_t kr = (size_t)krow_of(r);
#pragma unroll
                    for (int bj = 0; bj < 2; ++bj) {
                        const f32x4 x1 = acc[ai][bj][m][0], x2 = acc[ai][bj][m][1];
                        const f32x4 o1 = x1 * cs - x2 * sn, o2 = x2 * cs + x1 * sn;
                        u32x4 w; w.x = pk2(o1[0], o1[1]); w.y = pk2(o1[2], o1[3]); w.z = pk2(o2[0], o2[1]); w.w = pk2(o2[2], o2[3]);
                        if (isq) *(u32x4*)(Q + (size_t)r * 512 + cbp + bj * HALF) = w;
                        else { *(u32x4*)(Kb + kr * 512 + cbp + bj * HALF) = w;
                            if (!sample) { float* s = stK + (size_t)r * 512 + cbl + bj * HALF; *(f32x4*)s = x1; *(f32x4*)(s + 16) = x2; } }
                    }
                }
        } else if (pn < 8) {
            const bool isv = pn < 6; const int cb = (pn & 1) * 256 + cp;
#pragma unroll
            for (int ai = 0; ai < 2; ++ai)
#pragma unroll
                for (int m = 0; m < 4; ++m) {
                    const int r = rbase + ai * HALF + m * 16;
                    const size_t orow = isv ? (size_t)krow_of(r) : (size_t)r;
                    bf16_t* base = (isv ? Vb : BG) + orow * 512 + cb;
#pragma unroll
                    for (int bj = 0; bj < 2; ++bj) {
                        const f32x4 x1 = acc[ai][bj][m][0], x2 = acc[ai][bj][m][1];
                        u32x4 w; w.x = pk2(x1[0], x1[1]); w.y = pk2(x1[2], x1[3]); w.z = pk2(x2[0], x2[1]); w.w = pk2(x2[2], x2[3]);
                        *(u32x4*)(base + bj * HALF) = w;
                        if (isv && !sample) { float* s = stV + (size_t)r * 512 + cb + bj * HALF; *(f32x4*)s = x1; *(f32x4*)(s + 4) = x2; }
                    }
                }
        } else {
            const int cb = (pn - 8) * 128 + cp;
#pragma unroll
            for (int ai = 0; ai < 2; ++ai)
#pragma unroll
                for (int m = 0; m < 4; ++m) {
                    const int r = rbase + ai * HALF + m * 16;
                    const f32x4 z1 = acc[ai][0][m][0] * acc[ai][1][m][0], z2 = acc[ai][0][m][1] * acc[ai][1][m][1];
                    u32x4 w; w.x = pk2(z1[0], z1[1]); w.y = pk2(z1[2], z1[3]); w.z = pk2(z2[0], z2[1]); w.w = pk2(z2[2], z2[3]);
                    *(u32x4*)(Z + (size_t)r * 512 + cb) = w;
                }
        }
    }
};
struct EpiSS {
    static constexpr bool PERM = true, AFTER_DRAIN = false; static constexpr int PROBE_ID = 2;
    bf16_t* O; float* SS;
    __device__ __forceinline__ void operator()(const f32x4 (&acc)[2][2][4][2], const Unit& u, int wr, int wc, int fr, int fq) const {
        const int rbase = u.pm * BM + wr * 64 + fr; const int c0 = u.pn * BM + wc * 32 + 8 * fq;
#pragma unroll
        for (int ai = 0; ai < 2; ++ai)
#pragma unroll
            for (int m = 0; m < 4; ++m) {
                const int r = rbase + ai * HALF + m * 16; float s = 0.f;
#pragma unroll
                for (int bj = 0; bj < 2; ++bj) {
                    const f32x4 v0 = acc[ai][bj][m][0], v1 = acc[ai][bj][m][1];
                    s += (v0[0] * v0[0] + v0[1] * v0[1]) + (v0[2] * v0[2] + v0[3] * v0[3]) + (v1[0] * v1[0] + v1[1] * v1[1]) + (v1[2] * v1[2] + v1[3] * v1[3]);
                    u32x4 w; w.x = pk2(v0[0], v0[1]); w.y = pk2(v0[2], v0[3]); w.z = pk2(v1[0], v1[1]); w.w = pk2(v1[2], v1[3]);
                    *(u32x4*)(O + (size_t)r * D + c0 + bj * HALF) = w;
                }
                s += __shfl_xor(s, 16); s += __shfl_xor(s, 32);
                if (fq == 0) SS[(size_t)r * 16 + u.pn * 4 + wc] = s;
            }
    }
};
struct EpiGlu {
    static constexpr bool PERM = true, AFTER_DRAIN = false; static constexpr int PROBE_ID = 3;
    bf16_t* H;
    __device__ __forceinline__ void operator()(const f32x4 (&acc)[2][2][4][2], const Unit& u, int wr, int wc, int fr, int fq) const {
        const int rbase = u.pm * BM + wr * 64 + fr; const int c0 = u.pn * HALF + wc * 32 + 8 * fq;
#pragma unroll
        for (int ai = 0; ai < 2; ++ai)
#pragma unroll
            for (int m = 0; m < 4; ++m) {
                const int r = rbase + ai * HALF + m * 16; f32x4 hv[2];
#pragma unroll
                for (int n = 0; n < 2; ++n) { const f32x4 g = acc[ai][0][m][n], up = acc[ai][1][m][n];
                    f32x4 e; e[0] = __builtin_amdgcn_exp2f(g[0]); e[1] = __builtin_amdgcn_exp2f(g[1]); e[2] = __builtin_amdgcn_exp2f(g[2]); e[3] = __builtin_amdgcn_exp2f(g[3]);
                    const f32x4 d = e + 1.0f;
                    f32x4 rc; rc[0] = __builtin_amdgcn_rcpf(d[0]); rc[1] = __builtin_amdgcn_rcpf(d[1]); rc[2] = __builtin_amdgcn_rcpf(d[2]); rc[3] = __builtin_amdgcn_rcpf(d[3]);
                    hv[n] = (g * up) * rc; }
                u32x4 w; w.x = pk2(hv[0][0], hv[0][1]); w.y = pk2(hv[0][2], hv[0][3]); w.z = pk2(hv[1][0], hv[1][1]); w.w = pk2(hv[1][2], hv[1][3]);
                *(u32x4*)(H + (size_t)r * DFF + c0) = w;
            }
    }
};
}

namespace att {
constexpr int TILEB = 16384, NSLOT = 3, VRING = NSLOT * TILEB, WSF_OFF = 2 * NSLOT * TILEB, LDS_NEED = WSF_OFF + NWAVES * 256;
static_assert(LDS_NEED <= 131072 && 4 * 32 * 128 * 4 <= WSF_OFF, "attention LDS");
constexpr float THR = 8.f;
__device__ __forceinline__ int crow(int r, int hi) { return (r & 3) + 8 * (r >> 2) + 4 * hi; }
__device__ __forceinline__ bf16x8 vfrag(const LAS char* p0, const LAS char* p1) {
    const v4i16_t lo = __builtin_amdgcn_ds_read_tr16_b64_v4i16((LAS v4i16_t*)p0), hi = __builtin_amdgcn_ds_read_tr16_b64_v4i16((LAS v4i16_t*)p1);
    return (bf16x8){lo[0], lo[1], lo[2], lo[3], hi[0], hi[1], hi[2], hi[3]};
}
__device__ __forceinline__ void glds16(const void* gsrc, unsigned lds_dst) { unsigned keep;
    asm volatile("s_mov_b32 %0, m0\n\ts_mov_b32 m0, %2\n\ts_nop 0\n\tglobal_load_lds_dwordx4 %1, off\n\ts_mov_b32 m0, %0" : "=&s"(keep) : "v"(gsrc), "s"(lds_dst) : "memory"); }
__device__ __forceinline__ void glds16s(const void* sbase, unsigned voff, unsigned lds_dst) { unsigned keep;
    asm volatile("s_mov_b32 %0, m0\n\ts_mov_b32 m0, %3\n\ts_nop 0\n\tglobal_load_lds_dwordx4 %1, %2\n\ts_mov_b32 m0, %0" : "=&s"(keep) : "v"(voff), "s"(sbase), "s"(lds_dst) : "memory"); }
__device__ __forceinline__ float swapmax(float m) { auto rr = __builtin_amdgcn_permlane32_swap(__float_as_uint(m), __float_as_uint(m), false, false); return fmaxf(__uint_as_float(rr[0]), __uint_as_float(rr[1])); }
#define ATT_WAIT_BAR(N) asm volatile("s_waitcnt vmcnt(" #N ") lgkmcnt(0)\n\ts_barrier" ::: "memory")
#define ATT_SB() __builtin_amdgcn_sched_barrier(0)
struct AttnCtx {
    LAS char* lds; LAS float* wsf; const char* kg; const char* vg; unsigned soff[2]; unsigned lds0; int ka[4]; int va[2][4]; int r32, hi, NT;
};
__device__ __forceinline__ float max3f(float a, float b, float c) { return fmaxf(fmaxf(a, b), c); }
template <bool LAST, int S0, bool DOMAX>
__device__ __forceinline__ void attn_step(const AttnCtx& C, int t, f32x16& P0, f32x16& P1, f32x16& N0, f32x16& N1, f32x16 (&o)[4], f32x16& negm, const bf16x8 (&qr)[4], float& mhat, float& l, float& rm) {
    constexpr int s0 = S0, s1 = (S0 + 1) % 3, s2 = (S0 + 2) % 3;
    const bool ik = (t + 3 < C.NT), iv = (t + 2 < C.NT);
    const LAS char* kb = C.lds + s1 * TILEB; const LAS char* vb = C.lds + s0 * TILEB;
    bf16x8 kf[8], vf[16];
#define ATT_KF(i) (*(const LAS bf16x8*)(kb + C.ka[(i) >> 1] + ((i) & 1) * 8192))
#define ATT_VF(n) vfrag(vb + C.va[0][(n) & 3] + ((n) >> 2) * 4096, vb + C.va[1][(n) & 3] + ((n) >> 2) * 4096)
    if (!LAST) { kf[0] = ATT_KF(0); kf[1] = ATT_KF(1); }
#ifdef PROBE_DMA2
    if (ik) { const char* p_ = C.kg + (size_t)(t + 3) * 65536; const unsigned d_ = (unsigned)__builtin_amdgcn_readfirstlane(C.lds0 + s0 * TILEB); glds16(p_ + C.soff[0], d_); glds16(p_ + C.soff[1], d_ + 1024); glds16(p_ + C.soff[0], d_); glds16(p_ + C.soff[1], d_ + 1024); }
    if (iv) { const char* p_ = C.vg + (size_t)(t + 2) * 65536; const unsigned d_ = (unsigned)__builtin_amdgcn_readfirstlane(C.lds0 + VRING + s2 * TILEB); glds16(p_ + C.soff[0], d_); glds16(p_ + C.soff[1], d_ + 1024); glds16(p_ + C.soff[0], d_); glds16(p_ + C.soff[1], d_ + 1024); }
#else
    if (ik) { const char* p_ = C.kg + (size_t)(t + 3) * 65536; const unsigned d_ = (unsigned)__builtin_amdgcn_readfirstlane(C.lds0 + s0 * TILEB); glds16s(p_, C.soff[0], d_); glds16s(p_, C.soff[1], d_ + 1024); }
    if (iv) { const char* p_ = C.vg + (size_t)(t + 2) * 65536; const unsigned d_ = (unsigned)__builtin_amdgcn_readfirstlane(C.lds0 + VRING + s2 * TILEB); glds16s(p_, C.soff[0], d_); glds16s(p_, C.soff[1], d_ + 1024); }
#endif
    ATT_SB();
    if (__any(rm > THR)) {
        const float dl = fmaxf(rm, 0.f);
        mhat += dl;
#pragma unroll
        for (int r = 0; r < 16; ++r) { P0[r] -= dl; P1[r] -= dl; negm[r] = -mhat; }
        const float f = __builtin_amdgcn_exp2f(-dl); l *= f;
        C.wsf[C.r32] = f;
#pragma unroll
        for (int r = 0; r < 16; ++r) { const float fr_ = C.wsf[crow(r, C.hi)];
#pragma unroll
            for (int db = 0; db < 4; ++db) o[db][r] *= fr_; }
    }
    ATT_SB();
    float ls = 0.f; v4u pwu[4]; float rn = -INFINITY;
#define ATT_SOFT(g) do { _Pragma("unroll") for (int e_ = ((g) < 4 ? 0 : 2 * ((g) - 4)); e_ < ((g) < 4 ? 0 : (2 * ((g) - 3) < 32 ? 2 * ((g) - 3) : 32)); ++e_) { \
        float x_; if (e_ < 16) { x_ = __builtin_amdgcn_exp2f(P0[e_ & 15]); P0[e_ & 15] = x_; } else { x_ = __builtin_amdgcn_exp2f(P1[e_ & 15]); P1[e_ & 15] = x_; } \
        ls += x_; \
        if (e_ & 1) { unsigned w_ = pk2(e_ < 16 ? P0[(e_ - 1) & 15] : P1[(e_ - 1) & 15], x_); asm volatile("" : "+v"(w_)); pwu[e_ >> 3][(e_ >> 1) & 3] = w_; } } \
        asm volatile("" : "+v"(ls)); \
        if (DOMAX && (g) >= 20) { _Pragma("unroll") for (int k_ = 4 * ((g) - 20); k_ < 4 * ((g) - 20) + 4; ++k_) rn = max3f(rn, N0[k_ & 15], N1[k_ & 15]); asm volatile("" : "+v"(rn)); } } while (0)
#pragma unroll
    for (int i = 0; i < 8; ++i) {
        if (!LAST) {
            if (i == 0)      N0 = __builtin_amdgcn_mfma_f32_32x32x16_bf16(kf[i], qr[i >> 1], negm, 0, 0, 0);
            else if (i == 1) N1 = __builtin_amdgcn_mfma_f32_32x32x16_bf16(kf[i], qr[i >> 1], negm, 0, 0, 0);
            else if (i & 1)  N1 = __builtin_amdgcn_mfma_f32_32x32x16_bf16(kf[i], qr[i >> 1], N1, 0, 0, 0);
            else             N0 = __builtin_amdgcn_mfma_f32_32x32x16_bf16(kf[i], qr[i >> 1], N0, 0, 0, 0);
            if (i < 6) kf[i + 2] = ATT_KF(i + 2);
        }
        if (i >= 6) vf[i - 6] = ATT_VF(i - 6);
        ATT_SOFT(i);
        ATT_SB();
    }
#pragma unroll
    for (int j = 0; j < 8; ++j) {
        o[j & 3] = __builtin_amdgcn_mfma_f32_32x32x16_bf16(__builtin_bit_cast(bf16x8, pwu[j >> 2]), vf[j], o[j & 3], 0, 0, 0);
        vf[j + 2] = ATT_VF(j + 2);
        ATT_SOFT(8 + j);
        ATT_SB();
    }
#pragma unroll
    for (int j = 0; j < 8; ++j) {
        o[j & 3] = __builtin_amdgcn_mfma_f32_32x32x16_bf16(__builtin_bit_cast(bf16x8, pwu[2 + (j >> 2)]), vf[8 + j], o[j & 3], 0, 0, 0);
        if (j < 6) vf[8 + j + 2] = ATT_VF(8 + j + 2);
        ATT_SOFT(16 + j);
        ATT_SB();
    }
#undef ATT_SOFT
#undef ATT_KF
#undef ATT_VF
    l += ls;
    if (DOMAX) rm = swapmax(rn); else rm = 0.f;
#ifdef PROBE_DMA2
    if (ik) ATT_WAIT_BAR(8); else if (iv) ATT_WAIT_BAR(4); else ATT_WAIT_BAR(0);
#else
    if (ik) ATT_WAIT_BAR(4); else if (iv) ATT_WAIT_BAR(2); else ATT_WAIT_BAR(0);
#endif
}
__device__ __forceinline__ void attn_unit(LAS char* lds, const bf16* Q, const bf16* Kb, const bf16* Vb, bf16* MIX, int qrow0, int krow0, int NT, int h, float lam, const float* gsub) {
    const int tid = threadIdx.x, lane = tid & 63, r32 = lane & 31, hi = lane >> 5; const int wid = __builtin_amdgcn_readfirstlane(tid >> 6), qg = wid & 3, map = wid >> 2;
    AttnCtx C; C.lds = lds; C.r32 = r32; C.hi = hi; C.NT = NT;
    C.kg = (const char*)Kb + ((size_t)krow0 * 512 + h * 128) * 2;
    C.vg = (const char*)Vb + ((size_t)krow0 * 512 + h * 128) * 2;
    C.wsf = (LAS float*)(lds + WSF_OFF) + wid * 64;
    LAS float* wsf = C.wsf;
#pragma unroll
    for (int j = 0; j < 2; ++j) { const int row = 8 * wid + 4 * j + (lane >> 4); const int sw = (((lane >> 4) & 3) << 2) | ((2 * wid + j) & 3); C.soff[j] = (unsigned)(row * 1024 + (((lane & 15) ^ sw) * 16)); }
    C.lds0 = (unsigned)(uintptr_t)lds + (unsigned)wid * 2048u;
#define ATT_DMAK(t, slot) do { const char* p_ = C.kg + (size_t)(t) * 65536; const unsigned d_ = (unsigned)__builtin_amdgcn_readfirstlane(C.lds0 + (slot) * TILEB); glds16(p_ + C.soff[0], d_); glds16(p_ + C.soff[1], d_ + 1024); } while (0)
#define ATT_DMAV(t, slot) do { const char* p_ = C.vg + (size_t)(t) * 65536; const unsigned d_ = (unsigned)__builtin_amdgcn_readfirstlane(C.lds0 + VRING + (slot) * TILEB); glds16(p_ + C.soff[0], d_); glds16(p_ + C.soff[1], d_ + 1024); } while (0)
    asm volatile("s_waitcnt vmcnt(0)" ::: "memory");
    ATT_DMAK(0, 0); ATT_DMAV(0, 0); ATT_DMAK(1, 1); ATT_DMAV(1, 1);
    if (NT > 2) ATT_DMAK(2, 2);
#undef ATT_DMAK
#undef ATT_DMAV
    bf16x8 qr[4];
    { const bf16* qp = Q + (size_t)(qrow0 + 32 * qg + r32) * 512 + h * 128 + map * 64 + hi * 8;
#pragma unroll
      for (int ds = 0; ds < 4; ++ds) qr[ds] = *(const bf16x8*)(qp + ds * 16); }
    { const int swk = ((r32 & 3) << 2) | ((r32 >> 2) & 3);
#pragma unroll
      for (int ds = 0; ds < 4; ++ds) C.ka[ds] = 256 * r32 + 16 * ((8 * map + 2 * ds + hi) ^ swk);
      const int q = (lane & 15) >> 2, p = lane & 3, blk = (lane >> 4) & 1;
#pragma unroll
      for (int hh = 0; hh < 2; ++hh)
#pragma unroll
          for (int db = 0; db < 4; ++db) { const int row = 4 * hi + q + 8 * hh; const int sw = (q << 2) | ((hi + 2 * hh) & 3); C.va[hh][db] = VRING + 256 * row + 16 * ((4 * db + 2 * blk + (p >> 1)) ^ sw) + 8 * (p & 1); } }
    f32x16 o[4];
#pragma unroll
    for (int i = 0; i < 4; ++i) o[i] = (f32x16){};
    float mhat = 0.f, l = 0.f, rm; f32x16 negm;
    ATT_WAIT_BAR(0);
    f32x16 pA0 = (f32x16){}, pA1 = (f32x16){}, pB0, pB1;
    {
#pragma unroll
        for (int ds = 0; ds < 4; ++ds) {
            const bf16x8 a0 = *(const LAS bf16x8*)(lds + C.ka[ds]), a1 = *(const LAS bf16x8*)(lds + C.ka[ds] + 8192);
            pA0 = __builtin_amdgcn_mfma_f32_32x32x16_bf16(a0, qr[ds], pA0, 0, 0, 0);
            pA1 = __builtin_amdgcn_mfma_f32_32x32x16_bf16(a1, qr[ds], pA1, 0, 0, 0);
        }
        float m0 = fmaxf(pA0[0], pA1[0]);
#pragma unroll
        for (int r = 1; r < 16; ++r) m0 = fmaxf(m0, fmaxf(pA0[r], pA1[r]));
        mhat = swapmax(m0); rm = 0.f;
#pragma unroll
        for (int r = 0; r < 16; ++r) { pA0[r] -= mhat; pA1[r] -= mhat; negm[r] = -mhat; }
    }
    asm volatile("s_waitcnt lgkmcnt(0)\n\ts_barrier" ::: "memory");
    static_assert((KV_PER_B / 64) % 6 == 2 && SEQ_P / 64 == 4, "attention step remainder");
#define ATT_STEP_AB(LASTF, SLOT, tt) attn_step<LASTF, SLOT, false>(C, (tt), pA0, pA1, pB0, pB1, o, negm, qr, mhat, l, rm)
#define ATT_STEP_BA(LASTF, SLOT, tt) attn_step<LASTF, SLOT, !(LASTF)>(C, (tt), pB0, pB1, pA0, pA1, o, negm, qr, mhat, l, rm)
    int t = 0;
    for (; t + 6 < NT; t += 6) {
        ATT_STEP_AB(false, 0, t); ATT_STEP_BA(false, 1, t + 1); ATT_STEP_AB(false, 2, t + 2);
        ATT_STEP_BA(false, 0, t + 3); ATT_STEP_AB(false, 1, t + 4); ATT_STEP_BA(false, 2, t + 5);
    }
    ATT_STEP_AB(false, 0, t);
    if (NT - t == 2) { ATT_STEP_BA(true, 1, t + 1); }
    else { ATT_STEP_BA(false, 1, t + 1); ATT_STEP_AB(false, 2, t + 2); ATT_STEP_BA(true, 0, t + 3); }
#undef ATT_STEP_AB
#undef ATT_STEP_BA
    l += __shfl_xor(l, 32);
    wsf[32 + r32] = l;
    float rl[16];
#pragma unroll
    for (int r = 0; r < 16; ++r) rl[r] = 1.0f / wsf[32 + crow(r, hi)];
    LAS float* X = (LAS float*)lds + qg * 4096;
    if (map == 1) {
#pragma unroll
        for (int r = 0; r < 16; ++r)
#pragma unroll
            for (int db = 0; db < 4; ++db) X[crow(r, hi) * 128 + db * 32 + r32] = o[db][r] * rl[r];
    }
    __syncthreads();
    if (map == 0) {
        float gs[4];
#pragma unroll
        for (int db = 0; db < 4; ++db) gs[db] = gsub[db * 32 + r32] * 0.8f;
#pragma unroll
        for (int r = 0; r < 16; ++r) {
            float ss = 0.f;
#pragma unroll
            for (int db = 0; db < 4; ++db) { const float v = o[db][r] * rl[r] - lam * X[crow(r, hi) * 128 + db * 32 + r32]; o[db][r] = v; ss += v * v; }
#pragma unroll
            for (int of = 1; of < 32; of <<= 1) ss += __shfl_xor(ss, of);
            const float rs = __builtin_amdgcn_rsqf(ss * (1.0f / 128.0f) + EPS);
            bf16* op = MIX + (size_t)(qrow0 + 32 * qg + crow(r, hi)) * D + h * 128 + r32;
#pragma unroll
            for (int db = 0; db < 4; ++db) op[db * 32] = (bf16)(pk2(o[db][r] * rs * gs[db], 0.f) & 0xffffu);
        }
    }
    __syncthreads();
}
}

struct Args { const float* in[23]; float* out; unsigned char* ws; int ph_lo, ph_hi; };
enum { I_XP = 0, I_XS, I_CK, I_CV, I_C, I_CCTX, I_WADA, I_BADA, I_GAPRE, I_GAPOST, I_GFPRE, I_GFPOST, I_WIN, I_CONVW, I_CONVB, I_LQ1, I_LK1, I_LQ2, I_LK2, I_GSUB, I_WOUT, I_WFI, I_WFO };
constexpr int N_PHASES = 9;

#define mod ((float*)(args.ws + WS_MOD))
#define rot ((float*)(args.ws + WS_ROT))
#define SS1 ((float*)(args.ws + WS_SS1))
#define SS2 ((float*)(args.ws + WS_SS2))
#define WinT ((bf16*)(args.ws + WS_WIN))
#define WoT ((bf16*)(args.ws + WS_WO))
#define WfiT ((bf16*)(args.ws + WS_WFI))
#define WfoT ((bf16*)(args.ws + WS_WFO))
#define U ((bf16*)(args.ws + WS_U))
#define MIXO ((bf16*)(args.ws + WS_MIXO))
#define Qb ((bf16*)(args.ws + WS_Q))
#define Kb ((bf16*)(args.ws + WS_K))
#define Vb ((bf16*)(args.ws + WS_V))
#define MIX ((bf16*)(args.ws + WS_MIX))
#define BG ((bf16*)(args.ws + WS_BG))
#define Z ((bf16*)(args.ws + WS_Z))
#define H ((bf16*)(args.ws + WS_H))
#define xp (args.in[I_XP])
#define xs (args.in[I_XS])
#define Y (args.out)
#define stK (args.out + (size_t)M * D)
#define stV (args.out + (size_t)M * D + (size_t)MP * 512)

namespace pg8 {
struct PanelOrder {
    int G, c, lo, hi;
    __device__ __forceinline__ bool next(int i, Unit& u) const { const int L = lo + i * G + c; if (L >= hi) return false; const int xcd = L & 7, w = L >> 3; u.pm = 18 * xcd + (w >> 2); u.pn = w & 3; return true; }
    __device__ __forceinline__ void a_ready(const Unit&) const {}
    __device__ __forceinline__ void done(const Unit&) const {}
};
}
__device__ __forceinline__ int rowmap(int e, bool late) { const int p = e >> 8; const int pm = late ? 18 * (p >> 1) + 16 + (p & 1) : 18 * (p >> 4) + (p & 15); return pm * 256 + (e & 255); }
__device__ __forceinline__ void tail_arrive(unsigned* cnt) {
    asm volatile("s_waitcnt vmcnt(0)" ::: "memory");
    __syncthreads();
    if (threadIdx.x == 0) {
        __builtin_amdgcn_fence(__ATOMIC_RELEASE, "agent");
        asm volatile("s_waitcnt vmcnt(0)" ::: "memory");
        (void)xb_add(cnt, 1u);
    }
}
__device__ __forceinline__ void tail_wait(unsigned* cnt, unsigned expect) {
    if (threadIdx.x == 0) {
        unsigned sp = 0u;
        while (xb_ld(cnt) < expect) { __builtin_amdgcn_s_sleep(1); if (++sp > (1u << 20)) break; }
        __builtin_amdgcn_fence(__ATOMIC_ACQUIRE, "agent");
        asm volatile("s_waitcnt vmcnt(0)" ::: "memory");
    }
    __syncthreads();
}
__device__ __forceinline__ void free_share(int f, int& e0, int& en) { if (f < 128) { e0 = f * 171; en = 171; } else { e0 = 128 * 171 + (f - 128) * 170; en = 170; } }
__device__ __forceinline__ void early_share(int bx, int na, int nb, int& e0, int& en) { if (bx < 64) { e0 = bx * nb; en = nb; } else { e0 = 64 * nb + (bx - 64) * na; en = na; } }
__device__ __forceinline__ void p5_rows(const Args& args, int e0, int en, bool late, int wave, int lane) {
        const float* gpo = args.in[I_GAPOST]; const float* gfp = args.in[I_GFPRE];
        for (int i0 = wave; i0 < en; i0 += 8 * 2) {
            f32x4 v[2][4]; v2u mo[2][4]; float ssp[2];
#pragma unroll
            for (int q = 0; q < 2; ++q) { const int idx = i0 + 8 * q; const int r = rowmap(e0 + idx, late); ssp[q] = 0.f;
                if (idx < en) { const float* xr = r < MP ? xp + (size_t)r * D : xs + (size_t)(r - MP) * D;
                    ssp[q] = SS1[(size_t)r * 16 + (lane & 15)];
#pragma unroll
                    for (int j = 0; j < 4; ++j) { v[q][j] = __builtin_nontemporal_load((const f32x4*)(xr + 4 * lane + 256 * j)); mo[q][j] = *(const v2u*)(MIXO + (size_t)r * D + 4 * lane + 256 * j); } } }
#pragma unroll
            for (int q = 0; q < 2; ++q) { const int idx = i0 + 8 * q; const int r = rowmap(e0 + idx, late);
                if (idx < en) {
                    const float* mp = mod + (r < MP ? 0 : 1 + ((r - MP) >> 12)) * 6144;
                    float sp = ssp[q]; sp += __shfl_xor(sp, 1); sp += __shfl_xor(sp, 2); sp += __shfl_xor(sp, 4); sp += __shfl_xor(sp, 8);
                    const float rstd1 = __builtin_amdgcn_rsqf(sp * (1.f / D) + EPS); float s = 0.f;
#pragma unroll
                    for (int j = 0; j < 4; ++j) { const int c = 4 * lane + 256 * j;
                        const f32x4 mf = (f32x4){__uint_as_float(mo[q][j][0] << 16), __uint_as_float(mo[q][j][0] & 0xffff0000u), __uint_as_float(mo[q][j][1] << 16), __uint_as_float(mo[q][j][1] & 0xffff0000u)};
                        const f32x4 gg = *(const f32x4*)(gpo + c), ga = *(const f32x4*)(mp + 2048 + c);
                        v[q][j] = v[q][j] + ga * (mf * rstd1 * gg);
                        s += (v[q][j][0] * v[q][j][0] + v[q][j][1] * v[q][j][1]) + (v[q][j][2] * v[q][j][2] + v[q][j][3] * v[q][j][3]); }
                    const float rstd = __builtin_amdgcn_rsqf(wave_sum(s) * (1.f / D) + EPS);
#pragma unroll
                    for (int j = 0; j < 4; ++j) { const int c = 4 * lane + 256 * j; const f32x4 gg = *(const f32x4*)(gfp + c), sh = *(const f32x4*)(mp + 3072 + c), sc = *(const f32x4*)(mp + 4096 + c);
                        const f32x4 u = v[q][j] * rstd * gg * (sc + 1.f) + sh;
                        *(v2u*)(U + (size_t)r * D + c) = (v2u){pk2(u[0], u[1]), pk2(u[2], u[3])}; } } }
        }
}
__device__ __forceinline__ void p8_rows(const Args& args, int e0, int en, bool late, int wave, int lane) {
        const float* gpo = args.in[I_GAPOST]; const float* gfo = args.in[I_GFPOST];
        for (int i0 = wave; i0 < en; i0 += 8 * 2) {
            f32x4 v[2][4]; v2u mo[2][4], fo[2][4]; float ssp1[2], ssp2[2];
#pragma unroll
            for (int q = 0; q < 2; ++q) { const int idx = i0 + 8 * q; const int r = rowmap(e0 + idx, late); ssp1[q] = 0.f; ssp2[q] = 0.f;
                if (idx < en) { const float* xr = r < MP ? xp + (size_t)r * D : xs + (size_t)(r - MP) * D;
                    ssp1[q] = SS1[(size_t)r * 16 + (lane & 15)]; ssp2[q] = SS2[(size_t)r * 16 + (lane & 15)];
#pragma unroll
                    for (int j = 0; j < 4; ++j) { v[q][j] = __builtin_nontemporal_load((const f32x4*)(xr + 4 * lane + 256 * j)); mo[q][j] = *(const v2u*)(MIXO + (size_t)r * D + 4 * lane + 256 * j); fo[q][j] = *(const v2u*)(U + (size_t)r * D + 4 * lane + 256 * j); } } }
#pragma unroll
            for (int q = 0; q < 2; ++q) { const int idx = i0 + 8 * q; const int r = rowmap(e0 + idx, late);
                if (idx < en) {
                    const float* mp = mod + (r < MP ? 0 : 1 + ((r - MP) >> 12)) * 6144;
                    float sp = ssp1[q]; sp += __shfl_xor(sp, 1); sp += __shfl_xor(sp, 2); sp += __shfl_xor(sp, 4); sp += __shfl_xor(sp, 8);
                    const float rstd1 = __builtin_amdgcn_rsqf(sp * (1.f / D) + EPS);
                    float sq = ssp2[q]; sq += __shfl_xor(sq, 1); sq += __shfl_xor(sq, 2); sq += __shfl_xor(sq, 4); sq += __shfl_xor(sq, 8);
                    const float rstd2 = __builtin_amdgcn_rsqf(sq * (1.f / D) + EPS);
#pragma unroll
                    for (int j = 0; j < 4; ++j) { const int c = 4 * lane + 256 * j;
                        const f32x4 mf = (f32x4){__uint_as_float(mo[q][j][0] << 16), __uint_as_float(mo[q][j][0] & 0xffff0000u), __uint_as_float(mo[q][j][1] << 16), __uint_as_float(mo[q][j][1] & 0xffff0000u)};
                        const f32x4 ff = (f32x4){__uint_as_float(fo[q][j][0] << 16), __uint_as_float(fo[q][j][0] & 0xffff0000u), __uint_as_float(fo[q][j][1] << 16), __uint_as_float(fo[q][j][1] & 0xffff0000u)};
                        const f32x4 gg = *(const f32x4*)(gpo + c), ga = *(const f32x4*)(mp + 2048 + c);
                        const f32x4 x1 = v[q][j] + ga * (mf * rstd1 * gg);
                        const f32x4 g2 = *(const f32x4*)(gfo + c), gf = *(const f32x4*)(mp + 5120 + c);
                        __builtin_nontemporal_store(x1 + gf * (ff * rstd2 * g2), (f32x4*)(Y + (size_t)r * D + c)); } } }
        }
}
struct P0Item { const float* W; bf16* WT; int K, N, dst_row0, src_col0, k0; bool rperm; float scale; };
__device__ __forceinline__ P0Item p0_item(const Args& args, int it) {
    constexpr int I_1 = 16 * 96, I_2 = 16 * 32, I_3 = 16 * 176;
    P0Item q; int r = it; q.rperm = false; q.scale = 1.0f;
    if (r < I_1) { const int kb = r / 96, nb = r % 96, n0 = 32 * nb; int src = n0;
        if (n0 >= 2048) { const int j = (n0 - 2048) >> 8, c = (n0 - 2048) & 255; src = c < 128 ? 2048 + 128 * j + c : 2560 + 128 * j + (c - 128); }
        q.W = args.in[I_WIN]; q.WT = WinT; q.K = D; q.N = NIN; q.dst_row0 = n0; q.src_col0 = src; q.k0 = 64 * kb; q.rperm = n0 < 1024; return q; }
    r -= I_1;
    if (r < I_2) { const int kb = r / 32, nb = r % 32; q.W = args.in[I_WOUT]; q.WT = WoT; q.K = D; q.N = D; q.dst_row0 = 32 * nb; q.src_col0 = 32 * nb; q.k0 = 64 * kb; return q; }
    r -= I_2;
    if (r < I_3) { const int kb = r / 176, nb = r % 176, n0 = 32 * nb; const int j = n0 >> 8, c = n0 & 255; const int src = c < 128 ? 128 * j + c : DFF + 128 * j + (c - 128);
        q.W = args.in[I_WFI]; q.WT = WfiT; q.K = D; q.N = NFI; q.dst_row0 = n0; q.src_col0 = src; q.k0 = 64 * kb;
        q.scale = c < 128 ? -1.4426950408889634f : -0.6931471805599453f; return q; }
    r -= I_3;
    { const int kb = r / 32, nb = r % 32; q.W = args.in[I_WFO]; q.WT = WfoT; q.K = DFF; q.N = D; q.dst_row0 = 32 * nb; q.src_col0 = 32 * nb; q.k0 = 64 * kb; return q; }
}
__device__ __forceinline__ void p0_item_load(const P0Item& q, float (&tv)[32], int lane) {
#pragma unroll
    for (int i = 0; i < 32; ++i) { const int kk = 2 * i + (lane >> 5); tv[i] = __builtin_nontemporal_load(q.W + (size_t)(q.k0 + kk) * q.N + q.src_col0 + (lane & 31)); }
}
__device__ __forceinline__ void p0_item_finish(const P0Item& q, const float (&tv)[32], LAS float* scr, int lane) {
#pragma unroll
    for (int i = 0; i < 32; ++i) { const int kk = 2 * i + (lane >> 5); scr[kk * 33 + (lane & 31)] = tv[i] * q.scale; }
    asm volatile("s_waitcnt lgkmcnt(0)" ::: "memory");
    const int c = lane & 7;
#pragma unroll
    for (int j = 0; j < 4; ++j) { const int n = (lane >> 3) + 8 * j; const int ns = q.rperm ? (16 * ((n >> 2) & 1) + 4 * (n >> 3) + (n & 3)) : n; const LAS float* s = scr + (8 * c) * 33 + ns;
        v4u o; o.x = pk2(s[0 * 33], s[1 * 33]); o.y = pk2(s[2 * 33], s[3 * 33]); o.z = pk2(s[4 * 33], s[5 * 33]); o.w = pk2(s[6 * 33], s[7 * 33]);
        *(v4u*)(q.WT + (size_t)(q.dst_row0 + n) * q.K + q.k0 + 8 * c) = o; }
    asm volatile("s_waitcnt lgkmcnt(0)" ::: "memory");
}

__device__ __forceinline__ void p0_transposes(const Args& args, int it0, int it1, int widx, int nw, LAS float* scr, int lane) {
    int it = it0 + widx;
    if (it < it1) {
        P0Item cur = p0_item(args, it); float ta[32], tb[32];
        p0_item_load(cur, ta, lane);
        for (;;) {
            const int nx = it + nw; const bool more = nx < it1; P0Item nxt = cur;
            if (more) { nxt = p0_item(args, nx); p0_item_load(nxt, tb, lane); }
            p0_item_finish(cur, ta, scr, lane);
            if (!more) break;
#pragma unroll
            for (int i = 0; i < 32; ++i) ta[i] = tb[i];
            cur = nxt; it = nx;
        }
    }
}
constexpr int IT_WIN = 16 * 96, IT_WO = IT_WIN + 16 * 32, IT_WFI = IT_WO + 16 * 176, IT_WFO = IT_WFI + 44 * 32;

__global__ void __launch_bounds__(NTHREADS, 2) fwd_megakernel(Args args) {
    extern __shared__ __attribute__((aligned(16))) unsigned char lds_raw[];
    LAS unsigned char* lds = (LAS unsigned char*)lds_raw;
    cg::grid_group grid = cg::this_grid();
    const int tid = threadIdx.x, lane = tid & 63; const int wave = __builtin_amdgcn_readfirstlane(tid >> 6);
    const int G = gridDim.x, bx = blockIdx.x;
    const int vcu = (G % 8 == 0) ? (bx % 8) * (G / 8) + bx / 8 : bx;
    const int gw = vcu * NWAVES + wave, NGW = G * NWAVES;
    unsigned char* ws = args.ws;
    const int lo = args.ph_lo, hi_ph = args.ph_hi;
#define IN(k) (lo <= (k) && (k) < hi_ph)
    if (tid < 16) ((LAS unsigned*)(lds + MISC_OFF))[tid] = 0u;
    __syncthreads();
    XcdBarrier bar = xcd_barrier_post((unsigned*)(ws + WS_BAR), (volatile LAS unsigned*)(lds + MISC_OFF));
    if (lo < 0) grid.sync();
#ifdef PROBE_BAR2
#define SEAM(k) do { if (IN(k) && IN((k) + 1)) { xcd_barrier(bar); xcd_barrier(bar); } } while (0)
#else
#define SEAM(k) do { if (IN(k) && IN((k) + 1)) xcd_barrier(bar); } while (0)
#endif

    if (IN(0)) {
#ifdef PROBE_P0
      for (int rep_ = 0; rep_ < 3; ++rep_) {
#endif
        if (bx < 192) {
            LAS float* S = (LAS float*)lds; LAS float* red = (LAS float*)(lds + 9 * 1024 * 4);
            { float cv[18];
#pragma unroll
              for (int u = 0; u < 18; ++u) { const int e = tid + u * NTHREADS, i = e >> 10, k = e & 1023; cv[u] = (i == 0) ? args.in[I_CCTX][k] : args.in[I_C][(i - 1) * 1024 + k]; }
#pragma unroll
              for (int u = 0; u < 18; ++u) S[tid + u * NTHREADS] = cv[u] / (1.f + __expf(-cv[u])); }
            __syncthreads();
            const int kgp = tid >> 5, cl = tid & 31, j0 = 32 * bx;
            float a[9];
#pragma unroll
            for (int i = 0; i < 9; ++i) a[i] = 0.f;
            const float* wp = args.in[I_WADA] + (size_t)(kgp * 64) * 6144 + j0 + cl;
            float wv[64];
#pragma unroll
            for (int k = 0; k < 64; ++k) wv[k] = __builtin_nontemporal_load(wp + (size_t)k * 6144);
#pragma unroll
            for (int k = 0; k < 64; ++k) {
#pragma unroll
                for (int i = 0; i < 9; ++i) a[i] += S[i * 1024 + kgp * 64 + k] * wv[k]; }
#pragma unroll
            for (int i = 0; i < 9; ++i) red[(kgp * 9 + i) * 32 + cl] = a[i];
            __syncthreads();
            if (tid < 288) { const int i = tid >> 5; float s = args.in[I_BADA][j0 + cl];
#pragma unroll
                for (int g = 0; g < 16; ++g) s += red[(g * 9 + i) * 32 + cl];
                mod[i * 6144 + j0 + cl] = s; }
            tail_arrive((unsigned*)(args.ws + WS_BAR) + 3712);
        }
        p0_transposes(args, 0, IT_WIN, gw, NGW, (LAS float*)(lds + wave * 16384), lane);
        {
            f32x4 cv0[2], cv1[2];
#pragma unroll
            for (int u = 0; u < 2; ++u) { const int ir = gw + u * NGW;
                if (ir < 2 * NB_S * PAST) { const int which = ir / (NB_S * PAST), rr = ir % (NB_S * PAST);
                    const float* src_ = args.in[which ? I_CV : I_CK] + (size_t)rr * 512 + lane * 8; cv0[u] = *(const f32x4*)src_; cv1[u] = *(const f32x4*)(src_ + 4); } }
#pragma unroll
            for (int u = 0; u < 2; ++u) { const int ir = gw + u * NGW;
                if (ir < 2 * NB_S * PAST) { const int which = ir / (NB_S * PAST), rr = ir % (NB_S * PAST), b = rr / PAST, j = rr % PAST;
                    bf16* drow = (which ? Vb : Kb) + (size_t)(MP + b * KV_PER_B + j) * 512;
                    if (which) *(v4u*)(drow + lane * 8) = (v4u){pk2(cv0[u][0], cv0[u][1]), pk2(cv0[u][2], cv0[u][3]), pk2(cv1[u][0], cv1[u][1]), pk2(cv1[u][2], cv1[u][3])};
                    else { const int l0 = lane * 8, g32 = l0 & ~31, la = l0 & 31, lb = la + 4;
                        *(v2u*)(drow + g32 + 8 * ((la >> 2) & 3) + 4 * (la >> 4)) = (v2u){pk2(cv0[u][0], cv0[u][1]), pk2(cv0[u][2], cv0[u][3])};
                        *(v2u*)(drow + g32 + 8 * ((lb >> 2) & 3) + 4 * (lb >> 4)) = (v2u){pk2(cv1[u][0], cv1[u][1]), pk2(cv1[u][2], cv1[u][3])}; } } }
            for (int ir = gw + 2 * NGW; ir < 2 * NB_S * PAST; ir += NGW) {
                const int which = ir / (NB_S * PAST), rr = ir % (NB_S * PAST), b = rr / PAST, j = rr % PAST;
                const float* src_ = args.in[which ? I_CV : I_CK] + (size_t)rr * 512 + lane * 8;
                const f32x4 v0 = *(const f32x4*)src_, v1 = *(const f32x4*)(src_ + 4);
                bf16* drow = (which ? Vb : Kb) + (size_t)(MP + b * KV_PER_B + j) * 512;
                if (which) *(v4u*)(drow + lane * 8) = (v4u){pk2(v0[0], v0[1]), pk2(v0[2], v0[3]), pk2(v1[0], v1[1]), pk2(v1[2], v1[3])};
                else { const int l0 = lane * 8, g32 = l0 & ~31, la = l0 & 31, lb = la + 4;
                    *(v2u*)(drow + g32 + 8 * ((la >> 2) & 3) + 4 * (la >> 4)) = (v2u){pk2(v0[0], v0[1]), pk2(v0[2], v0[3])};
                    *(v2u*)(drow + g32 + 8 * ((lb >> 2) & 3) + 4 * (lb >> 4)) = (v2u){pk2(v1[0], v1[1]), pk2(v1[2], v1[3])}; }
            }
        }
        if (bx == 255 || (G < 256 && bx == 0)) {
            for (int e = tid; e < 1024; e += NTHREADS) { const int pos = e >> 4, i = e & 15; const float inv = 1.0f / powf(10000.0f, (float)i / 16.0f); const float ang = (float)pos * inv; rot[e] = cosf(ang); rot[1024 + e] = sinf(ang); }
        }
#ifdef PROBE_P0
      __syncthreads(); }
#endif
    }
    if (IN(0) && IN(1)) tail_wait((unsigned*)(args.ws + WS_BAR) + 3712, 192u);

    if (IN(1)) {
        const float* g = args.in[I_GAPRE];
#ifdef PROBE_ROWS
        for (int rep_ = 0; rep_ < 2; ++rep_)
#endif
        for (int r0 = gw; r0 < M; r0 += 3 * NGW) {
            f32x4 v[3][4]; float s[3];
#pragma unroll
            for (int q = 0; q < 3; ++q) { const int r = r0 + q * NGW; s[q] = 0.f;
                if (r < M) { const float* xr = r < MP ? xp + (size_t)r * D : xs + (size_t)(r - MP) * D;
#pragma unroll
                    for (int j = 0; j < 4; ++j) v[q][j] = __builtin_nontemporal_load((const f32x4*)(xr + 4 * lane + 256 * j)); } }
#pragma unroll
            for (int q = 0; q < 3; ++q) { const int r = r0 + q * NGW;
                if (r < M) {
#pragma unroll
                    for (int j = 0; j < 4; ++j) s[q] += (v[q][j][0] * v[q][j][0] + v[q][j][1] * v[q][j][1]) + (v[q][j][2] * v[q][j][2] + v[q][j][3] * v[q][j][3]);
                    const float rstd = __builtin_amdgcn_rsqf(wave_sum(s[q]) * (1.f / D) + EPS);
                    const float* mp = mod + (r < MP ? 0 : 1 + ((r - MP) >> 12)) * 6144;
#pragma unroll
                    for (int j = 0; j < 4; ++j) { const int c = 4 * lane + 256 * j; const f32x4 gg = *(const f32x4*)(g + c), sh = *(const f32x4*)(mp + c), sc = *(const f32x4*)(mp + 1024 + c);
                        const f32x4 u = v[q][j] * rstd * gg * (sc + 1.f) + sh;
                        *(v2u*)(U + (size_t)r * D + c) = (v2u){pk2(u[0], u[1]), pk2(u[2], u[3])}; } } }
        }
    }
    SEAM(1);

    if (IN(2)) {
        pg8::Gemm g{U, WinT, M, NIN, D}; pg8::StaticOrder S; S.init(M, NIN, G, bx);
        pg8::EpiIn E{Qb, Kb, Vb, BG, Z, stK, stV, rot};
        pg8::gemm_phase<pg8::EpiIn, pg8::StaticOrder, PG8_ALIGN, PG8_SP2>(lds, g, S, E);
        if (G == 256 && bx >= 192) p0_transposes(args, IT_WIN, IT_WFI, (bx - 192) * NWAVES + wave, 64 * NWAVES, (LAS float*)(lds + wave * 16384), lane);
        else if (G != 256) p0_transposes(args, IT_WIN, IT_WFI, gw, NGW, (LAS float*)(lds + wave * 16384), lane);
#ifdef PROBE_GEMM2
        __syncthreads(); pg8::gemm_phase<pg8::EpiIn, pg8::StaticOrder, PG8_ALIGN, PG8_SP2>(lds, g, S, E);
#endif
    }
    SEAM(2);

    if (IN(3)) {
        {
            const float* cw = args.in[I_CONVW]; const float* cb = args.in[I_CONVB];
            const int c8 = (tid & 63) * 8;
            float w0[8], w1[8], w2[8], bb[8];
#pragma unroll
            for (int e = 0; e < 8; ++e) { w0[e] = cw[c8 + e]; w1[e] = cw[512 + c8 + e]; w2[e] = cw[1024 + c8 + e]; bb[e] = cb[c8 + e]; }
            const bool hasp = (G == 256) && (vcu < NB_P * 4 * 2); const int cn = (G == 256) ? (hasp ? 112 : 176) : (M + G - 1) / G; const int cbase = (G == 256) ? (hasp ? vcu * 112 : 128 * 112 + (vcu - 128) * 176) : vcu * cn;
#ifdef PROBE_CONV
            for (int rep_ = 0; rep_ < 3; ++rep_)
#endif
            for (int i0 = wave; i0 < cn; i0 += 24) {
                v4u zc[3], zp[3], zn[3], bg[3];
#pragma unroll
                for (int q = 0; q < 3; ++q) { const int idx = i0 + 8 * q; const int r = cbase + idx;
                    zp[q] = (v4u){0u, 0u, 0u, 0u}; zn[q] = (v4u){0u, 0u, 0u, 0u}; zc[q] = zp[q]; bg[q] = zp[q];
                    if (idx < cn && r < M) { const int t = r < MP ? (r & (SEQ_P - 1)) : ((r - MP) & (SEQ_S - 1)); const int L = r < MP ? SEQ_P : SEQ_S;
                        zc[q] = *(const v4u*)(Z + (size_t)r * 512 + c8); bg[q] = *(const v4u*)(BG + (size_t)r * 512 + c8);
                        if (t > 0) zp[q] = *(const v4u*)(Z + (size_t)(r - 1) * 512 + c8);
                        if (t < L - 1) zn[q] = *(const v4u*)(Z + (size_t)(r + 1) * 512 + c8); } }
#pragma unroll
                for (int q = 0; q < 3; ++q) { const int idx = i0 + 8 * q; const int r = cbase + idx;
                    if (idx < cn && r < M) { float o[8];
#pragma unroll
                        for (int e = 0; e < 4; ++e) {
                            const float zc0 = __uint_as_float(zc[q][e] << 16), zc1 = __uint_as_float(zc[q][e] & 0xffff0000u), zp0 = __uint_as_float(zp[q][e] << 16), zp1 = __uint_as_float(zp[q][e] & 0xffff0000u);
                            const float zn0 = __uint_as_float(zn[q][e] << 16), zn1 = __uint_as_float(zn[q][e] & 0xffff0000u), b0 = __uint_as_float(bg[q][e] << 16), b1 = __uint_as_float(bg[q][e] & 0xffff0000u);
                            o[2 * e] = b0 * (w0[2 * e] * zp0 + w1[2 * e] * zc0 + w2[2 * e] * zn0 + bb[2 * e]);
                            o[2 * e + 1] = b1 * (w0[2 * e + 1] * zp1 + w1[2 * e + 1] * zc1 + w2[2 * e + 1] * zn1 + bb[2 * e + 1]); }
                        *(v4u*)(MIX + (size_t)r * D + 512 + c8) = (v4u){pk2(o[0], o[1]), pk2(o[2], o[3]), pk2(o[4], o[5]), pk2(o[6], o[7])}; } }
            }
        }
        float lam;
        { const float a = args.in[I_LQ1][lane] * args.in[I_LK1][lane], b = args.in[I_LQ2][lane] * args.in[I_LK2][lane];
          lam = __expf(wave_sum(a)) - __expf(wave_sum(b)) + 0.2f; }
        __syncthreads();
        const float* gsub = args.in[I_GSUB];
        for (int i = vcu; i < NB_S * 4 * 32; i += G) {
            const int bh = (i >> 5) & 31, qb = i & 31; const int b = bh >> 2, h = bh & 3;
            att::attn_unit((LAS char*)lds, Qb, Kb, Vb, MIX, MP + b * SEQ_S + qb * 128, MP + b * KV_PER_B, KV_PER_B / 64, h, lam, gsub);
        }
#ifdef PROBE_ATT2
        for (int i = vcu; i < NB_S * 4 * 32; i += G) {
            const int bh = (i >> 5) & 31, qb = i & 31; const int b = bh >> 2, h = bh & 3;
            att::attn_unit((LAS char*)lds, Qb, Kb, Vb, MIX, MP + b * SEQ_S + qb * 128, MP + b * KV_PER_B, KV_PER_B / 64, h, lam, gsub);
        }
#endif
        for (int i = vcu; i < NB_P * 4 * 2; i += G) {
            const int b = i >> 3, h = (i >> 1) & 3, qb = i & 1;
            att::attn_unit((LAS char*)lds, Qb, Kb, Vb, MIX, b * SEQ_P + qb * 128, b * SEQ_P, SEQ_P / 64, h, lam, gsub);
        }
    }
    SEAM(3);

    if (IN(4)) {
        pg8::Gemm g{MIX, WoT, M, D, D}; pg8::PanelOrder S{G, bx, 0, 512}; pg8::EpiSS E{MIXO, SS1};
        pg8::gemm_phase<pg8::EpiSS, pg8::PanelOrder, PG8_ALIGN, PG8_SP2>(lds, g, S, E);
    }
    SEAM(4);
    if (IN(5)) {
        unsigned* cnt = (unsigned*)(args.ws + WS_BAR) + 3584;
        if (bx < 64) { pg8::Gemm g{MIX, WoT, M, D, D}; pg8::PanelOrder S{G, bx, 512, 576}; pg8::EpiSS E{MIXO, SS1};
            pg8::gemm_phase<pg8::EpiSS, pg8::PanelOrder, PG8_ALIGN, PG8_SP2>(lds, g, S, E);
            tail_arrive(cnt); }
        int e0, en; early_share(bx, 144, 80, e0, en);
        p5_rows(args, e0, en, false, wave, lane);
        tail_wait(cnt, 64u);
        p5_rows(args, bx * 16, 16, true, wave, lane);
    }
    SEAM(5);
    if (IN(6)) {
        pg8::Gemm g{U, WfiT, M, NFI, D}; pg8::StaticOrder S; S.init(M, NFI, G, bx);
        pg8::EpiGlu E{H};
        pg8::gemm_phase<pg8::EpiGlu, pg8::StaticOrder, PG8_ALIGN, PG8_SP2>(lds, g, S, E);
        if (G == 256 && bx >= 96) p0_transposes(args, IT_WFI, IT_WFO, (bx - 96) * NWAVES + wave, 160 * NWAVES, (LAS float*)(lds + wave * 16384), lane);
        else if (G != 256) p0_transposes(args, IT_WFI, IT_WFO, gw, NGW, (LAS float*)(lds + wave * 16384), lane);
    }
    SEAM(6);
    if (IN(7)) {
        pg8::Gemm g{H, WfoT, M, D, DFF}; pg8::PanelOrder S{G, bx, 0, 512}; pg8::EpiSS E{U, SS2};
        pg8::gemm_phase<pg8::EpiSS, pg8::PanelOrder, PG8_ALIGN, PG8_SP2>(lds, g, S, E);
    }
    SEAM(7);
    if (IN(8)) {
        unsigned* cnt = (unsigned*)(args.ws + WS_BAR) + 3648;
        if (bx < 64) { pg8::Gemm g{H, WfoT, M, D, DFF}; pg8::PanelOrder S{G, bx, 512, 576}; pg8::EpiSS E{U, SS2};
            pg8::gemm_phase<pg8::EpiSS, pg8::PanelOrder, PG8_ALIGN, PG8_SP2>(lds, g, S, E);
            tail_arrive(cnt); }
        if (bx >= 64) { int e0, en; free_share(bx - 64, e0, en); p8_rows(args, e0, en, false, wave, lane); }
        tail_wait(cnt, 64u);
        p8_rows(args, bx * 16, 16, true, wave, lane);
    }
#undef IN
#undef SEAM
#undef mod
#undef rot
#undef SS1
#undef SS2
#undef WinT
#undef WoT
#undef WfiT
#undef WfoT
#undef U
#undef MIXO
#undef Qb
#undef Kb
#undef Vb
#undef MIX
#undef BG
#undef Z
#undef H
#undef xp
#undef xs
#undef Y
#undef stK
#undef stV
}

extern "C" void kernel_launch(void* const* d_in, const int* in_sizes, int n_in, void* d_out, int out_size, void* d_ws, size_t ws_size, hipStream_t stream) {
    static int grid = 0;
    if (grid == 0) {
        if (n_in != 23 || ws_size < WS_END || out_size != M * D + 2 * MP * 512) { fprintf(stderr, "kernel_launch: unexpected problem (n_in %d, ws %zu, out %d)\n", n_in, ws_size, out_size); grid = -1; return; }
        int dev = 0, cus = 0, per_cu = 0;
        hipGetDevice(&dev); hipDeviceGetAttribute(&cus, hipDeviceAttributeMultiprocessorCount, dev);
        if (hipFuncSetAttribute((const void*)fwd_megakernel, hipFuncAttributeMaxDynamicSharedMemorySize, LDS_BYTES) != hipSuccess) { fprintf(stderr, "kernel_launch: hipFuncSetAttribute failed\n"); grid = -1; return; }
        if (hipOccupancyMaxActiveBlocksPerMultiprocessor(&per_cu, (const void*)fwd_megakernel, NTHREADS, LDS_BYTES) != hipSuccess || per_cu < 1) { fprintf(stderr, "kernel_launch: occupancy query failed (%d)\n", per_cu); (void)hipGetLastError(); per_cu = 1; }
        grid = cus * 1;
        if (grid > cus * per_cu) grid = cus * per_cu;
    }
    if (grid < 0) return;
    Args a{};
    for (int i = 0; i < 23; ++i) a.in[i] = (const float*)d_in[i];
    a.out = (float*)d_out; a.ws = (unsigned char*)d_ws;
    if (hipMemsetAsync((char*)d_ws + WS_BAR, 0, BAR_BYTES, stream) != hipSuccess) { fprintf(stderr, "kernel_launch: memset failed\n"); return; }
#if MK_COOP
    a.ph_lo = 0; a.ph_hi = N_PHASES;
    void* kargs[] = {&a};
    hipError_t e = hipLaunchCooperativeKernel((const void*)fwd_megakernel, dim3(grid), dim3(NTHREADS), kargs, LDS_BYTES, stream);
    if (e != hipSuccess) fprintf(stderr, "cooperative launch failed: %s (grid %d)\n", hipGetErrorString(e), grid);
#else
    for (int p = 0; p < N_PHASES; ++p) { a.ph_lo = p; a.ph_hi = p + 1; hipLaunchKernelGGL(fwd_megakernel, dim3(grid), dim3(NTHREADS), LDS_BYTES, stream, a); }
#endif
}
```

```cpp
#include <hip/hip_runtime.h>
#include <hip/hip_cooperative_groups.h>
#include <cstdio>
#include <cstdint>
namespace cg = cooperative_groups;
namespace pg8 {
#define PG8_LAS __attribute__((address_space(3)))
typedef unsigned short bf16_t;
typedef short bf16x8 __attribute__((ext_vector_type(8)));
typedef float f32x4 __attribute__((ext_vector_type(4)));
typedef unsigned u32x4 __attribute__((ext_vector_type(4)));
constexpr int BM = 256, BK = 64, HALF = 128, HTB = HALF * BK * 2  , STAGE_BYTES = 8 * HTB, NXCD = 8, WGM = 8;

__host__ __device__ __forceinline__ int lds_byte(int r, int c) { const int st = (r >> 4) * 2 + (c >> 5), rr = r & 15, cc = c & 31, ob = rr * 64 + cc * 2; return st * 1024 + (ob ^ (((ob >> 9) & 1) << 5)); }
__host__ __device__ __forceinline__ void stage_rc(int b, int& R, int& C) { const int st = b / 1024, sb = b % 1024, swz = sb ^ (((sb >> 9) & 1) << 5); R = (st >> 1) * 16 + swz / 64; C = (st & 1) * 32 + (swz % 64) / 2; }
__host__ __device__ __forceinline__ int perm32(int rho) { const int n = rho >> 4, i = rho & 15; return 8 * (i >> 2) + 4 * n + (i & 3); }

struct Unit { int pm, pn; };
struct Gemm { const bf16_t* A; const bf16_t* Bt; int M, N, K; };

struct StaticOrder {
    int nM, nN, nwg, G, c;
    __host__ __device__ void init(int M, int N, int G_, int c_) { nM = M / BM; nN = N / BM; nwg = nM * nN; G = G_; c = c_; }
    __host__ __device__ bool next(int i, Unit& u) const {
        const long L = (long)i * G + c; if (L >= nwg) return false;
        int wgid = (int)L; { const int q = nwg / NXCD, r = nwg % NXCD, xcd = wgid % NXCD, off = wgid / NXCD; wgid = (xcd < r ? xcd * (q + 1) : r * (q + 1) + (xcd - r) * q) + off; }
        const int nig = WGM * nN, gid = wgid / nig, fm = gid * WGM, gsz = (nM - fm) < WGM ? (nM - fm) : WGM;
        u.pm = fm + ((wgid % nig) % gsz); u.pn = (wgid % nig) / gsz; return true;
    }
    __device__ __forceinline__ void a_ready(const Unit&) const {}
    __device__ __forceinline__ void done(const Unit&) const {}
};

__device__ __forceinline__ unsigned cvt_pk_bf16(float lo, float hi) { unsigned r; asm volatile("v_cvt_pk_bf16_f32 %0, %1, %2" : "=v"(r) : "v"(lo), "v"(hi)); return r; }
template <class Epi, class Sched, bool ALIGN_EPI = false, bool SP2 = false>
__device__ __forceinline__ void gemm_phase(PG8_LAS unsigned char* lds, const Gemm g, const Sched& S, const Epi& E) {
    const int tid = threadIdx.x, wid = __builtin_amdgcn_readfirstlane(tid >> 6), lane = tid & 63, wr = wid >> 2, wc = wid & 3, fr = lane & 15, fq = lane >> 4;
    const int K = g.K, nt = K / BK;
    unsigned voffA[2], voffB[2];
#pragma unroll
    for (int i = 0; i < 2; ++i) { int R, C; stage_rc(tid * 16 + i * 8192, R, C); const int Rb = Epi::PERM ? ((R & ~31) + perm32(R & 31)) : R;
        voffA[i] = (unsigned)(R * K + C) * 2u; voffB[i] = (unsigned)(Rb * K + C) * 2u; }
    const size_t kstep = (size_t)(BK * 2);
    const size_t hstep = (size_t)HALF * K * 2;
    const size_t tstep = 2 * hstep;
    const unsigned ldsw = (unsigned)wid * 1024u;
    const int aoff = lds_byte(wr * 64 + fr, fq * 8), boff = lds_byte(wc * 32 + fr, fq * 8);
#define PG8_SA(b, h) (((b) * 2 + (h)) * HTB)
#define PG8_SB(b, h) ((4 + (b) * 2 + (h)) * HTB)
#define PG8_STAGE(bufoff, gbase, voff) do { _Pragma("unroll") for (int _i = 0; _i < 2; ++_i) \
        __builtin_amdgcn_global_load_lds((const unsigned*)((const char*)(gbase) + (voff)[_i]), (PG8_LAS unsigned*)(lds + (bufoff) + ldsw + _i * 8192), 16, 0, 0); } while (0)
#define PG8_LDA(dst, b, h) do { _Pragma("unroll") for (int m = 0; m < 4; ++m) _Pragma("unroll") for (int k = 0; k < 2; ++k) dst[m][k] = *(const PG8_LAS bf16x8*)(lds + PG8_SA(b, h) + aoff + m * 2048 + k * 1024); } while (0)
#define PG8_LDB(dst, b, h) do { _Pragma("unroll") for (int n = 0; n < 2; ++n) _Pragma("unroll") for (int k = 0; k < 2; ++k) dst[n][k] = *(const PG8_LAS bf16x8*)(lds + PG8_SB(b, h) + boff + n * 2048 + k * 1024); } while (0)
#define PG8_MMA(ai, bj, At, Bt) do { __builtin_amdgcn_s_setprio(1); _Pragma("unroll") for (int m = 0; m < 4; ++m) _Pragma("unroll") for (int n = 0; n < 2; ++n) _Pragma("unroll") for (int k = 0; k < 2; ++k) \
        acc[ai][bj][m][n] = __builtin_amdgcn_mfma_f32_16x16x32_bf16(Bt[n][k], At[m][k], acc[ai][bj][m][n], 0, 0, 0); __builtin_amdgcn_s_setprio(0); } while (0)
#define PG8_WAIT_V(n) asm volatile("s_waitcnt vmcnt(" #n ")" ::: "memory")
#define PG8_WAIT_L(n) asm volatile("s_waitcnt lgkmcnt(" #n ")" ::: "memory")
#define PG8_BAR __builtin_amdgcn_s_barrier()
#define PG8_SCHED __builtin_amdgcn_sched_barrier(0)
    Unit cur, nxt; int ui = 0;
    if (!S.next(0, cur)) return;
    f32x4 acc[2][2][4][2];
#pragma unroll
    for (int a = 0; a < 2; ++a)
#pragma unroll
        for (int b = 0; b < 2; ++b)
#pragma unroll
            for (int m = 0; m < 4; ++m)
#pragma unroll
                for (int n = 0; n < 2; ++n) acc[a][b][m][n] = (f32x4){0.f, 0.f, 0.f, 0.f};
    bf16x8 At[4][2], B0[2][2], B1[2][2];
    const char* cA = (const char*)g.A + (size_t)cur.pm * tstep; const char* cB = (const char*)g.Bt + (size_t)cur.pn * tstep;
    S.a_ready(cur);
    if constexpr (SP2) {
        PG8_STAGE(PG8_SB(0, 0), cB, voffB); PG8_STAGE(PG8_SB(0, 1), cB + hstep, voffB); PG8_STAGE(PG8_SA(0, 0), cA, voffA); PG8_STAGE(PG8_SA(0, 1), cA + hstep, voffA);
        if (wr == 1) PG8_BAR;
        PG8_WAIT_V(2); PG8_BAR;
        PG8_STAGE(PG8_SB(1, 0), cB + kstep, voffB); PG8_STAGE(PG8_SA(1, 0), cA + kstep, voffA); PG8_STAGE(PG8_SB(1, 1), cB + hstep + kstep, voffB);
        PG8_WAIT_V(6); PG8_BAR;
    } else {
        PG8_STAGE(PG8_SB(0, 0), cB, voffB); PG8_STAGE(PG8_SA(0, 0), cA, voffA); PG8_STAGE(PG8_SB(0, 1), cB + hstep, voffB); PG8_STAGE(PG8_SA(0, 1), cA + hstep, voffA);
        if (wr == 1) PG8_BAR;
        PG8_WAIT_V(4); PG8_BAR;
        PG8_STAGE(PG8_SB(1, 0), cB + kstep, voffB); PG8_STAGE(PG8_SA(1, 0), cA + kstep, voffA); PG8_STAGE(PG8_SB(1, 1), cB + hstep + kstep, voffB);
        PG8_WAIT_V(6); PG8_BAR;
    }
    for (;;) {
        const bool has_next = S.next(ui + 1, nxt);
        const char* nA = has_next ? (const char*)g.A + (size_t)nxt.pm * tstep : cA; const char* nB = has_next ? (const char*)g.Bt + (size_t)nxt.pn * tstep : cB;
        for (int t = 0; t < nt; t += 2) {
            const bool last = (t == nt - 2);
            const char* a1 = cA + (size_t)(t + 1) * kstep;
            const char* a2 = last ? nA : cA + (size_t)(t + 2) * kstep; const char* b2 = last ? nB : cB + (size_t)(t + 2) * kstep;
            const char* a3 = a2 + kstep; const char* b3 = b2 + kstep;
            if (last && has_next) S.a_ready(nxt);
            if constexpr (SP2) {
            PG8_LDB(B0, 0, 0); PG8_LDB(B1, 0, 1); PG8_SCHED; PG8_LDA(At, 0, 0); PG8_STAGE(PG8_SA(1, 1), a1 + hstep, voffA);
            PG8_WAIT_V(8); PG8_WAIT_L(0); PG8_BAR; PG8_MMA(0, 0, At, B0); PG8_MMA(0, 1, At, B1); PG8_BAR; PG8_SCHED;
            PG8_LDA(At, 0, 1); PG8_STAGE(PG8_SB(0, 0), b2, voffB); PG8_STAGE(PG8_SB(0, 1), b2 + hstep, voffB); PG8_STAGE(PG8_SA(0, 0), a2, voffA);
            PG8_WAIT_V(8); PG8_WAIT_L(0); PG8_BAR; PG8_MMA(1, 0, At, B0); PG8_MMA(1, 1, At, B1); PG8_BAR; PG8_SCHED;
            PG8_LDB(B0, 1, 0); PG8_LDB(B1, 1, 1); PG8_SCHED; PG8_LDA(At, 1, 0); PG8_STAGE(PG8_SA(0, 1), a2 + hstep, voffA);
            PG8_WAIT_V(8); PG8_WAIT_L(0); PG8_BAR; PG8_MMA(0, 0, At, B0); PG8_MMA(0, 1, At, B1); PG8_BAR; PG8_SCHED;
            PG8_LDA(At, 1, 1); PG8_STAGE(PG8_SB(1, 0), b3, voffB); PG8_STAGE(PG8_SB(1, 1), b3 + hstep, voffB); PG8_STAGE(PG8_SA(1, 0), a3, voffA);
            PG8_WAIT_V(8); PG8_WAIT_L(0); PG8_BAR; PG8_MMA(1, 0, At, B0); PG8_MMA(1, 1, At, B1); PG8_BAR; PG8_SCHED;
            } else {
            PG8_LDB(B0, 0, 0); PG8_SCHED; PG8_LDA(At, 0, 0); PG8_STAGE(PG8_SA(1, 1), a1 + hstep, voffA);
            PG8_WAIT_L(8); PG8_BAR; PG8_WAIT_L(0); PG8_MMA(0, 0, At, B0); PG8_BAR; PG8_SCHED;
            PG8_LDB(B1, 0, 1); PG8_STAGE(PG8_SB(0, 0), b2, voffB);
            PG8_BAR; PG8_WAIT_L(0); PG8_MMA(0, 1, At, B1); PG8_BAR;
            PG8_LDA(At, 0, 1); PG8_STAGE(PG8_SA(0, 0), a2, voffA);
            PG8_BAR; PG8_WAIT_L(0); PG8_MMA(1, 0, At, B0); PG8_BAR; PG8_SCHED;
            PG8_STAGE(PG8_SB(0, 1), b2 + hstep, voffB);
            PG8_WAIT_V(6); PG8_BAR; PG8_MMA(1, 1, At, B1); PG8_BAR;
            PG8_LDB(B0, 1, 0); PG8_SCHED; PG8_LDA(At, 1, 0); PG8_STAGE(PG8_SA(0, 1), a2 + hstep, voffA);
            PG8_WAIT_L(8); PG8_BAR; PG8_WAIT_L(0); PG8_MMA(0, 0, At, B0); PG8_BAR; PG8_SCHED;
            PG8_LDB(B1, 1, 1); PG8_STAGE(PG8_SB(1, 0), b3, voffB);
            PG8_BAR; PG8_WAIT_L(0); PG8_MMA(0, 1, At, B1); PG8_BAR;
            PG8_LDA(At, 1, 1); PG8_STAGE(PG8_SA(1, 0), a3, voffA);
            PG8_BAR; PG8_WAIT_L(0); PG8_MMA(1, 0, At, B0); PG8_BAR; PG8_SCHED;
            PG8_STAGE(PG8_SB(1, 1), b3 + hstep, voffB);
            PG8_WAIT_V(6); PG8_BAR; PG8_MMA(1, 1, At, B1); PG8_BAR;
            }
        }
        if constexpr (ALIGN_EPI) { if (wr == 0) PG8_BAR; }
        if constexpr (!Epi::AFTER_DRAIN) { E(acc, cur, wr, wc, fr, fq);
#ifdef PROBE_EPI2
            if constexpr (Epi::PROBE_ID == PROBE_EPI2) { asm volatile("" ::: "memory"); E(acc, cur, wr, wc, fr, fq); }
#endif
            S.done(cur); }
        if (!has_next) break;
#pragma unroll
        for (int a = 0; a < 2; ++a)
#pragma unroll
            for (int b = 0; b < 2; ++b)
#pragma unroll
                for (int m = 0; m < 4; ++m)
#pragma unroll
                    for (int n = 0; n < 2; ++n) acc[a][b][m][n] = (f32x4){0.f, 0.f, 0.f, 0.f};
        cur = nxt; cA = nA; cB = nB; ++ui;
        if constexpr (ALIGN_EPI) { if (wr == 1) PG8_BAR; }
    }
    PG8_WAIT_V(0);
    if constexpr (!ALIGN_EPI) { if (wr == 0) PG8_BAR; }
    PG8_BAR;
    if constexpr (Epi::AFTER_DRAIN) { E.fused(acc, cur, wr, wc, fr, fq, lds, wid, lane); S.done(cur); }
#undef PG8_SA
#undef PG8_SB
#undef PG8_STAGE
#undef PG8_LDA
#undef PG8_LDB
#undef PG8_MMA
#undef PG8_WAIT_V
#undef PG8_WAIT_L
#undef PG8_BAR
#undef PG8_SCHED
}
}
#ifndef PG8_SP2
#define PG8_SP2 true
#endif
#ifndef PG8_ALIGN
#define PG8_ALIGN true
#endif
#ifndef MK_COOP
#define MK_COOP 1
#endif

#define LAS __attribute__((address_space(3)))
typedef unsigned short bf16;
typedef unsigned v4u __attribute__((ext_vector_type(4)));
typedef unsigned v2u __attribute__((ext_vector_type(2)));
typedef float f32x4 __attribute__((ext_vector_type(4)));
typedef float f32x16 __attribute__((ext_vector_type(16)));
typedef short bf16x8 __attribute__((ext_vector_type(8)));
typedef short v4i16_t __attribute__((ext_vector_type(4)));
typedef float f32x2_t __attribute__((ext_vector_type(2)));
typedef __bf16 bf16x2_t __attribute__((ext_vector_type(2)));

constexpr int D = 1024, MP = 4096, MS = 32768, M = MP + MS, NIN = 3072, DFF = 2816, NFI = 2 * DFF;
constexpr int SEQ_P = 256, SEQ_S = 4096, PAST = 256, NB_S = 8, NB_P = 16;
constexpr int KV_PER_B = PAST + SEQ_S;
constexpr int KROWS = MP + NB_S * KV_PER_B;
constexpr float EPS = 1e-6f;
constexpr float QSCALE = 0.125f * 1.4426950408889634f;
constexpr int NWAVES = 8, NTHREADS = 512;

constexpr size_t MiB = 1u << 20;
constexpr size_t WS_MOD = 0;
constexpr size_t WS_ROT = 256 * 1024;
constexpr size_t WS_BAR = 512 * 1024, BAR_BYTES = 16384;
constexpr size_t WS_SS1 = 1 * MiB;
constexpr size_t WS_SS2 = 4 * MiB;
constexpr size_t WS_WIN = 8 * MiB, WS_WO = 14 * MiB, WS_WFI = 16 * MiB, WS_WFO = 27 * MiB;
constexpr size_t WS_U = 34 * MiB;
constexpr size_t WS_MIXO = 106 * MiB;
constexpr size_t WS_Q = 178 * MiB;
constexpr size_t WS_K = 214 * MiB;
constexpr size_t WS_V = 252 * MiB;
constexpr size_t WS_MIX = 290 * MiB;
constexpr size_t WS_BG = 362 * MiB;
constexpr size_t WS_Z = 398 * MiB;
constexpr size_t WS_H = 178 * MiB;
constexpr size_t WS_END = 434 * MiB;
static_assert(WS_H + (size_t)M * DFF * 2 <= WS_Z, "H overlay");
static_assert(WS_K + (size_t)KROWS * 512 * 2 <= WS_V && WS_V + (size_t)KROWS * 512 * 2 <= WS_MIX, "kv map");

constexpr int MISC_OFF = 131072 + 1024;
constexpr int LDS_BYTES = 131072 + 2048;

__device__ __forceinline__ unsigned pk2(float lo, float hi) { f32x2_t v = {lo, hi}; bf16x2_t b = __builtin_convertvector(v, bf16x2_t); return __builtin_bit_cast(unsigned, b); }
__device__ __forceinline__ float bf2f(unsigned short b) { return __uint_as_float((unsigned)b << 16); }
__device__ __forceinline__ float wave_sum(float v) {
#pragma unroll
    for (int o = 1; o < 64; o <<= 1) v += __shfl_xor(v, o);
    return v;
}
__device__ __forceinline__ int krow_of(int r) { return r < MP ? r : MP + ((r - MP) >> 12) * KV_PER_B + PAST + ((r - MP) & 4095); }

#define XB_TMO      128
#define XB_XCNT(j)  (256  + 64 * (j))
#define XB_XSUB(j)  (1280 + 64 * (j))
#define XB_XGEN(j)  (2304 + 64 * (j))
#define XB_TOP      3328
#define XB_TOPGEN   3392
#define XCD_BAR_WORDS 3456
#define XB_SPIN_CAP (1u << 18)

__device__ __forceinline__ unsigned xb_ld(unsigned* p)              { return __hip_atomic_load(p, __ATOMIC_RELAXED, __HIP_MEMORY_SCOPE_AGENT); }
__device__ __forceinline__ unsigned xb_add(unsigned* p, unsigned v) { return __hip_atomic_fetch_add(p, v, __ATOMIC_RELAXED, __HIP_MEMORY_SCOPE_AGENT); }
__device__ __forceinline__ unsigned xb_xcc_id() { return (unsigned)__builtin_amdgcn_s_getreg((3 << 11) | 20) & 0xFu; }
#define XB_SPIN(cond, bar) do { unsigned _sp = 0; while (cond) { __builtin_amdgcn_s_sleep(1); \
    if ((++_sp & 255u) == 0u) { if (xb_ld(&(bar)[XB_TMO])) break; if (_sp > XB_SPIN_CAP) { atomicAdd(&(bar)[XB_TMO], 1u); break; } } } } while (0)

struct XcdBarrier {
    unsigned* bar; unsigned x;
    volatile LAS unsigned* st;
};

__device__ __forceinline__ XcdBarrier xcd_barrier_post(unsigned* bar, volatile LAS unsigned* st) {
    XcdBarrier b; b.bar = bar; b.x = xb_xcc_id(); b.st = st;
    if (threadIdx.x == 0) (void)xb_add(&bar[XB_XCNT(b.x)], 1u);
    return b;
}
__device__ __forceinline__ void xcd_barrier_complete(unsigned* bar, unsigned x, unsigned& nloc, unsigned& nx) {
    const unsigned G = gridDim.x * gridDim.y * gridDim.z;
    unsigned sum, cnt, mine, sp = 0u;
    for (;;) {
        sum = 0u; cnt = 0u; mine = 0u;
#pragma unroll
        for (unsigned j = 0; j < 16; ++j) { const unsigned c = xb_ld(&bar[XB_XCNT(j)]); sum += c; cnt += (c > 0u) ? 1u : 0u; mine = (j == x) ? c : mine; }
        if (sum == G) break;
        __builtin_amdgcn_s_sleep(1);
        if ((++sp & 255u) == 0u) { if (xb_ld(&bar[XB_TMO])) break; if (sp > XB_SPIN_CAP) { atomicAdd(&bar[XB_TMO], 1u); break; } }
    }
    nloc = mine > 0u ? mine : 1u; nx = cnt > 0u ? cnt : 1u;
}

__device__ __forceinline__ void xcd_barrier(const XcdBarrier& b) {
    asm volatile("s_waitcnt vmcnt(0)" ::: "memory");
    __syncthreads();
    if (threadIdx.x == 0) {
        unsigned* bar = b.bar;
        __builtin_amdgcn_s_waitcnt(0);
        unsigned nloc = b.st[0], nx = b.st[1];
        if (nloc == 0u) { xcd_barrier_complete(bar, b.x, nloc, nx); b.st[0] = nloc; b.st[1] = nx; }
        const unsigned old = xb_add(&bar[XB_XSUB(b.x)], 1u);
        const unsigned gen = old / nloc;
        if (old + 1u == (gen + 1u) * nloc) {
            __builtin_amdgcn_fence(__ATOMIC_RELEASE, "agent");
            asm volatile("s_waitcnt vmcnt(0)" ::: "memory");
            const unsigned og = xb_add(&bar[XB_TOP], 1u);
            const unsigned tg = og / nx;
            if (og + 1u == (tg + 1u) * nx) xb_add(&bar[XB_TOPGEN], 1u);
            else XB_SPIN(xb_ld(&bar[XB_TOPGEN]) == tg, bar);
            __builtin_amdgcn_fence(__ATOMIC_ACQUIRE, "agent");
            xb_add(&bar[XB_XGEN(b.x)], 1u);
            asm volatile("s_waitcnt vmcnt(0)" ::: "memory");
        } else {
            XB_SPIN(xb_ld(&bar[XB_XGEN(b.x)]) == gen, bar);
            __builtin_amdgcn_fence(__ATOMIC_ACQUIRE, "agent");
            asm volatile("s_waitcnt vmcnt(0)" ::: "memory");
        }
    }
    __syncthreads();
}

namespace pg8 {
struct EpiIn {
    static constexpr bool PERM = true, AFTER_DRAIN = false; static constexpr int PROBE_ID = 1;
    bf16_t *Q, *Kb, *Vb, *BG, *Z; float *stK, *stV; const float* rot;
    __device__ __forceinline__ void operator()(const f32x4 (&acc)[2][2][4][2], const Unit& u, int wr, int wc, int fr, int fq) const {
        const int pn = u.pn; const bool sample = u.pm >= (MP / 256);
        const int rbase = u.pm * BM + wr * 64 + fr;
        const int cp = wc * 32 + 8 * fq;
        if (pn < 4) {
            const bool isq = pn < 2; const int cbp = (pn & 1) * 256 + cp, cbl = (pn & 1) * 256 + wc * 32 + 4 * fq;
            const float qs = isq ? QSCALE : 1.0f;
#pragma unroll
            for (int ai = 0; ai < 2; ++ai)
#pragma unroll
                for (int m = 0; m < 4; ++m) {
                    const int r = rbase + ai * HALF + m * 16;
                    f32x4 cs = (f32x4){1.f, 1.f, 1.f, 1.f}, sn = (f32x4){0.f, 0.f, 0.f, 0.f};
                    if (sample) { const int t = (r - MP) & 4095; const int pos = (wc & 1) ? (t & 63) : (t >> 6);
                        cs = *(const f32x4*)(rot + pos * 16 + 4 * fq); sn = *(const f32x4*)(rot + 1024 + pos * 16 + 4 * fq); }
                    cs = cs * qs; sn = sn * qs;
                    const size_t kr = (size_t)krow_of(r);
#pragma unroll
                    for (int bj = 0; bj < 2; ++bj) {
                        const f32x4 x1 = acc[ai][bj][m][0], x2 = acc[ai][bj][m][1];
                        const f32x4 o1 = x1 * cs - x2 * sn, o2 = x2 * cs + x1 * sn;
                        u32x4 w; w.x = pk2(o1[0], o1[1]); w.y = pk2(o1[2], o1[3]); w.z = pk2(o2[0], o2[1]); w.w = pk2(o2[2], o2[3]);
                        if (isq) *(u32x4*)(Q + (size_t)r * 512 + cbp + bj * HALF) = w;
                        else { *(u32x4*)(Kb + kr * 512 + cbp + bj * HALF) = w;
                            if (!sample) { float* s = stK + (size_t)r * 512 + cbl + bj * HALF; *(f32x4*)s = x1; *(f32x4*)(s + 16) = x2; } }
                    }
                }
        } else if (pn < 8) {
            const bool isv = pn < 6; const int cb = (pn & 1) * 256 + cp;
#pragma unroll
            for (int ai = 0; ai < 2; ++ai)
#pragma unroll
                for (int m = 0; m < 4; ++m) {
                    const int r = rbase + ai * HALF + m * 16;
                    const size_t orow = isv ? (size_t)krow_of(r) : (size_t)r;
                    bf16_t* base = (isv ? Vb : BG) + orow * 512 + cb;
#pragma unroll
                    for (int bj = 0; bj < 2; ++bj) {
                        const f32x4 x1 = acc[ai][bj][m][0], x2 = acc[ai][bj][m][1];
                        u32x4 w; w.x = pk2(x1[0], x1[1]); w.y = pk2(x1[2], x1[3]); w.z = pk2(x2[0], x2[1]); w.w = pk2(x2[2], x2[3]);
                        *(u32x4*)(base + bj * HALF) = w;
                        if (isv && !sample) { float* s = stV + (size_t)r * 512 + cb + bj * HALF; *(f32x4*)s = x1; *(f32x4*)(s + 4) = x2; }
                    }
                }
        } else {
            const int cb = (pn - 8) * 128 + cp;
#pragma unroll
            for (int ai = 0; ai < 2; ++ai)
#pragma unroll
                for (int m = 0; m < 4; ++m) {
                    const int r = rbase + ai * HALF + m * 16;
                    const f32x4 z1 = acc[ai][0][m][0] * acc[ai][1][m][0], z2 = acc[ai][0][m][1] * acc[ai][1][m][1];
                    u32x4 w; w.x = pk2(z1[0], z1[1]); w.y = pk2(z1[2], z1[3]); w.z = pk2(z2[0], z2[1]); w.w = pk2(z2[2], z2[3]);
                    *(u32x4*)(Z + (size_t)r * 512 + cb) = w;
                }
        }
    }
};
struct EpiSS {
    static constexpr bool PERM = true, AFTER_DRAIN = false; static constexpr int PROBE_ID = 2;
    bf16_t* O; float* SS;
    __device__ __forceinline__ void operator()(const f32x4 (&acc)[2][2][4][2], const Unit& u, int wr, int wc, int fr, int fq) const {
        const int rbase = u.pm * BM + wr * 64 + fr; const int c0 = u.pn * BM + wc * 32 + 8 * fq;
#pragma unroll
        for (int ai = 0; ai < 2; ++ai)
#pragma unroll
            for (int m = 0; m < 4; ++m) {
                const int r = rbase + ai * HALF + m * 16; float s = 0.f;
#pragma unroll
                for (int bj = 0; bj < 2; ++bj) {
                    const f32x4 v0 = acc[ai][bj][m][0], v1 = acc[ai][bj][m][1];
                    s += (v0[0] * v0[0] + v0[1] * v0[1]) + (v0[2] * v0[2] + v0[3] * v0[3]) + (v1[0] * v1[0] + v1[1] * v1[1]) + (v1[2] * v1[2] + v1[3] * v1[3]);
                    u32x4 w; w.x = pk2(v0[0], v0[1]); w.y = pk2(v0[2], v0[3]); w.z = pk2(v1[0], v1[1]); w.w = pk2(v1[2], v1[3]);
                    *(u32x4*)(O + (size_t)r * D + c0 + bj * HALF) = w;
                }
                s += __shfl_xor(s, 16); s += __shfl_xor(s, 32);
                if (fq == 0) SS[(size_t)r * 16 + u.pn * 4 + wc] = s;
            }
    }
};
struct EpiGlu {
    static constexpr bool PERM = true, AFTER_DRAIN = false; static constexpr int PROBE_ID = 3;
    bf16_t* H;
    __device__ __forceinline__ void operator()(const f32x4 (&acc)[2][2][4][2], const Unit& u, int wr, int wc, int fr, int fq) const {
        const int rbase = u.pm * BM + wr * 64 + fr; const int c0 = u.pn * HALF + wc * 32 + 8 * fq;
#pragma unroll
        for (int ai = 0; ai < 2; ++ai)
#pragma unroll
            for (int m = 0; m < 4; ++m) {
                const int r = rbase + ai * HALF + m * 16; f32x4 hv[2];
#pragma unroll
                for (int n = 0; n < 2; ++n) { const f32x4 g = acc[ai][0][m][n], up = acc[ai][1][m][n];
                    f32x4 e; e[0] = __builtin_amdgcn_exp2f(g[0]); e[1] = __builtin_amdgcn_exp2f(g[1]); e[2] = __builtin_amdgcn_exp2f(g[2]); e[3] = __builtin_amdgcn_exp2f(g[3]);
                    const f32x4 d = e + 1.0f;
                    f32x4 rc; rc[0] = __builtin_amdgcn_rcpf(d[0]); rc[1] = __builtin_amdgcn_rcpf(d[1]); rc[2] = __builtin_amdgcn_rcpf(d[2]); rc[3] = __builtin_amdgcn_rcpf(d[3]);
                    hv[n] = (g * up) * rc; }
                u32x4 w; w.x = pk2(hv[0][0], hv[0][1]); w.y = pk2(hv[0][2], hv[0][3]); w.z = pk2(hv[1][0], hv[1][1]); w.w = pk2(hv[1][2], hv[1][3]);
                *(u32x4*)(H + (size_t)r * DFF + c0) = w;
            }
    }
};
}

namespace att {
constexpr int TILEB = 16384, NSLOT = 3, VRING = NSLOT * TILEB, WSF_OFF = 2 * NSLOT * TILEB, LDS_NEED = WSF_OFF + NWAVES * 256;
static_assert(LDS_NEED <= 131072 && 4 * 32 * 128 * 4 <= WSF_OFF, "attention LDS");
constexpr float THR = 8.f;
__device__ __forceinline__ int crow(int r, int hi) { return (r & 3) + 8 * (r >> 2) + 4 * hi; }
__device__ __forceinline__ bf16x8 vfrag(const LAS char* p0, const LAS char* p1) {
    const v4i16_t lo = __builtin_amdgcn_ds_read_tr16_b64_v4i16((LAS v4i16_t*)p0), hi = __builtin_amdgcn_ds_read_tr16_b64_v4i16((LAS v4i16_t*)p1);
    return (bf16x8){lo[0], lo[1], lo[2], lo[3], hi[0], hi[1], hi[2], hi[3]};
}
__device__ __forceinline__ void glds16(const void* gsrc, unsigned lds_dst) { unsigned keep;
    asm volatile("s_mov_b32 %0, m0\n\ts_mov_b32 m0, %2\n\ts_nop 0\n\tglobal_load_lds_dwordx4 %1, off\n\ts_mov_b32 m0, %0" : "=&s"(keep) : "v"(gsrc), "s"(lds_dst) : "memory"); }
__device__ __forceinline__ void glds16s(const void* sbase, unsigned voff, unsigned lds_dst) { unsigned keep;
    asm volatile("s_mov_b32 %0, m0\n\ts_mov_b32 m0, %3\n\ts_nop 0\n\tglobal_load_lds_dwordx4 %1, %2\n\ts_mov_b32 m0, %0" : "=&s"(keep) : "v"(voff), "s"(sbase), "s"(lds_dst) : "memory"); }
__device__ __forceinline__ float swapmax(float m) { auto rr = __builtin_amdgcn_permlane32_swap(__float_as_uint(m), __float_as_uint(m), false, false); return fmaxf(__uint_as_float(rr[0]), __uint_as_float(rr[1])); }
#define ATT_WAIT_BAR(N) asm volatile("s_waitcnt vmcnt(" #N ") lgkmcnt(0)\n\ts_barrier" ::: "memory")
#define ATT_SB() __builtin_amdgcn_sched_barrier(0)
struct AttnCtx {
    LAS char* lds; LAS float* wsf; const char* kg; const char* vg; unsigned soff[2]; unsigned lds0; int ka[4]; int va[2][4]; int r32, hi, NT;
};
__device__ __forceinline__ float max3f(float a, float b, float c) { return fmaxf(fmaxf(a, b), c); }
template <bool LAST, int S0, bool DOMAX>
__device__ __forceinline__ void attn_step(const AttnCtx& C, int t, f32x16& P0, f32x16& P1, f32x16& N0, f32x16& N1, f32x16 (&o)[4], f32x16& negm, const bf16x8 (&qr)[4], float& mhat, float& l, float& rm) {
    constexpr int s0 = S0, s1 = (S0 + 1) % 3, s2 = (S0 + 2) % 3;
    const bool ik = (t + 3 < C.NT), iv = (t + 2 < C.NT);
    const LAS char* kb = C.lds + s1 * TILEB; const LAS char* vb = C.lds + s0 * TILEB;
    bf16x8 kf[8], vf[16];
#define ATT_KF(i) (*(const LAS bf16x8*)(kb + C.ka[(i) >> 1] + ((i) & 1) * 8192))
#define ATT_VF(n) vfrag(vb + C.va[0][(n) & 3] + ((n) >> 2) * 4096, vb + C.va[1][(n) & 3] + ((n) >> 2) * 4096)
    if (!LAST) { kf[0] = ATT_KF(0); kf[1] = ATT_KF(1); }
#ifdef PROBE_DMA2
    if (ik) { const char* p_ = C.kg + (size_t)(t + 3) * 65536; const unsigned d_ = (unsigned)__builtin_amdgcn_readfirstlane(C.lds0 + s0 * TILEB); glds16(p_ + C.soff[0], d_); glds16(p_ + C.soff[1], d_ + 1024); glds16(p_ + C.soff[0], d_); glds16(p_ + C.soff[1], d_ + 1024); }
    if (iv) { const char* p_ = C.vg + (size_t)(t + 2) * 65536; const unsigned d_ = (unsigned)__builtin_amdgcn_readfirstlane(C.lds0 + VRING + s2 * TILEB); glds16(p_ + C.soff[0], d_); glds16(p_ + C.soff[1], d_ + 1024); glds16(p_ + C.soff[0], d_); glds16(p_ + C.soff[1], d_ + 1024); }
#else
    if (ik) { const char* p_ = C.kg + (size_t)(t + 3) * 65536; const unsigned d_ = (unsigned)__builtin_amdgcn_readfirstlane(C.lds0 + s0 * TILEB); glds16s(p_, C.soff[0], d_); glds16s(p_, C.soff[1], d_ + 1024); }
    if (iv) { const char* p_ = C.vg + (size_t)(t + 2) * 65536; const unsigned d_ = (unsigned)__builtin_amdgcn_readfirstlane(C.lds0 + VRING + s2 * TILEB); glds16s(p_, C.soff[0], d_); glds16s(p_, C.soff[1], d_ + 1024); }
#endif
    ATT_SB();
    if (__any(rm > THR)) {
        const float dl = fmaxf(rm, 0.f);
        mhat += dl;
#pragma unroll
        for (int r = 0; r < 16; ++r) { P0[r] -= dl; P1[r] -= dl; negm[r] = -mhat; }
        const float f = __builtin_amdgcn_exp2f(-dl); l *= f;
        C.wsf[C.r32] = f;
#pragma unroll
        for (int r = 0; r < 16; ++r) { const float fr_ = C.wsf[crow(r, C.hi)];
#pragma unroll
            for (int db = 0; db < 4; ++db) o[db][r] *= fr_; }
    }
    ATT_SB();
    float ls = 0.f; v4u pwu[4]; float rn = -INFINITY;
#define ATT_SOFT(g) do { _Pragma("unroll") for (int e_ = ((g) < 4 ? 0 : 2 * ((g) - 4)); e_ < ((g) < 4 ? 0 : (2 * ((g) - 3) < 32 ? 2 * ((g) - 3) : 32)); ++e_) { \
        float x_; if (e_ < 16) { x_ = __builtin_amdgcn_exp2f(P0[e_ & 15]); P0[e_ & 15] = x_; } else { x_ = __builtin_amdgcn_exp2f(P1[e_ & 15]); P1[e_ & 15] = x_; } \
        ls += x_; \
        if (e_ & 1) { unsigned w_ = pk2(e_ < 16 ? P0[(e_ - 1) & 15] : P1[(e_ - 1) & 15], x_); asm volatile("" : "+v"(w_)); pwu[e_ >> 3][(e_ >> 1) & 3] = w_; } } \
        asm volatile("" : "+v"(ls)); \
        if (DOMAX && (g) >= 20) { _Pragma("unroll") for (int k_ = 4 * ((g) - 20); k_ < 4 * ((g) - 20) + 4; ++k_) rn = max3f(rn, N0[k_ & 15], N1[k_ & 15]); asm volatile("" : "+v"(rn)); } } while (0)
#pragma unroll
    for (int i = 0; i < 8; ++i) {
        if (!LAST) {
            if (i == 0)      N0 = __builtin_amdgcn_mfma_f32_32x32x16_bf16(kf[i], qr[i >> 1], negm, 0, 0, 0);
            else if (i == 1) N1 = __builtin_amdgcn_mfma_f32_32x32x16_bf16(kf[i], qr[i >> 1], negm, 0, 0, 0);
            else if (i & 1)  N1 = __builtin_amdgcn_mfma_f32_32x32x16_bf16(kf[i], qr[i >> 1], N1, 0, 0, 0);
            else             N0 = __builtin_amdgcn_mfma_f32_32x32x16_bf16(kf[i], qr[i >> 1], N0, 0, 0, 0);
            if (i < 6) kf[i + 2] = ATT_KF(i + 2);
        }
        if (i >= 6) vf[i - 6] = ATT_VF(i - 6);
        ATT_SOFT(i);
        ATT_SB();
    }
#pragma unroll
    for (int j = 0; j < 8; ++j) {
        o[j & 3] = __builtin_amdgcn_mfma_f32_32x32x16_bf16(__builtin_bit_cast(bf16x8, pwu[j >> 2]), vf[j], o[j & 3], 0, 0, 0);
        vf[j + 2] = ATT_VF(j + 2);
        ATT_SOFT(8 + j);
        ATT_SB();
    }
#pragma unroll
    for (int j = 0; j < 8; ++j) {
        o[j & 3] = __builtin_amdgcn_mfma_f32_32x32x16_bf16(__builtin_bit_cast(bf16x8, pwu[2 + (j >> 2)]), vf[8 + j], o[j & 3], 0, 0, 0);
        if (j < 6) vf[8 + j + 2] = ATT_VF(8 + j + 2);
        ATT_SOFT(16 + j);
        ATT_SB();
    }
#undef ATT_SOFT
#undef ATT_KF
#undef ATT_VF
    l += ls;
    if (DOMAX) rm = swapmax(rn); else rm = 0.f;
#ifdef PROBE_DMA2
    if (ik) ATT_WAIT_BAR(8); else if (iv) ATT_WAIT_BAR(4); else ATT_WAIT_BAR(0);
#else
    if (ik) ATT_WAIT_BAR(4); else if (iv) ATT_WAIT_BAR(2); else ATT_WAIT_BAR(0);
#endif
}
__device__ __forceinline__ void attn_unit(LAS char* lds, const bf16* Q, const bf16* Kb, const bf16* Vb, bf16* MIX, int qrow0, int krow0, int NT, int h, float lam, const float* gsub) {
    const int tid = threadIdx.x, lane = tid & 63, r32 = lane & 31, hi = lane >> 5; const int wid = __builtin_amdgcn_readfirstlane(tid >> 6), qg = wid & 3, map = wid >> 2;
    AttnCtx C; C.lds = lds; C.r32 = r32; C.hi = hi; C.NT = NT;
    C.kg = (const char*)Kb + ((size_t)krow0 * 512 + h * 128) * 2;
    C.vg = (const char*)Vb + ((size_t)krow0 * 512 + h * 128) * 2;
    C.wsf = (LAS float*)(lds + WSF_OFF) + wid * 64;
    LAS float* wsf = C.wsf;
#pragma unroll
    for (int j = 0; j < 2; ++j) { const int row = 8 * wid + 4 * j + (lane >> 4); const int sw = (((lane >> 4) & 3) << 2) | ((2 * wid + j) & 3); C.soff[j] = (unsigned)(row * 1024 + (((lane & 15) ^ sw) * 16)); }
    C.lds0 = (unsigned)(uintptr_t)lds + (unsigned)wid * 2048u;
#define ATT_DMAK(t, slot) do { const char* p_ = C.kg + (size_t)(t) * 65536; const unsigned d_ = (unsigned)__builtin_amdgcn_readfirstlane(C.lds0 + (slot) * TILEB); glds16(p_ + C.soff[0], d_); glds16(p_ + C.soff[1], d_ + 1024); } while (0)
#define ATT_DMAV(t, slot) do { const char* p_ = C.vg + (size_t)(t) * 65536; const unsigned d_ = (unsigned)__builtin_amdgcn_readfirstlane(C.lds0 + VRING + (slot) * TILEB); glds16(p_ + C.soff[0], d_); glds16(p_ + C.soff[1], d_ + 1024); } while (0)
    asm volatile("s_waitcnt vmcnt(0)" ::: "memory");
    ATT_DMAK(0, 0); ATT_DMAV(0, 0); ATT_DMAK(1, 1); ATT_DMAV(1, 1);
    if (NT > 2) ATT_DMAK(2, 2);
#undef ATT_DMAK
#undef ATT_DMAV
    bf16x8 qr[4];
    { const bf16* qp = Q + (size_t)(qrow0 + 32 * qg + r32) * 512 + h * 128 + map * 64 + hi * 8;
#pragma unroll
      for (int ds = 0; ds < 4; ++ds) qr[ds] = *(const bf16x8*)(qp + ds * 16); }
    { const int swk = ((r32 & 3) << 2) | ((r32 >> 2) & 3);
#pragma unroll
      for (int ds = 0; ds < 4; ++ds) C.ka[ds] = 256 * r32 + 16 * ((8 * map + 2 * ds + hi) ^ swk);
      const int q = (lane & 15) >> 2, p = lane & 3, blk = (lane >> 4) & 1;
#pragma unroll
      for (int hh = 0; hh < 2; ++hh)
#pragma unroll
          for (int db = 0; db < 4; ++db) { const int row = 4 * hi + q + 8 * hh; const int sw = (q << 2) | ((hi + 2 * hh) & 3); C.va[hh][db] = VRING + 256 * row + 16 * ((4 * db + 2 * blk + (p >> 1)) ^ sw) + 8 * (p & 1); } }
    f32x16 o[4];
#pragma unroll
    for (int i = 0; i < 4; ++i) o[i] = (f32x16){};
    float mhat = 0.f, l = 0.f, rm; f32x16 negm;
    ATT_WAIT_BAR(0);
    f32x16 pA0 = (f32x16){}, pA1 = (f32x16){}, pB0, pB1;
    {
#pragma unroll
        for (int ds = 0; ds < 4; ++ds) {
            const bf16x8 a0 = *(const LAS bf16x8*)(lds + C.ka[ds]), a1 = *(const LAS bf16x8*)(lds + C.ka[ds] + 8192);
            pA0 = __builtin_amdgcn_mfma_f32_32x32x16_bf16(a0, qr[ds], pA0, 0, 0, 0);
            pA1 = __builtin_amdgcn_mfma_f32_32x32x16_bf16(a1, qr[ds], pA1, 0, 0, 0);
        }
        float m0 = fmaxf(pA0[0], pA1[0]);
#pragma unroll
        for (int r = 1; r < 16; ++r) m0 = fmaxf(m0, fmaxf(pA0[r], pA1[r]));
        mhat = swapmax(m0); rm = 0.f;
#pragma unroll
        for (int r = 0; r < 16; ++r) { pA0[r] -= mhat; pA1[r] -= mhat; negm[r] = -mhat; }
    }
    asm volatile("s_waitcnt lgkmcnt(0)\n\ts_barrier" ::: "memory");
    static_assert((KV_PER_B / 64) % 6 == 2 && SEQ_P / 64 == 4, "attention step remainder");
#define ATT_STEP_AB(LASTF, SLOT, tt) attn_step<LASTF, SLOT, false>(C, (tt), pA0, pA1, pB0, pB1, o, negm, qr, mhat, l, rm)
#define ATT_STEP_BA(LASTF, SLOT, tt) attn_step<LASTF, SLOT, !(LASTF)>(C, (tt), pB0, pB1, pA0, pA1, o, negm, qr, mhat, l, rm)
    int t = 0;
    for (; t + 6 < NT; t += 6) {
        ATT_STEP_AB(false, 0, t); ATT_STEP_BA(false, 1, t + 1); ATT_STEP_AB(false, 2, t + 2);
        ATT_STEP_BA(false, 0, t + 3); ATT_STEP_AB(false, 1, t + 4); ATT_STEP_BA(false, 2, t + 5);
    }
    ATT_STEP_AB(false, 0, t);
    if (NT - t == 2) { ATT_STEP_BA(true, 1, t + 1); }
    else { ATT_STEP_BA(false, 1, t + 1); ATT_STEP_AB(false, 2, t + 2); ATT_STEP_BA(true, 0, t + 3); }
#undef ATT_STEP_AB
#undef ATT_STEP_BA
    l += __shfl_xor(l, 32);
    wsf[32 + r32] = l;
    float rl[16];
#pragma unroll
    for (int r = 0; r < 16; ++r) rl[r] = 1.0f / wsf[32 + crow(r, hi)];
    LAS float* X = (LAS float*)lds + qg * 4096;
    if (map == 1) {
#pragma unroll
        for (int r = 0; r < 16; ++r)
#pragma unroll
            for (int db = 0; db < 4; ++db) X[crow(r, hi) * 128 + db * 32 + r32] = o[db][r] * rl[r];
    }
    __syncthreads();
    if (map == 0) {
        float gs[4];
#pragma unroll
        for (int db = 0; db < 4; ++db) gs[db] = gsub[db * 32 + r32] * 0.8f;
#pragma unroll
        for (int r = 0; r < 16; ++r) {
            float ss = 0.f;
#pragma unroll
            for (int db = 0; db < 4; ++db) { const float v = o[db][r] * rl[r] - lam * X[crow(r, hi) * 128 + db * 32 + r32]; o[db][r] = v; ss += v * v; }
#pragma unroll
            for (int of = 1; of < 32; of <<= 1) ss += __shfl_xor(ss, of);
            const float rs = __builtin_amdgcn_rsqf(ss * (1.0f / 128.0f) + EPS);
            bf16* op = MIX + (size_t)(qrow0 + 32 * qg + crow(r, hi)) * D + h * 128 + r32;
#pragma unroll
            for (int db = 0; db < 4; ++db) op[db * 32] = (bf16)(pk2(o[db][r] * rs * gs[db], 0.f) & 0xffffu);
        }
    }
    __syncthreads();
}
}

struct Args { const float* in[23]; float* out; unsigned char* ws; int ph_lo, ph_hi; };
enum { I_XP = 0, I_XS, I_CK, I_CV, I_C, I_CCTX, I_WADA, I_BADA, I_GAPRE, I_GAPOST, I_GFPRE, I_GFPOST, I_WIN, I_CONVW, I_CONVB, I_LQ1, I_LK1, I_LQ2, I_LK2, I_GSUB, I_WOUT, I_WFI, I_WFO };
constexpr int N_PHASES = 9;

#define mod ((float*)(args.ws + WS_MOD))
#define rot ((float*)(args.ws + WS_ROT))
#define SS1 ((float*)(args.ws + WS_SS1))
#define SS2 ((float*)(args.ws + WS_SS2))
#define WinT ((bf16*)(args.ws + WS_WIN))
#define WoT ((bf16*)(args.ws + WS_WO))
#define WfiT ((bf16*)(args.ws + WS_WFI))
#define WfoT ((bf16*)(args.ws + WS_WFO))
#define U ((bf16*)(args.ws + WS_U))
#define MIXO ((bf16*)(args.ws + WS_MIXO))
#define Qb ((bf16*)(args.ws + WS_Q))
#define Kb ((bf16*)(args.ws + WS_K))
#define Vb ((bf16*)(args.ws + WS_V))
#define MIX ((bf16*)(args.ws + WS_MIX))
#define BG ((bf16*)(args.ws + WS_BG))
#define Z ((bf16*)(args.ws + WS_Z))
#define H ((bf16*)(args.ws + WS_H))
#define xp (args.in[I_XP])
#define xs (args.in[I_XS])
#define Y (args.out)
#define stK (args.out + (size_t)M * D)
#define stV (args.out + (size_t)M * D + (size_t)MP * 512)

namespace pg8 {
struct PanelOrder {
    int G, c, lo, hi;
    __device__ __forceinline__ bool next(int i, Unit& u) const { const int L = lo + i * G + c; if (L >= hi) return false; const int xcd = L & 7, w = L >> 3; u.pm = 18 * xcd + (w >> 2); u.pn = w & 3; return true; }
    __device__ __forceinline__ void a_ready(const Unit&) const {}
    __device__ __forceinline__ void done(const Unit&) const {}
};
}
__device__ __forceinline__ int rowmap(int e, bool late) { const int p = e >> 8; const int pm = late ? 18 * (p >> 1) + 16 + (p & 1) : 18 * (p >> 4) + (p & 15); return pm * 256 + (e & 255); }
__device__ __forceinline__ void tail_arrive(unsigned* cnt) {
    asm volatile("s_waitcnt vmcnt(0)" ::: "memory");
    __syncthreads();
    if (threadIdx.x == 0) {
        __builtin_amdgcn_fence(__ATOMIC_RELEASE, "agent");
        asm volatile("s_waitcnt vmcnt(0)" ::: "memory");
        (void)xb_add(cnt, 1u);
    }
}
__device__ __forceinline__ void tail_wait(unsigned* cnt, unsigned expect) {
    if (threadIdx.x == 0) {
        unsigned sp = 0u;
        while (xb_ld(cnt) < expect) { __builtin_amdgcn_s_sleep(1); if (++sp > (1u << 20)) break; }
        __builtin_amdgcn_fence(__ATOMIC_ACQUIRE, "agent");
        asm volatile("s_waitcnt vmcnt(0)" ::: "memory");
    }
    __syncthreads();
}
__device__ __forceinline__ void free_share(int f, int& e0, int& en) { if (f < 128) { e0 = f * 171; en = 171; } else { e0 = 128 * 171 + (f - 128) * 170; en = 170; } }
__device__ __forceinline__ void early_share(int bx, int na, int nb, int& e0, int& en) { if (bx < 64) { e0 = bx * nb; en = nb; } else { e0 = 64 * nb + (bx - 64) * na; en = na; } }
__device__ __forceinline__ void p5_rows(const Args& args, int e0, int en, bool late, int wave, int lane) {
        const float* gpo = args.in[I_GAPOST]; const float* gfp = args.in[I_GFPRE];
        for (int i0 = wave; i0 < en; i0 += 8 * 2) {
            f32x4 v[2][4]; v2u mo[2][4]; float ssp[2];
#pragma unroll
            for (int q = 0; q < 2; ++q) { const int idx = i0 + 8 * q; const int r = rowmap(e0 + idx, late); ssp[q] = 0.f;
                if (idx < en) { const float* xr = r < MP ? xp + (size_t)r * D : xs + (size_t)(r - MP) * D;
                    ssp[q] = SS1[(size_t)r * 16 + (lane & 15)];
#pragma unroll
                    for (int j = 0; j < 4; ++j) { v[q][j] = __builtin_nontemporal_load((const f32x4*)(xr + 4 * lane + 256 * j)); mo[q][j] = *(const v2u*)(MIXO + (size_t)r * D + 4 * lane + 256 * j); } } }
#pragma unroll
            for (int q = 0; q < 2; ++q) { const int idx = i0 + 8 * q; const int r = rowmap(e0 + idx, late);
                if (idx < en) {
                    const float* mp = mod + (r < MP ? 0 : 1 + ((r - MP) >> 12)) * 6144;
                    float sp = ssp[q]; sp += __shfl_xor(sp, 1); sp += __shfl_xor(sp, 2); sp += __shfl_xor(sp, 4); sp += __shfl_xor(sp, 8);
                    const float rstd1 = __builtin_amdgcn_rsqf(sp * (1.f / D) + EPS); float s = 0.f;
#pragma unroll
                    for (int j = 0; j < 4; ++j) { const int c = 4 * lane + 256 * j;
                        const f32x4 mf = (f32x4){__uint_as_float(mo[q][j][0] << 16), __uint_as_float(mo[q][j][0] & 0xffff0000u), __uint_as_float(mo[q][j][1] << 16), __uint_as_float(mo[q][j][1] & 0xffff0000u)};
                        const f32x4 gg = *(const f32x4*)(gpo + c), ga = *(const f32x4*)(mp + 2048 + c);
                        v[q][j] = v[q][j] + ga * (mf * rstd1 * gg);
                        s += (v[q][j][0] * v[q][j][0] + v[q][j][1] * v[q][j][1]) + (v[q][j][2] * v[q][j][2] + v[q][j][3] * v[q][j][3]); }
                    const float rstd = __builtin_amdgcn_rsqf(wave_sum(s) * (1.f / D) + EPS);
#pragma unroll
                    for (int j = 0; j < 4; ++j) { const int c = 4 * lane + 256 * j; const f32x4 gg = *(const f32x4*)(gfp + c), sh = *(const f32x4*)(mp + 3072 + c), sc = *(const f32x4*)(mp + 4096 + c);
                        const f32x4 u = v[q][j] * rstd * gg * (sc + 1.f) + sh;
                        *(v2u*)(U + (size_t)r * D + c) = (v2u){pk2(u[0], u[1]), pk2(u[2], u[3])}; } } }
        }
}
__device__ __forceinline__ void p8_rows(const Args& args, int e0, int en, bool late, int wave, int lane) {
        const float* gpo = args.in[I_GAPOST]; const float* gfo = args.in[I_GFPOST];
        for (int i0 = wave; i0 < en; i0 += 8 * 2) {
            f32x4 v[2][4]; v2u mo[2][4], fo[2][4]; float ssp1[2], ssp2[2];
#pragma unroll
            for (int q = 0; q < 2; ++q) { const int idx = i0 + 8 * q; const int r = rowmap(e0 + idx, late); ssp1[q] = 0.f; ssp2[q] = 0.f;
                if (idx < en) { const float* xr = r < MP ? xp + (size_t)r * D : xs + (size_t)(r - MP) * D;
                    ssp1[q] = SS1[(size_t)r * 16 + (lane & 15)]; ssp2[q] = SS2[(size_t)r * 16 + (lane & 15)];
#pragma unroll
                    for (int j = 0; j < 4; ++j) { v[q][j] = __builtin_nontemporal_load((const f32x4*)(xr + 4 * lane + 256 * j)); mo[q][j] = *(const v2u*)(MIXO + (size_t)r * D + 4 * lane + 256 * j); fo[q][j] = *(const v2u*)(U + (size_t)r * D + 4 * lane + 256 * j); } } }
#pragma unroll
            for (int q = 0; q < 2; ++q) { const int idx = i0 + 8 * q; const int r = rowmap(e0 + idx, late);
                if (idx < en) {
                    const float* mp = mod + (r < MP ? 0 : 1 + ((r - MP) >> 12)) * 6144;
                    float sp = ssp1[q]; sp += __shfl_xor(sp, 1); sp += __shfl_xor(sp, 2); sp += __shfl_xor(sp, 4); sp += __shfl_xor(sp, 8);
                    const float rstd1 = __builtin_amdgcn_rsqf(sp * (1.f / D) + EPS);
                    float sq = ssp2[q]; sq += __shfl_xor(sq, 1); sq += __shfl_xor(sq, 2); sq += __shfl_xor(sq, 4); sq += __shfl_xor(sq, 8);
                    const float rstd2 = __builtin_amdgcn_rsqf(sq * (1.f / D) + EPS);
#pragma unroll
                    for (int j = 0; j < 4; ++j) { const int c = 4 * lane + 256 * j;
                        const f32x4 mf = (f32x4){__uint_as_float(mo[q][j][0] << 16), __uint_as_float(mo[q][j][0] & 0xffff0000u), __uint_as_float(mo[q][j][1] << 16), __uint_as_float(mo[q][j][1] & 0xffff0000u)};
                        const f32x4 ff = (f32x4){__uint_as_float(fo[q][j][0] << 16), __uint_as_float(fo[q][j][0] & 0xffff0000u), __uint_as_float(fo[q][j][1] << 16), __uint_as_float(fo[q][j][1] & 0xffff0000u)};
                        const f32x4 gg = *(const f32x4*)(gpo + c), ga = *(const f32x4*)(mp + 2048 + c);
                        const f32x4 x1 = v[q][j] + ga * (mf * rstd1 * gg);
                        const f32x4 g2 = *(const f32x4*)(gfo + c), gf = *(const f32x4*)(mp + 5120 + c);
                        __builtin_nontemporal_store(x1 + gf * (ff * rstd2 * g2), (f32x4*)(Y + (size_t)r * D + c)); } } }
        }
}
struct P0Item { const float* W; bf16* WT; int K, N, dst_row0, src_col0, k0; bool rperm; float scale; };
__device__ __forceinline__ P0Item p0_item(const Args& args, int it) {
    constexpr int I_1 = 16 * 96, I_2 = 16 * 32, I_3 = 16 * 176;
    P0Item q; int r = it; q.rperm = false; q.scale = 1.0f;
    if (r < I_1) { const int kb = r / 96, nb = r % 96, n0 = 32 * nb; int src = n0;
        if (n0 >= 2048) { const int j = (n0 - 2048) >> 8, c = (n0 - 2048) & 255; src = c < 128 ? 2048 + 128 * j + c : 2560 + 128 * j + (c - 128); }
        q.W = args.in[I_WIN]; q.WT = WinT; q.K = D; q.N = NIN; q.dst_row0 = n0; q.src_col0 = src; q.k0 = 64 * kb; q.rperm = n0 < 1024; return q; }
    r -= I_1;
    if (r < I_2) { const int kb = r / 32, nb = r % 32; q.W = args.in[I_WOUT]; q.WT = WoT; q.K = D; q.N = D; q.dst_row0 = 32 * nb; q.src_col0 = 32 * nb; q.k0 = 64 * kb; return q; }
    r -= I_2;
    if (r < I_3) { const int kb = r / 176, nb = r % 176, n0 = 32 * nb; const int j = n0 >> 8, c = n0 & 255; const int src = c < 128 ? 128 * j + c : DFF + 128 * j + (c - 128);
        q.W = args.in[I_WFI]; q.WT = WfiT; q.K = D; q.N = NFI; q.dst_row0 = n0; q.src_col0 = src; q.k0 = 64 * kb;
        q.scale = c < 128 ? -1.4426950408889634f : -0.6931471805599453f; return q; }
    r -= I_3;
    { const int kb = r / 32, nb = r % 32; q.W = args.in[I_WFO]; q.WT = WfoT; q.K = DFF; q.N = D; q.dst_row0 = 32 * nb; q.src_col0 = 32 * nb; q.k0 = 64 * kb; return q; }
}
__device__ __forceinline__ void p0_item_load(const P0Item& q, float (&tv)[32], int lane) {
#pragma unroll
    for (int i = 0; i < 32; ++i) { const int kk = 2 * i + (lane >> 5); tv[i] = __builtin_nontemporal_load(q.W + (size_t)(q.k0 + kk) * q.N + q.src_col0 + (lane & 31)); }
}
__device__ __forceinline__ void p0_item_finish(const P0Item& q, const float (&tv)[32], LAS float* scr, int lane) {
#pragma unroll
    for (int i = 0; i < 32; ++i) { const int kk = 2 * i + (lane >> 5); scr[kk * 33 + (lane & 31)] = tv[i] * q.scale; }
    asm volatile("s_waitcnt lgkmcnt(0)" ::: "memory");
    const int c = lane & 7;
#pragma unroll
    for (int j = 0; j < 4; ++j) { const int n = (lane >> 3) + 8 * j; const int ns = q.rperm ? (16 * ((n >> 2) & 1) + 4 * (n >> 3) + (n & 3)) : n; const LAS float* s = scr + (8 * c) * 33 + ns;
        v4u o; o.x = pk2(s[0 * 33], s[1 * 33]); o.y = pk2(s[2 * 33], s[3 * 33]); o.z = pk2(s[4 * 33], s[5 * 33]); o.w = pk2(s[6 * 33], s[7 * 33]);
        *(v4u*)(q.WT + (size_t)(q.dst_row0 + n) * q.K + q.k0 + 8 * c) = o; }
    asm volatile("s_waitcnt lgkmcnt(0)" ::: "memory");
}

__device__ __forceinline__ void p0_transposes(const Args& args, int it0, int it1, int widx, int nw, LAS float* scr, int lane) {
    int it = it0 + widx;
    if (it < it1) {
        P0Item cur = p0_item(args, it); float ta[32], tb[32];
        p0_item_load(cur, ta, lane);
        for (;;) {
            const int nx = it + nw; const bool more = nx < it1; P0Item nxt = cur;
            if (more) { nxt = p0_item(args, nx); p0_item_load(nxt, tb, lane); }
            p0_item_finish(cur, ta, scr, lane);
            if (!more) break;
#pragma unroll
            for (int i = 0; i < 32; ++i) ta[i] = tb[i];
            cur = nxt; it = nx;
        }
    }
}
constexpr int IT_WIN = 16 * 96, IT_WO = IT_WIN + 16 * 32, IT_WFI = IT_WO + 16 * 176, IT_WFO = IT_WFI + 44 * 32;

__global__ void __launch_bounds__(NTHREADS, 2) fwd_megakernel(Args args) {
    extern __shared__ __attribute__((aligned(16))) unsigned char lds_raw[];
    LAS unsigned char* lds = (LAS unsigned char*)lds_raw;
    cg::grid_group grid = cg::this_grid();
    const int tid = threadIdx.x, lane = tid & 63; const int wave = __builtin_amdgcn_readfirstlane(tid >> 6);
    const int G = gridDim.x, bx = blockIdx.x;
    const int vcu = (G % 8 == 0) ? (bx % 8) * (G / 8) + bx / 8 : bx;
    const int gw = vcu * NWAVES + wave, NGW = G * NWAVES;
    unsigned char* ws = args.ws;
    const int lo = args.ph_lo, hi_ph = args.ph_hi;
#define IN(k) (lo <= (k) && (k) < hi_ph)
    if (tid < 16) ((LAS unsigned*)(lds + MISC_OFF))[tid] = 0u;
    __syncthreads();
    XcdBarrier bar = xcd_barrier_post((unsigned*)(ws + WS_BAR), (volatile LAS unsigned*)(lds + MISC_OFF));
    if (lo < 0) grid.sync();
#ifdef PROBE_BAR2
#define SEAM(k) do { if (IN(k) && IN((k) + 1)) { xcd_barrier(bar); xcd_barrier(bar); } } while (0)
#else
#define SEAM(k) do { if (IN(k) && IN((k) + 1)) xcd_barrier(bar); } while (0)
#endif

    if (IN(0)) {
#ifdef PROBE_P0
      for (int rep_ = 0; rep_ < 3; ++rep_) {
#endif
        if (bx < 192) {
            LAS float* S = (LAS float*)lds; LAS float* red = (LAS float*)(lds + 9 * 1024 * 4);
            { float cv[18];
#pragma unroll
              for (int u = 0; u < 18; ++u) { const int e = tid + u * NTHREADS, i = e >> 10, k = e & 1023; cv[u] = (i == 0) ? args.in[I_CCTX][k] : args.in[I_C][(i - 1) * 1024 + k]; }
#pragma unroll
              for (int u = 0; u < 18; ++u) S[tid + u * NTHREADS] = cv[u] / (1.f + __expf(-cv[u])); }
            __syncthreads();
            const int kgp = tid >> 5, cl = tid & 31, j0 = 32 * bx;
            float a[9];
#pragma unroll
            for (int i = 0; i < 9; ++i) a[i] = 0.f;
            const float* wp = args.in[I_WADA] + (size_t)(kgp * 64) * 6144 + j0 + cl;
            float wv[64];
#pragma unroll
            for (int k = 0; k < 64; ++k) wv[k] = __builtin_nontemporal_load(wp + (size_t)k * 6144);
#pragma unroll
            for (int k = 0; k < 64; ++k) {
#pragma unroll
                for (int i = 0; i < 9; ++i) a[i] += S[i * 1024 + kgp * 64 + k] * wv[k]; }
#pragma unroll
            for (int i = 0; i < 9; ++i) red[(kgp * 9 + i) * 32 + cl] = a[i];
            __syncthreads();
            if (tid < 288) { const int i = tid >> 5; float s = args.in[I_BADA][j0 + cl];
#pragma unroll
                for (int g = 0; g < 16; ++g) s += red[(g * 9 + i) * 32 + cl];
                mod[i * 6144 + j0 + cl] = s; }
            tail_arrive((unsigned*)(args.ws + WS_BAR) + 3712);
        }
        p0_transposes(args, 0, IT_WIN, gw, NGW, (LAS float*)(lds + wave * 16384), lane);
        {
            f32x4 cv0[2], cv1[2];
#pragma unroll
            for (int u = 0; u < 2; ++u) { const int ir = gw + u * NGW;
                if (ir < 2 * NB_S * PAST) { const int which = ir / (NB_S * PAST), rr = ir % (NB_S * PAST);
                    const float* src_ = args.in[which ? I_CV : I_CK] + (size_t)rr * 512 + lane * 8; cv0[u] = *(const f32x4*)src_; cv1[u] = *(const f32x4*)(src_ + 4); } }
#pragma unroll
            for (int u = 0; u < 2; ++u) { const int ir = gw + u * NGW;
                if (ir < 2 * NB_S * PAST) { const int which = ir / (NB_S * PAST), rr = ir % (NB_S * PAST), b = rr / PAST, j = rr % PAST;
                    bf16* drow = (which ? Vb : Kb) + (size_t)(MP + b * KV_PER_B + j) * 512;
                    if (which) *(v4u*)(drow + lane * 8) = (v4u){pk2(cv0[u][0], cv0[u][1]), pk2(cv0[u][2], cv0[u][3]), pk2(cv1[u][0], cv1[u][1]), pk2(cv1[u][2], cv1[u][3])};
                    else { const int l0 = lane * 8, g32 = l0 & ~31, la = l0 & 31, lb = la + 4;
                        *(v2u*)(drow + g32 + 8 * ((la >> 2) & 3) + 4 * (la >> 4)) = (v2u){pk2(cv0[u][0], cv0[u][1]), pk2(cv0[u][2], cv0[u][3])};
                        *(v2u*)(drow + g32 + 8 * ((lb >> 2) & 3) + 4 * (lb >> 4)) = (v2u){pk2(cv1[u][0], cv1[u][1]), pk2(cv1[u][2], cv1[u][3])}; } } }
            for (int ir = gw + 2 * NGW; ir < 2 * NB_S * PAST; ir += NGW) {
                const int which = ir / (NB_S * PAST), rr = ir % (NB_S * PAST), b = rr / PAST, j = rr % PAST;
                const float* src_ = args.in[which ? I_CV : I_CK] + (size_t)rr * 512 + lane * 8;
                const f32x4 v0 = *(const f32x4*)src_, v1 = *(const f32x4*)(src_ + 4);
                bf16* drow = (which ? Vb : Kb) + (size_t)(MP + b * KV_PER_B + j) * 512;
                if (which) *(v4u*)(drow + lane * 8) = (v4u){pk2(v0[0], v0[1]), pk2(v0[2], v0[3]), pk2(v1[0], v1[1]), pk2(v1[2], v1[3])};
                else { const int l0 = lane * 8, g32 = l0 & ~31, la = l0 & 31, lb = la + 4;
                    *(v2u*)(drow + g32 + 8 * ((la >> 2) & 3) + 4 * (la >> 4)) = (v2u){pk2(v0[0], v0[1]), pk2(v0[2], v0[3])};
                    *(v2u*)(drow + g32 + 8 * ((lb >> 2) & 3) + 4 * (lb >> 4)) = (v2u){pk2(v1[0], v1[1]), pk2(v1[2], v1[3])}; }
            }
        }
        if (bx == 255 || (G < 256 && bx == 0)) {
            for (int e = tid; e < 1024; e += NTHREADS) { const int pos = e >> 4, i = e & 15; const float inv = 1.0f / powf(10000.0f, (float)i / 16.0f); const float ang = (float)pos * inv; rot[e] = cosf(ang); rot[1024 + e] = sinf(ang); }
        }
#ifdef PROBE_P0
      __syncthreads(); }
#endif
    }
    if (IN(0) && IN(1)) tail_wait((unsigned*)(args.ws + WS_BAR) + 3712, 192u);

    if (IN(1)) {
        const float* g = args.in[I_GAPRE];
#ifdef PROBE_ROWS
        for (int rep_ = 0; rep_ < 2; ++rep_)
#endif
        for (int r0 = gw; r0 < M; r0 += 3 * NGW) {
            f32x4 v[3][4]; float s[3];
#pragma unroll
            for (int q = 0; q < 3; ++q) { const int r = r0 + q * NGW; s[q] = 0.f;
                if (r < M) { const float* xr = r < MP ? xp + (size_t)r * D : xs + (size_t)(r - MP) * D;
#pragma unroll
                    for (int j = 0; j < 4; ++j) v[q][j] = __builtin_nontemporal_load((const f32x4*)(xr + 4 * lane + 256 * j)); } }
#pragma unroll
            for (int q = 0; q < 3; ++q) { const int r = r0 + q * NGW;
                if (r < M) {
#pragma unroll
                    for (int j = 0; j < 4; ++j) s[q] += (v[q][j][0] * v[q][j][0] + v[q][j][1] * v[q][j][1]) + (v[q][j][2] * v[q][j][2] + v[q][j][3] * v[q][j][3]);
                    const float rstd = __builtin_amdgcn_rsqf(wave_sum(s[q]) * (1.f / D) + EPS);
                    const float* mp = mod + (r < MP ? 0 : 1 + ((r - MP) >> 12)) * 6144;
#pragma unroll
                    for (int j = 0; j < 4; ++j) { const int c = 4 * lane + 256 * j; const f32x4 gg = *(const f32x4*)(g + c), sh = *(const f32x4*)(mp + c), sc = *(const f32x4*)(mp + 1024 + c);
                        const f32x4 u = v[q][j] * rstd * gg * (sc + 1.f) + sh;
                        *(v2u*)(U + (size_t)r * D + c) = (v2u){pk2(u[0], u[1]), pk2(u[2], u[3])}; } } }
        }
    }
    SEAM(1);

    if (IN(2)) {
        pg8::Gemm g{U, WinT, M, NIN, D}; pg8::StaticOrder S; S.init(M, NIN, G, bx);
        pg8::EpiIn E{Qb, Kb, Vb, BG, Z, stK, stV, rot};
        pg8::gemm_phase<pg8::EpiIn, pg8::StaticOrder, PG8_ALIGN, PG8_SP2>(lds, g, S, E);
        if (G == 256 && bx >= 192) p0_transposes(args, IT_WIN, IT_WFI, (bx - 192) * NWAVES + wave, 64 * NWAVES, (LAS float*)(lds + wave * 16384), lane);
        else if (G != 256) p0_transposes(args, IT_WIN, IT_WFI, gw, NGW, (LAS float*)(lds + wave * 16384), lane);
#ifdef PROBE_GEMM2
        __syncthreads(); pg8::gemm_phase<pg8::EpiIn, pg8::StaticOrder, PG8_ALIGN, PG8_SP2>(lds, g, S, E);
#endif
    }
    SEAM(2);

    if (IN(3)) {
        {
            const float* cw = args.in[I_CONVW]; const float* cb = args.in[I_CONVB];
            const int c8 = (tid & 63) * 8;
            float w0[8], w1[8], w2[8], bb[8];
#pragma unroll
            for (int e = 0; e < 8; ++e) { w0[e] = cw[c8 + e]; w1[e] = cw[512 + c8 + e]; w2[e] = cw[1024 + c8 + e]; bb[e] = cb[c8 + e]; }
            const bool hasp = (G == 256) && (vcu < NB_P * 4 * 2); const int cn = (G == 256) ? (hasp ? 112 : 176) : (M + G - 1) / G; const int cbase = (G == 256) ? (hasp ? vcu * 112 : 128 * 112 + (vcu - 128) * 176) : vcu * cn;
#ifdef PROBE_CONV
            for (int rep_ = 0; rep_ < 3; ++rep_)
#endif
            for (int i0 = wave; i0 < cn; i0 += 24) {
                v4u zc[3], zp[3], zn[3], bg[3];
#pragma unroll
                for (int q = 0; q < 3; ++q) { const int idx = i0 + 8 * q; const int r = cbase + idx;
                    zp[q] = (v4u){0u, 0u, 0u, 0u}; zn[q] = (v4u){0u, 0u, 0u, 0u}; zc[q] = zp[q]; bg[q] = zp[q];
                    if (idx < cn && r < M) { const int t = r < MP ? (r & (SEQ_P - 1)) : ((r - MP) & (SEQ_S - 1)); const int L = r < MP ? SEQ_P : SEQ_S;
                        zc[q] = *(const v4u*)(Z + (size_t)r * 512 + c8); bg[q] = *(const v4u*)(BG + (size_t)r * 512 + c8);
                        if (t > 0) zp[q] = *(const v4u*)(Z + (size_t)(r - 1) * 512 + c8);
                        if (t < L - 1) zn[q] = *(const v4u*)(Z + (size_t)(r + 1) * 512 + c8); } }
#pragma unroll
                for (int q = 0; q < 3; ++q) { const int idx = i0 + 8 * q; const int r = cbase + idx;
                    if (idx < cn && r < M) { float o[8];
#pragma unroll
                        for (int e = 0; e < 4; ++e) {
                            const float zc0 = __uint_as_float(zc[q][e] << 16), zc1 = __uint_as_float(zc[q][e] & 0xffff0000u), zp0 = __uint_as_float(zp[q][e] << 16), zp1 = __uint_as_float(zp[q][e] & 0xffff0000u);
                            const float zn0 = __uint_as_float(zn[q][e] << 16), zn1 = __uint_as_float(zn[q][e] & 0xffff0000u), b0 = __uint_as_float(bg[q][e] << 16), b1 = __uint_as_float(bg[q][e] & 0xffff0000u);
                            o[2 * e] = b0 * (w0[2 * e] * zp0 + w1[2 * e] * zc0 + w2[2 * e] * zn0 + bb[2 * e]);
                            o[2 * e + 1] = b1 * (w0[2 * e + 1] * zp1 + w1[2 * e + 1] * zc1 + w2[2 * e + 1] * zn1 + bb[2 * e + 1]); }
                        *(v4u*)(MIX + (size_t)r * D + 512 + c8) = (v4u){pk2(o[0], o[1]), pk2(o[2], o[3]), pk2(o[4], o[5]), pk2(o[6], o[7])}; } }
            }
        }
        float lam;
        { const float a = args.in[I_LQ1][lane] * args.in[I_LK1][lane], b = args.in[I_LQ2][lane] * args.in[I_LK2][lane];
          lam = __expf(wave_sum(a)) - __expf(wave_sum(b)) + 0.2f; }
        __syncthreads();
        const float* gsub = args.in[I_GSUB];
        if (wave >= 4) __builtin_amdgcn_s_setprio(1);
        for (int i = vcu; i < NB_S * 4 * 32; i += G) {
            const int bh = (i >> 5) & 31, qb = i & 31; const int b = bh >> 2, h = bh & 3;
            att::attn_unit((LAS char*)lds, Qb, Kb, Vb, MIX, MP + b * SEQ_S + qb * 128, MP + b * KV_PER_B, KV_PER_B / 64, h, lam, gsub);
        }
#ifdef PROBE_ATT2
        for (int i = vcu; i < NB_S * 4 * 32; i += G) {
            const int bh = (i >> 5) & 31, qb = i & 31; const int b = bh >> 2, h = bh & 3;
            att::attn_unit((LAS char*)lds, Qb, Kb, Vb, MIX, MP + b * SEQ_S + qb * 128, MP + b * KV_PER_B, KV_PER_B / 64, h, lam, gsub);
        }
#endif
        for (int i = vcu; i < NB_P * 4 * 2; i += G) {
            const int b = i >> 3, h = (i >> 1) & 3, qb = i & 1;
            att::attn_unit((LAS char*)lds, Qb, Kb, Vb, MIX, b * SEQ_P + qb * 128, b * SEQ_P, SEQ_P / 64, h, lam, gsub);
        }
        __builtin_amdgcn_s_setprio(0);
    }
    SEAM(3);

    if (IN(4)) {
        pg8::Gemm g{MIX, WoT, M, D, D}; pg8::PanelOrder S{G, bx, 0, 512}; pg8::EpiSS E{MIXO, SS1};
        pg8::gemm_phase<pg8::EpiSS, pg8::PanelOrder, PG8_ALIGN, PG8_SP2>(lds, g, S, E);
    }
    SEAM(4);
    if (IN(5)) {
        unsigned* cnt = (unsigned*)(args.ws + WS_BAR) + 3584;
        if (bx < 64) { pg8::Gemm g{MIX, WoT, M, D, D}; pg8::PanelOrder S{G, bx, 512, 576}; pg8::EpiSS E{MIXO, SS1};
            pg8::gemm_phase<pg8::EpiSS, pg8::PanelOrder, PG8_ALIGN, PG8_SP2>(lds, g, S, E);
            tail_arrive(cnt); }
        int e0, en; early_share(bx, 144, 80, e0, en);
        p5_rows(args, e0, en, false, wave, lane);
        tail_wait(cnt, 64u);
        p5_rows(args, bx * 16, 16, true, wave, lane);
    }
    SEAM(5);
    if (IN(6)) {
        pg8::Gemm g{U, WfiT, M, NFI, D}; pg8::StaticOrder S; S.init(M, NFI, G, bx);
        pg8::EpiGlu E{H};
        pg8::gemm_phase<pg8::EpiGlu, pg8::StaticOrder, PG8_ALIGN, PG8_SP2>(lds, g, S, E);
        if (G == 256 && bx >= 96) p0_transposes(args, IT_WFI, IT_WFO, (bx - 96) * NWAVES + wave, 160 * NWAVES, (LAS float*)(lds + wave * 16384), lane);
        else if (G != 256) p0_transposes(args, IT_WFI, IT_WFO, gw, NGW, (LAS float*)(lds + wave * 16384), lane);
    }
    SEAM(6);
    if (IN(7)) {
        pg8::Gemm g{H, WfoT, M, D, DFF}; pg8::PanelOrder S{G, bx, 0, 512}; pg8::EpiSS E{U, SS2};
        pg8::gemm_phase<pg8::EpiSS, pg8::PanelOrder, PG8_ALIGN, PG8_SP2>(lds, g, S, E);
    }
    SEAM(7);
    if (IN(8)) {
        unsigned* cnt = (unsigned*)(args.ws + WS_BAR) + 3648;
        if (bx < 64) { pg8::Gemm g{H, WfoT, M, D, DFF}; pg8::PanelOrder S{G, bx, 512, 576}; pg8::EpiSS E{U, SS2};
            pg8::gemm_phase<pg8::EpiSS, pg8::PanelOrder, PG8_ALIGN, PG8_SP2>(lds, g, S, E);
            tail_arrive(cnt); }
        if (bx >= 64) { int e0, en; free_share(bx - 64, e0, en); p8_rows(args, e0, en, false, wave, lane); }
        tail_wait(cnt, 64u);
        p8_rows(args, bx * 16, 16, true, wave, lane);
    }
#undef IN
#undef SEAM
#undef mod
#undef rot
#undef SS1
#undef SS2
#undef WinT
#undef WoT
#undef WfiT
#undef WfoT
#undef U
#undef MIXO
#undef Qb
#undef Kb
#undef Vb
#undef MIX
#undef BG
#undef Z
#undef H
#undef xp
#undef xs
#undef Y
#undef stK
#undef stV
}

extern "C" void kernel_launch(void* const* d_in, const int* in_sizes, int n_in, void* d_out, int out_size, void* d_ws, size_t ws_size, hipStream_t stream) {
    static int grid = 0;
    if (grid == 0) {
        if (n_in != 23 || ws_size < WS_END || out_size != M * D + 2 * MP * 512) { fprintf(stderr, "kernel_launch: unexpected problem (n_in %d, ws %zu, out %d)\n", n_in, ws_size, out_size); grid = -1; return; }
        int dev = 0, cus = 0, per_cu = 0;
        hipGetDevice(&dev); hipDeviceGetAttribute(&cus, hipDeviceAttributeMultiprocessorCount, dev);
        if (hipFuncSetAttribute((const void*)fwd_megakernel, hipFuncAttributeMaxDynamicSharedMemorySize, LDS_BYTES) != hipSuccess) { fprintf(stderr, "kernel_launch: hipFuncSetAttribute failed\n"); grid = -1; return; }
        if (hipOccupancyMaxActiveBlocksPerMultiprocessor(&per_cu, (const void*)fwd_megakernel, NTHREADS, LDS_BYTES) != hipSuccess || per_cu < 1) { fprintf(stderr, "kernel_launch: occupancy query failed (%d)\n", per_cu); (void)hipGetLastError(); per_cu = 1; }
        grid = cus * 1;
        if (grid > cus * per_cu) grid = cus * per_cu;
    }
    if (grid < 0) return;
    Args a{};
    for (int i = 0; i < 23; ++i) a.in[i] = (const float*)d_in[i];
    a.out = (float*)d_out; a.ws = (unsigned char*)d_ws;
    if (hipMemsetAsync((char*)d_ws + WS_BAR, 0, BAR_BYTES, stream) != hipSuccess) { fprintf(stderr, "kernel_launch: memset failed\n"); return; }
#if MK_COOP
    a.ph_lo = 0; a.ph_hi = N_PHASES;
    void* kargs[] = {&a};
    hipError_t e = hipLaunchCooperativeKernel((const void*)fwd_megakernel, dim3(grid), dim3(NTHREADS), kargs, LDS_BYTES, stream);
    if (e != hipSuccess) fprintf(stderr, "cooperative launch failed: %s (grid %d)\n", hipGetErrorString(e), grid);
#else
    for (int p = 0; p < N_PHASES; ++p) { a.ph_lo = p; a.ph_hi = p + 1; hipLaunchKernelGGL(fwd_megakernel, dim3(grid), dim3(NTHREADS), LDS_BYTES, stream, a); }
#endif
}
```

```cpp
#include <hip/hip_runtime.h>
#include <hip/hip_cooperative_groups.h>
#include <cstdio>
#include <cstdint>
namespace cg = cooperative_groups;
namespace pg8 {
#define PG8_LAS __attribute__((address_space(3)))
typedef unsigned short bf16_t;
typedef short bf16x8 __attribute__((ext_vector_type(8)));
typedef float f32x4 __attribute__((ext_vector_type(4)));
typedef unsigned u32x4 __attribute__((ext_vector_type(4)));
constexpr int BM = 256, BK = 64, HALF = 128, HTB = HALF * BK * 2  , STAGE_BYTES = 8 * HTB, NXCD = 8, WGM = 8;

__host__ __device__ __forceinline__ int lds_byte(int r, int c) { const int st = (r >> 4) * 2 + (c >> 5), rr = r & 15, cc = c & 31, ob = rr * 64 + cc * 2; return st * 1024 + (ob ^ (((ob >> 9) & 1) << 5)); }
__host__ __device__ __forceinline__ void stage_rc(int b, int& R, int& C) { const int st = b / 1024, sb = b % 1024, swz = sb ^ (((sb >> 9) & 1) << 5); R = (st >> 1) * 16 + swz / 64; C = (st & 1) * 32 + (swz % 64) / 2; }
__host__ __device__ __forceinline__ int perm32(int rho) { const int n = rho >> 4, i = rho & 15; return 8 * (i >> 2) + 4 * n + (i & 3); }

struct Unit { int pm, pn; };
struct Gemm { const bf16_t* A; const bf16_t* Bt; int M, N, K; };

struct StaticOrder {
    int nM, nN, nwg, G, c;
    __host__ __device__ void init(int M, int N, int G_, int c_) { nM = M / BM; nN = N / BM; nwg = nM * nN; G = G_; c = c_; }
    __host__ __device__ bool next(int i, Unit& u) const {
        const long L = (long)i * G + c; if (L >= nwg) return false;
        int wgid = (int)L; { const int q = nwg / NXCD, r = nwg % NXCD, xcd = wgid % NXCD, off = wgid / NXCD; wgid = (xcd < r ? xcd * (q + 1) : r * (q + 1) + (xcd - r) * q) + off; }
        const int nig = WGM * nN, gid = wgid / nig, fm = gid * WGM, gsz = (nM - fm) < WGM ? (nM - fm) : WGM;
        u.pm = fm + ((wgid % nig) % gsz); u.pn = (wgid % nig) / gsz; return true;
    }
    __device__ __forceinline__ void a_ready(const Unit&) const {}
    __device__ __forceinline__ void done(const Unit&) const {}
};

__device__ __forceinline__ unsigned cvt_pk_bf16(float lo, float hi) { unsigned r; asm volatile("v_cvt_pk_bf16_f32 %0, %1, %2" : "=v"(r) : "v"(lo), "v"(hi)); return r; }
template <class Epi, class Sched, bool ALIGN_EPI = false, bool SP2 = false>
__device__ __forceinline__ void gemm_phase(PG8_LAS unsigned char* lds, const Gemm g, const Sched& S, const Epi& E) {
    const int tid = threadIdx.x, wid = __builtin_amdgcn_readfirstlane(tid >> 6), lane = tid & 63, wr = wid >> 2, wc = wid & 3, fr = lane & 15, fq = lane >> 4;
    const int K = g.K, nt = K / BK;
    unsigned voffA[2], voffB[2];
#pragma unroll
    for (int i = 0; i < 2; ++i) { int R, C; stage_rc(tid * 16 + i * 8192, R, C); const int Rb = Epi::PERM ? ((R & ~31) + perm32(R & 31)) : R;
        voffA[i] = (unsigned)(R * K + C) * 2u; voffB[i] = (unsigned)(Rb * K + C) * 2u; }
    const size_t kstep = (size_t)(BK * 2);
    const size_t hstep = (size_t)HALF * K * 2;
    const size_t tstep = 2 * hstep;
    const unsigned ldsw = (unsigned)wid * 1024u;
    const int aoff = lds_byte(wr * 64 + fr, fq * 8), boff = lds_byte(wc * 32 + fr, fq * 8);
#define PG8_SA(b, h) (((b) * 2 + (h)) * HTB)
#define PG8_SB(b, h) ((4 + (b) * 2 + (h)) * HTB)
#define PG8_STAGE(bufoff, gbase, voff) do { _Pragma("unroll") for (int _i = 0; _i < 2; ++_i) \
        __builtin_amdgcn_global_load_lds((const unsigned*)((const char*)(gbase) + (voff)[_i]), (PG8_LAS unsigned*)(lds + (bufoff) + ldsw + _i * 8192), 16, 0, 0); } while (0)
#define PG8_LDA(dst, b, h) do { _Pragma("unroll") for (int m = 0; m < 4; ++m) _Pragma("unroll") for (int k = 0; k < 2; ++k) dst[m][k] = *(const PG8_LAS bf16x8*)(lds + PG8_SA(b, h) + aoff + m * 2048 + k * 1024); } while (0)
#define PG8_LDB(dst, b, h) do { _Pragma("unroll") for (int n = 0; n < 2; ++n) _Pragma("unroll") for (int k = 0; k < 2; ++k) dst[n][k] = *(const PG8_LAS bf16x8*)(lds + PG8_SB(b, h) + boff + n * 2048 + k * 1024); } while (0)
#define PG8_MMA(ai, bj, At, Bt) do { __builtin_amdgcn_s_setprio(1); _Pragma("unroll") for (int m = 0; m < 4; ++m) _Pragma("unroll") for (int n = 0; n < 2; ++n) _Pragma("unroll") for (int k = 0; k < 2; ++k) \
        acc[ai][bj][m][n] = __builtin_amdgcn_mfma_f32_16x16x32_bf16(Bt[n][k], At[m][k], acc[ai][bj][m][n], 0, 0, 0); __builtin_amdgcn_s_setprio(0); } while (0)
#define PG8_WAIT_V(n) asm volatile("s_waitcnt vmcnt(" #n ")" ::: "memory")
#define PG8_WAIT_L(n) asm volatile("s_waitcnt lgkmcnt(" #n ")" ::: "memory")
#define PG8_BAR __builtin_amdgcn_s_barrier()
#define PG8_SCHED __builtin_amdgcn_sched_barrier(0)
    Unit cur, nxt; int ui = 0;
    if (!S.next(0, cur)) return;
    f32x4 acc[2][2][4][2];
#pragma unroll
    for (int a = 0; a < 2; ++a)
#pragma unroll
        for (int b = 0; b < 2; ++b)
#pragma unroll
            for (int m = 0; m < 4; ++m)
#pragma unroll
                for (int n = 0; n < 2; ++n) acc[a][b][m][n] = (f32x4){0.f, 0.f, 0.f, 0.f};
    bf16x8 At[4][2], B0[2][2], B1[2][2];
    const char* cA = (const char*)g.A + (size_t)cur.pm * tstep; const char* cB = (const char*)g.Bt + (size_t)cur.pn * tstep;
    S.a_ready(cur);
    if constexpr (SP2) {
        PG8_STAGE(PG8_SB(0, 0), cB, voffB); PG8_STAGE(PG8_SB(0, 1), cB + hstep, voffB); PG8_STAGE(PG8_SA(0, 0), cA, voffA); PG8_STAGE(PG8_SA(0, 1), cA + hstep, voffA);
        if (wr == 1) PG8_BAR;
        PG8_WAIT_V(2); PG8_BAR;
        PG8_STAGE(PG8_SB(1, 0), cB + kstep, voffB); PG8_STAGE(PG8_SA(1, 0), cA + kstep, voffA); PG8_STAGE(PG8_SB(1, 1), cB + hstep + kstep, voffB);
        PG8_WAIT_V(6); PG8_BAR;
    } else {
        PG8_STAGE(PG8_SB(0, 0), cB, voffB); PG8_STAGE(PG8_SA(0, 0), cA, voffA); PG8_STAGE(PG8_SB(0, 1), cB + hstep, voffB); PG8_STAGE(PG8_SA(0, 1), cA + hstep, voffA);
        if (wr == 1) PG8_BAR;
        PG8_WAIT_V(4); PG8_BAR;
        PG8_STAGE(PG8_SB(1, 0), cB + kstep, voffB); PG8_STAGE(PG8_SA(1, 0), cA + kstep, voffA); PG8_STAGE(PG8_SB(1, 1), cB + hstep + kstep, voffB);
        PG8_WAIT_V(6); PG8_BAR;
    }
    for (;;) {
        const bool has_next = S.next(ui + 1, nxt);
        const char* nA = has_next ? (const char*)g.A + (size_t)nxt.pm * tstep : cA; const char* nB = has_next ? (const char*)g.Bt + (size_t)nxt.pn * tstep : cB;
        for (int t = 0; t < nt; t += 2) {
            const bool last = (t == nt - 2);
            const char* a1 = cA + (size_t)(t + 1) * kstep;
            const char* a2 = last ? nA : cA + (size_t)(t + 2) * kstep; const char* b2 = last ? nB : cB + (size_t)(t + 2) * kstep;
            const char* a3 = a2 + kstep; const char* b3 = b2 + kstep;
            if (last && has_next) S.a_ready(nxt);
            if constexpr (SP2) {
            PG8_LDB(B0, 0, 0); PG8_LDB(B1, 0, 1); PG8_SCHED; PG8_LDA(At, 0, 0); PG8_STAGE(PG8_SA(1, 1), a1 + hstep, voffA);
            PG8_WAIT_V(8); PG8_WAIT_L(0); PG8_BAR; PG8_MMA(0, 0, At, B0); PG8_MMA(0, 1, At, B1); PG8_BAR; PG8_SCHED;
            PG8_LDA(At, 0, 1); PG8_STAGE(PG8_SB(0, 0), b2, voffB); PG8_STAGE(PG8_SB(0, 1), b2 + hstep, voffB); PG8_STAGE(PG8_SA(0, 0), a2, voffA);
            PG8_WAIT_V(8); PG8_WAIT_L(0); PG8_BAR; PG8_MMA(1, 0, At, B0); PG8_MMA(1, 1, At, B1); PG8_BAR; PG8_SCHED;
            PG8_LDB(B0, 1, 0); PG8_LDB(B1, 1, 1); PG8_SCHED; PG8_LDA(At, 1, 0); PG8_STAGE(PG8_SA(0, 1), a2 + hstep, voffA);
            PG8_WAIT_V(8); PG8_WAIT_L(0); PG8_BAR; PG8_MMA(0, 0, At, B0); PG8_MMA(0, 1, At, B1); PG8_BAR; PG8_SCHED;
            PG8_LDA(At, 1, 1); PG8_STAGE(PG8_SB(1, 0), b3, voffB); PG8_STAGE(PG8_SB(1, 1), b3 + hstep, voffB); PG8_STAGE(PG8_SA(1, 0), a3, voffA);
            PG8_WAIT_V(8); PG8_WAIT_L(0); PG8_BAR; PG8_MMA(1, 0, At, B0); PG8_MMA(1, 1, At, B1); PG8_BAR; PG8_SCHED;
            } else {
            PG8_LDB(B0, 0, 0); PG8_SCHED; PG8_LDA(At, 0, 0); PG8_STAGE(PG8_SA(1, 1), a1 + hstep, voffA);
            PG8_WAIT_L(8); PG8_BAR; PG8_WAIT_L(0); PG8_MMA(0, 0, At, B0); PG8_BAR; PG8_SCHED;
            PG8_LDB(B1, 0, 1); PG8_STAGE(PG8_SB(0, 0), b2, voffB);
            PG8_BAR; PG8_WAIT_L(0); PG8_MMA(0, 1, At, B1); PG8_BAR;
            PG8_LDA(At, 0, 1); PG8_STAGE(PG8_SA(0, 0), a2, voffA);
            PG8_BAR; PG8_WAIT_L(0); PG8_MMA(1, 0, At, B0); PG8_BAR; PG8_SCHED;
            PG8_STAGE(PG8_SB(0, 1), b2 + hstep, voffB);
            PG8_WAIT_V(6); PG8_BAR; PG8_MMA(1, 1, At, B1); PG8_BAR;
            PG8_LDB(B0, 1, 0); PG8_SCHED; PG8_LDA(At, 1, 0); PG8_STAGE(PG8_SA(0, 1), a2 + hstep, voffA);
            PG8_WAIT_L(8); PG8_BAR; PG8_WAIT_L(0); PG8_MMA(0, 0, At, B0); PG8_BAR; PG8_SCHED;
            PG8_LDB(B1, 1, 1); PG8_STAGE(PG8_SB(1, 0), b3, voffB);
            PG8_BAR; PG8_WAIT_L(0); PG8_MMA(0, 1, At, B1); PG8_BAR;
            PG8_LDA(At, 1, 1); PG8_STAGE(PG8_SA(1, 0), a3, voffA);
            PG8_BAR; PG8_WAIT_L(0); PG8_MMA(1, 0, At, B0); PG8_BAR; PG8_SCHED;
            PG8_STAGE(PG8_SB(1, 1), b3 + hstep, voffB);
            PG8_WAIT_V(6); PG8_BAR; PG8_MMA(1, 1, At, B1); PG8_BAR;
            }
        }
        if constexpr (ALIGN_EPI) { if (wr == 0) PG8_BAR; }
        if constexpr (!Epi::AFTER_DRAIN) { E(acc, cur, wr, wc, fr, fq);
#ifdef PROBE_EPI2
            if constexpr (Epi::PROBE_ID == PROBE_EPI2) { asm volatile("" ::: "memory"); E(acc, cur, wr, wc, fr, fq); }
#endif
            S.done(cur); }
        if (!has_next) break;
#pragma unroll
        for (int a = 0; a < 2; ++a)
#pragma unroll
            for (int b = 0; b < 2; ++b)
#pragma unroll
                for (int m = 0; m < 4; ++m)
#pragma unroll
                    for (int n = 0; n < 2; ++n) acc[a][b][m][n] = (f32x4){0.f, 0.f, 0.f, 0.f};
        cur = nxt; cA = nA; cB = nB; ++ui;
        if constexpr (ALIGN_EPI) { if (wr == 1) PG8_BAR; }
    }
    PG8_WAIT_V(0);
    if constexpr (!ALIGN_EPI) { if (wr == 0) PG8_BAR; }
    PG8_BAR;
    if constexpr (Epi::AFTER_DRAIN) { E.fused(acc, cur, wr, wc, fr, fq, lds, wid, lane); S.done(cur); }
#undef PG8_SA
#undef PG8_SB
#undef PG8_STAGE
#undef PG8_LDA
#undef PG8_LDB
#undef PG8_MMA
#undef PG8_WAIT_V
#undef PG8_WAIT_L
#undef PG8_BAR
#undef PG8_SCHED
}
}
#ifndef PG8_SP2
#define PG8_SP2 true
#endif
#ifndef PG8_ALIGN
#define PG8_ALIGN true
#endif
#ifndef MK_COOP
#define MK_COOP 1
#endif

#define LAS __attribute__((address_space(3)))
typedef unsigned short bf16;
typedef unsigned v4u __attribute__((ext_vector_type(4)));
typedef unsigned v2u __attribute__((ext_vector_type(2)));
typedef float f32x4 __attribute__((ext_vector_type(4)));
typedef float f32x16 __attribute__((ext_vector_type(16)));
typedef short bf16x8 __attribute__((ext_vector_type(8)));
typedef short v4i16_t __attribute__((ext_vector_type(4)));
typedef float f32x2_t __attribute__((ext_vector_type(2)));
typedef __bf16 bf16x2_t __attribute__((ext_vector_type(2)));

constexpr int D = 1024, MP = 4096, MS = 32768, M = MP + MS, NIN = 3072, DFF = 2816, NFI = 2 * DFF;
constexpr int SEQ_P = 256, SEQ_S = 4096, PAST = 256, NB_S = 8, NB_P = 16;
constexpr int KV_PER_B = PAST + SEQ_S;
constexpr int KROWS = MP + NB_S * KV_PER_B;
constexpr float EPS = 1e-6f;
constexpr float QSCALE = 0.125f * 1.4426950408889634f;
constexpr int NWAVES = 8, NTHREADS = 512;

constexpr size_t MiB = 1u << 20;
constexpr size_t WS_MOD = 0;
constexpr size_t WS_ROT = 256 * 1024;
constexpr size_t WS_BAR = 512 * 1024, BAR_BYTES = 16384;
constexpr size_t WS_SS1 = 1 * MiB;
constexpr size_t WS_SS2 = 4 * MiB;
constexpr size_t WS_WIN = 8 * MiB, WS_WO = 14 * MiB, WS_WFI = 16 * MiB, WS_WFO = 27 * MiB;
constexpr size_t WS_U = 34 * MiB;
constexpr size_t WS_MIXO = 106 * MiB;
constexpr size_t WS_Q = 178 * MiB;
constexpr size_t WS_K = 214 * MiB;
constexpr size_t WS_V = 252 * MiB;
constexpr size_t WS_MIX = 290 * MiB;
constexpr size_t WS_BG = 362 * MiB;
constexpr size_t WS_Z = 398 * MiB;
constexpr size_t WS_H = 178 * MiB;
constexpr size_t WS_END = 434 * MiB;
static_assert(WS_H + (size_t)M * DFF * 2 <= WS_Z, "H overlay");
static_assert(WS_K + (size_t)KROWS * 512 * 2 <= WS_V && WS_V + (size_t)KROWS * 512 * 2 <= WS_MIX, "kv map");

constexpr int MISC_OFF = 131072 + 1024;
constexpr int LDS_BYTES = 131072 + 2048;

__device__ __forceinline__ unsigned pk2(float lo, float hi) { f32x2_t v = {lo, hi}; bf16x2_t b = __builtin_convertvector(v, bf16x2_t); return __builtin_bit_cast(unsigned, b); }
__device__ __forceinline__ float bf2f(unsigned short b) { return __uint_as_float((unsigned)b << 16); }
template <int CTRL> __device__ __forceinline__ float dpp_mov(float v) { return __builtin_bit_cast(float, __builtin_amdgcn_mov_dpp(__builtin_bit_cast(int, v), CTRL, 0xF, 0xF, false)); }
__device__ __forceinline__ float row16_sum(float v) {
    v += dpp_mov<0xB1>(v);
    v += dpp_mov<0x4E>(v);
    v += dpp_mov<0x124>(v);
    v += dpp_mov<0x128>(v);
    return v;
}
__device__ __forceinline__ float add_swap16(float v) { auto rr = __builtin_amdgcn_permlane16_swap(__float_as_uint(v), __float_as_uint(v), false, false); return __uint_as_float(rr[0]) + __uint_as_float(rr[1]); }
__device__ __forceinline__ float add_swap32(float v) { auto rr = __builtin_amdgcn_permlane32_swap(__float_as_uint(v), __float_as_uint(v), false, false); return __uint_as_float(rr[0]) + __uint_as_float(rr[1]); }
__device__ __forceinline__ float wave_sum(float v) { return add_swap32(add_swap16(row16_sum(v))); }
__device__ __forceinline__ int krow_of(int r) { return r < MP ? r : MP + ((r - MP) >> 12) * KV_PER_B + PAST + ((r - MP) & 4095); }

#define XB_TMO      128
#define XB_XCNT(j)  (256  + 64 * (j))
#define XB_XSUB(j)  (1280 + 64 * (j))
#define XB_XGEN(j)  (2304 + 64 * (j))
#define XB_TOP      3328
#define XB_TOPGEN   3392
#define XCD_BAR_WORDS 3456
#define XB_SPIN_CAP (1u << 18)

__device__ __forceinline__ unsigned xb_ld(unsigned* p)              { return __hip_atomic_load(p, __ATOMIC_RELAXED, __HIP_MEMORY_SCOPE_AGENT); }
__device__ __forceinline__ unsigned xb_add(unsigned* p, unsigned v) { return __hip_atomic_fetch_add(p, v, __ATOMIC_RELAXED, __HIP_MEMORY_SCOPE_AGENT); }
__device__ __forceinline__ unsigned xb_xcc_id() { return (unsigned)__builtin_amdgcn_s_getreg((3 << 11) | 20) & 0xFu; }
#define XB_SPIN(cond, bar) do { unsigned _sp = 0; while (cond) { __builtin_amdgcn_s_sleep(1); \
    if ((++_sp & 255u) == 0u) { if (xb_ld(&(bar)[XB_TMO])) break; if (_sp > XB_SPIN_CAP) { atomicAdd(&(bar)[XB_TMO], 1u); break; } } } } while (0)

struct XcdBarrier {
    unsigned* bar; unsigned x;
    volatile LAS unsigned* st;
};

__device__ __forceinline__ XcdBarrier xcd_barrier_post(unsigned* bar, volatile LAS unsigned* st) {
    XcdBarrier b; b.bar = bar; b.x = xb_xcc_id(); b.st = st;
    if (threadIdx.x == 0) (void)xb_add(&bar[XB_XCNT(b.x)], 1u);
    return b;
}
__device__ __forceinline__ void xcd_barrier_complete(unsigned* bar, unsigned x, unsigned& nloc, unsigned& nx) {
    const unsigned G = gridDim.x * gridDim.y * gridDim.z;
    unsigned sum, cnt, mine, sp = 0u;
    for (;;) {
        sum = 0u; cnt = 0u; mine = 0u;
#pragma unroll
        for (unsigned j = 0; j < 16; ++j) { const unsigned c = xb_ld(&bar[XB_XCNT(j)]); sum += c; cnt += (c > 0u) ? 1u : 0u; mine = (j == x) ? c : mine; }
        if (sum == G) break;
        __builtin_amdgcn_s_sleep(1);
        if ((++sp & 255u) == 0u) { if (xb_ld(&bar[XB_TMO])) break; if (sp > XB_SPIN_CAP) { atomicAdd(&bar[XB_TMO], 1u); break; } }
    }
    nloc = mine > 0u ? mine : 1u; nx = cnt > 0u ? cnt : 1u;
}

__device__ __forceinline__ void xcd_barrier(const XcdBarrier& b) {
    asm volatile("s_waitcnt vmcnt(0)" ::: "memory");
    __syncthreads();
    if (threadIdx.x == 0) {
        unsigned* bar = b.bar;
        __builtin_amdgcn_s_waitcnt(0);
        unsigned nloc = b.st[0], nx = b.st[1];
        if (nloc == 0u) { xcd_barrier_complete(bar, b.x, nloc, nx); b.st[0] = nloc; b.st[1] = nx; }
        const unsigned old = xb_add(&bar[XB_XSUB(b.x)], 1u);
        const unsigned gen = old / nloc;
        if (old + 1u == (gen + 1u) * nloc) {
            __builtin_amdgcn_fence(__ATOMIC_RELEASE, "agent");
            asm volatile("s_waitcnt vmcnt(0)" ::: "memory");
            const unsigned og = xb_add(&bar[XB_TOP], 1u);
            const unsigned tg = og / nx;
            if (og + 1u == (tg + 1u) * nx) xb_add(&bar[XB_TOPGEN], 1u);
            else XB_SPIN(xb_ld(&bar[XB_TOPGEN]) == tg, bar);
            __builtin_amdgcn_fence(__ATOMIC_ACQUIRE, "agent");
            xb_add(&bar[XB_XGEN(b.x)], 1u);
            asm volatile("s_waitcnt vmcnt(0)" ::: "memory");
        } else {
            XB_SPIN(xb_ld(&bar[XB_XGEN(b.x)]) == gen, bar);
            __builtin_amdgcn_fence(__ATOMIC_ACQUIRE, "agent");
            asm volatile("s_waitcnt vmcnt(0)" ::: "memory");
        }
    }
    __syncthreads();
}

namespace pg8 {
struct EpiIn {
    static constexpr bool PERM = true, AFTER_DRAIN = false; static constexpr int PROBE_ID = 1;
    bf16_t *Q, *Kb, *Vb, *BG, *Z; float *stK, *stV; const float* rot;
    __device__ __forceinline__ void operator()(const f32x4 (&acc)[2][2][4][2], const Unit& u, int wr, int wc, int fr, int fq) const {
        const int pn = u.pn; const bool sample = u.pm >= (MP / 256);
        const int rbase = u.pm * BM + wr * 64 + fr;
        const int cp = wc * 32 + 8 * fq;
        if (pn < 4) {
            const bool isq = pn < 2; const int cbp = (pn & 1) * 256 + cp, cbl = (pn & 1) * 256 + wc * 32 + 4 * fq;
            const float qs = isq ? QSCALE : 1.0f;
#pragma unroll
            for (int ai = 0; ai < 2; ++ai)
#pragma unroll
                for (int m = 0; m < 4; ++m) {
                    const int r = rbase + ai * HALF + m * 16;
                    f32x4 cs = (f32x4){1.f, 1.f, 1.f, 1.f}, sn = (f32x4){0.f, 0.f, 0.f, 0.f};
                    if (sample) { const int t = (r - MP) & 4095; const int pos = (wc & 1) ? (t & 63) : (t >> 6);
                        cs = *(const f32x4*)(rot + pos * 16 + 4 * fq); sn = *(const f32x4*)(rot + 1024 + pos * 16 + 4 * fq); }
                    cs = cs * qs; sn = sn * qs;
                    const size_t kr = (size_t)krow_of(r);
#pragma unroll
                    for (int bj = 0; bj < 2; ++bj) {
                        const f32x4 x1 = acc[ai][bj][m][0], x2 = acc[ai][bj][m][1];
                        const f32x4 o1 = x1 * cs - x2 * sn, o2 = x2 * cs + x1 * sn;
                        u32x4 w; w.x = pk2(o1[0], o1[1]); w.y = pk2(o1[2], o1[3]); w.z = pk2(o2[0], o2[1]); w.w = pk2(o2[2], o2[3]);
                        if (isq) *(u32x4*)(Q + (size_t)r * 512 + cbp + bj * HALF) = w;
                        else { *(u32x4*)(Kb + kr * 512 + cbp + bj * HALF) = w;
                            if (!sample) { float* s = stK + (size_t)r * 512 + cbl + bj * HALF; *(f32x4*)s = x1; *(f32x4*)(s + 16) = x2; } }
                    }
                }
        } else if (pn < 8) {
            const bool isv = pn < 6; const int cb = (pn & 1) * 256 + cp;
#pragma unroll
            for (int ai = 0; ai < 2; ++ai)
#pragma unroll
                for (int m = 0; m < 4; ++m) {
                    const int r = rbase + ai * HALF + m * 16;
                    const size_t orow = isv ? (size_t)krow_of(r) : (size_t)r;
                    bf16_t* base = (isv ? Vb : BG) + orow * 512 + cb;
#pragma unroll
                    for (int bj = 0; bj < 2; ++bj) {
                        const f32x4 x1 = acc[ai][bj][m][0], x2 = acc[ai][bj][m][1];
                        u32x4 w; w.x = pk2(x1[0], x1[1]); w.y = pk2(x1[2], x1[3]); w.z = pk2(x2[0], x2[1]); w.w = pk2(x2[2], x2[3]);
                        *(u32x4*)(base + bj * HALF) = w;
                        if (isv && !sample) { float* s = stV + (size_t)r * 512 + cb + bj * HALF; *(f32x4*)s = x1; *(f32x4*)(s + 4) = x2; }
                    }
                }
        } else {
            const int cb = (pn - 8) * 128 + cp;
#pragma unroll
            for (int ai = 0; ai < 2; ++ai)
#pragma unroll
                for (int m = 0; m < 4; ++m) {
                    const int r = rbase + ai * HALF + m * 16;
                    const f32x4 z1 = acc[ai][0][m][0] * acc[ai][1][m][0], z2 = acc[ai][0][m][1] * acc[ai][1][m][1];
                    u32x4 w; w.x = pk2(z1[0], z1[1]); w.y = pk2(z1[2], z1[3]); w.z = pk2(z2[0], z2[1]); w.w = pk2(z2[2], z2[3]);
                    *(u32x4*)(Z + (size_t)r * 512 + cb) = w;
                }
        }
    }
};
struct EpiSS {
    static constexpr bool PERM = true, AFTER_DRAIN = false; static constexpr int PROBE_ID = 2;
    bf16_t* O; float* SS;
    __device__ __forceinline__ void operator()(const f32x4 (&acc)[2][2][4][2], const Unit& u, int wr, int wc, int fr, int fq) const {
        const int rbase = u.pm * BM + wr * 64 + fr; const int c0 = u.pn * BM + wc * 32 + 8 * fq;
#pragma unroll
        for (int ai = 0; ai < 2; ++ai)
#pragma unroll
            for (int m = 0; m < 4; ++m) {
                const int r = rbase + ai * HALF + m * 16; float s = 0.f;
#pragma unroll
                for (int bj = 0; bj < 2; ++bj) {
                    const f32x4 v0 = acc[ai][bj][m][0], v1 = acc[ai][bj][m][1];
                    s += (v0[0] * v0[0] + v0[1] * v0[1]) + (v0[2] * v0[2] + v0[3] * v0[3]) + (v1[0] * v1[0] + v1[1] * v1[1]) + (v1[2] * v1[2] + v1[3] * v1[3]);
                    u32x4 w; w.x = pk2(v0[0], v0[1]); w.y = pk2(v0[2], v0[3]); w.z = pk2(v1[0], v1[1]); w.w = pk2(v1[2], v1[3]);
                    *(u32x4*)(O + (size_t)r * D + c0 + bj * HALF) = w;
                }
                s = add_swap32(add_swap16(s));
                if (fq == 0) SS[(size_t)r * 16 + u.pn * 4 + wc] = s;
            }
    }
};
struct EpiGlu {
    static constexpr bool PERM = true, AFTER_DRAIN = false; static constexpr int PROBE_ID = 3;
    bf16_t* H;
    __device__ __forceinline__ void operator()(const f32x4 (&acc)[2][2][4][2], const Unit& u, int wr, int wc, int fr, int fq) const {
        const int rbase = u.pm * BM + wr * 64 + fr; const int c0 = u.pn * HALF + wc * 32 + 8 * fq;
#pragma unroll
        for (int ai = 0; ai < 2; ++ai)
#pragma unroll
            for (int m = 0; m < 4; ++m) {
                const int r = rbase + ai * HALF + m * 16; f32x4 hv[2];
#pragma unroll
                for (int n = 0; n < 2; ++n) { const f32x4 g = acc[ai][0][m][n], up = acc[ai][1][m][n];
                    f32x4 e; e[0] = __builtin_amdgcn_exp2f(g[0]); e[1] = __builtin_amdgcn_exp2f(g[1]); e[2] = __builtin_amdgcn_exp2f(g[2]); e[3] = __builtin_amdgcn_exp2f(g[3]);
                    const f32x4 d = e + 1.0f;
                    f32x4 rc; rc[0] = __builtin_amdgcn_rcpf(d[0]); rc[1] = __builtin_amdgcn_rcpf(d[1]); rc[2] = __builtin_amdgcn_rcpf(d[2]); rc[3] = __builtin_amdgcn_rcpf(d[3]);
                    hv[n] = (g * up) * rc; }
                u32x4 w; w.x = pk2(hv[0][0], hv[0][1]); w.y = pk2(hv[0][2], hv[0][3]); w.z = pk2(hv[1][0], hv[1][1]); w.w = pk2(hv[1][2], hv[1][3]);
                *(u32x4*)(H + (size_t)r * DFF + c0) = w;
            }
    }
};
}

namespace att {
constexpr int TILEB = 16384, NSLOT = 3, VRING = NSLOT * TILEB, WSF_OFF = 2 * NSLOT * TILEB, LDS_NEED = WSF_OFF + NWAVES * 256;
static_assert(LDS_NEED <= 131072 && 4 * 32 * 128 * 4 <= WSF_OFF, "attention LDS");
constexpr float THR = 8.f;
__device__ __forceinline__ int crow(int r, int hi) { return (r & 3) + 8 * (r >> 2) + 4 * hi; }
__device__ __forceinline__ bf16x8 vfrag(const LAS char* p0, const LAS char* p1) {
    const v4i16_t lo = __builtin_amdgcn_ds_read_tr16_b64_v4i16((LAS v4i16_t*)p0), hi = __builtin_amdgcn_ds_read_tr16_b64_v4i16((LAS v4i16_t*)p1);
    return (bf16x8){lo[0], lo[1], lo[2], lo[3], hi[0], hi[1], hi[2], hi[3]};
}
__device__ __forceinline__ void glds16(const void* gsrc, unsigned lds_dst) { unsigned keep;
    asm volatile("s_mov_b32 %0, m0\n\ts_mov_b32 m0, %2\n\ts_nop 0\n\tglobal_load_lds_dwordx4 %1, off\n\ts_mov_b32 m0, %0" : "=&s"(keep) : "v"(gsrc), "s"(lds_dst) : "memory"); }
__device__ __forceinline__ void glds16s(const void* sbase, unsigned voff, unsigned lds_dst) { unsigned keep;
    asm volatile("s_mov_b32 %0, m0\n\ts_mov_b32 m0, %3\n\ts_nop 0\n\tglobal_load_lds_dwordx4 %1, %2\n\ts_mov_b32 m0, %0" : "=&s"(keep) : "v"(voff), "s"(sbase), "s"(lds_dst) : "memory"); }
__device__ __forceinline__ float swapmax(float m) { auto rr = __builtin_amdgcn_permlane32_swap(__float_as_uint(m), __float_as_uint(m), false, false); return fmaxf(__uint_as_float(rr[0]), __uint_as_float(rr[1])); }
#define ATT_WAIT_BAR(N) asm volatile("s_waitcnt vmcnt(" #N ") lgkmcnt(0)\n\ts_barrier" ::: "memory")
#define ATT_SB() __builtin_amdgcn_sched_barrier(0)
struct AttnCtx {
    LAS char* lds; LAS float* wsf; const char* kg; const char* vg; unsigned soff[2]; unsigned lds0; int ka[4]; int va[2][4]; int r32, hi, NT;
};
__device__ __forceinline__ float max3f(float a, float b, float c) { return fmaxf(fmaxf(a, b), c); }
template <bool LAST, int S0, bool DOMAX>
__device__ __forceinline__ void attn_step(const AttnCtx& C, int t, f32x16& P0, f32x16& P1, f32x16& N0, f32x16& N1, f32x16 (&o)[4], f32x16& negm, const bf16x8 (&qr)[4], float& mhat, float& l, float& rm) {
    constexpr int s0 = S0, s1 = (S0 + 1) % 3, s2 = (S0 + 2) % 3;
    const bool ik = (t + 3 < C.NT), iv = (t + 2 < C.NT);
    const LAS char* kb = C.lds + s1 * TILEB; const LAS char* vb = C.lds + s0 * TILEB;
    bf16x8 kf[8], vf[16];
#define ATT_KF(i) (*(const LAS bf16x8*)(kb + C.ka[(i) >> 1] + ((i) & 1) * 8192))
#define ATT_VF(n) vfrag(vb + C.va[0][(n) & 3] + ((n) >> 2) * 4096, vb + C.va[1][(n) & 3] + ((n) >> 2) * 4096)
    if (!LAST) { kf[0] = ATT_KF(0); kf[1] = ATT_KF(1); }
#ifdef PROBE_DMA2
    if (ik) { const char* p_ = C.kg + (size_t)(t + 3) * 65536; const unsigned d_ = (unsigned)__builtin_amdgcn_readfirstlane(C.lds0 + s0 * TILEB); glds16(p_ + C.soff[0], d_); glds16(p_ + C.soff[1], d_ + 1024); glds16(p_ + C.soff[0], d_); glds16(p_ + C.soff[1], d_ + 1024); }
    if (iv) { const char* p_ = C.vg + (size_t)(t + 2) * 65536; const unsigned d_ = (unsigned)__builtin_amdgcn_readfirstlane(C.lds0 + VRING + s2 * TILEB); glds16(p_ + C.soff[0], d_); glds16(p_ + C.soff[1], d_ + 1024); glds16(p_ + C.soff[0], d_); glds16(p_ + C.soff[1], d_ + 1024); }
#else
    if (ik) { const char* p_ = C.kg + (size_t)(t + 3) * 65536; const unsigned d_ = (unsigned)__builtin_amdgcn_readfirstlane(C.lds0 + s0 * TILEB); glds16s(p_, C.soff[0], d_); glds16s(p_, C.soff[1], d_ + 1024); }
    if (iv) { const char* p_ = C.vg + (size_t)(t + 2) * 65536; const unsigned d_ = (unsigned)__builtin_amdgcn_readfirstlane(C.lds0 + VRING + s2 * TILEB); glds16s(p_, C.soff[0], d_); glds16s(p_, C.soff[1], d_ + 1024); }
#endif
    ATT_SB();
    if (__any(rm > THR)) {
        const float dl = fmaxf(rm, 0.f);
        mhat += dl;
#pragma unroll
        for (int r = 0; r < 16; ++r) { P0[r] -= dl; P1[r] -= dl; negm[r] = -mhat; }
        const float f = __builtin_amdgcn_exp2f(-dl); l *= f;
        C.wsf[C.r32] = f;
#pragma unroll
        for (int r = 0; r < 16; ++r) { const float fr_ = C.wsf[crow(r, C.hi)];
#pragma unroll
            for (int db = 0; db < 4; ++db) o[db][r] *= fr_; }
    }
    ATT_SB();
    float ls = 0.f; v4u pwu[4]; float rn = -INFINITY;
#define ATT_SOFT(g) do { _Pragma("unroll") for (int e_ = ((g) < 4 ? 0 : 2 * ((g) - 4)); e_ < ((g) < 4 ? 0 : (2 * ((g) - 3) < 32 ? 2 * ((g) - 3) : 32)); ++e_) { \
        float x_; if (e_ < 16) { x_ = __builtin_amdgcn_exp2f(P0[e_ & 15]); P0[e_ & 15] = x_; } else { x_ = __builtin_amdgcn_exp2f(P1[e_ & 15]); P1[e_ & 15] = x_; } \
        ls += x_; \
        if (e_ & 1) { unsigned w_ = pk2(e_ < 16 ? P0[(e_ - 1) & 15] : P1[(e_ - 1) & 15], x_); asm volatile("" : "+v"(w_)); pwu[e_ >> 3][(e_ >> 1) & 3] = w_; } } \
        asm volatile("" : "+v"(ls)); \
        if (DOMAX && (g) >= 20) { _Pragma("unroll") for (int k_ = 4 * ((g) - 20); k_ < 4 * ((g) - 20) + 4; ++k_) rn = max3f(rn, N0[k_ & 15], N1[k_ & 15]); asm volatile("" : "+v"(rn)); } } while (0)
#pragma unroll
    for (int i = 0; i < 8; ++i) {
        if (!LAST) {
            if (i == 0)      N0 = __builtin_amdgcn_mfma_f32_32x32x16_bf16(kf[i], qr[i >> 1], negm, 0, 0, 0);
            else if (i == 1) N1 = __builtin_amdgcn_mfma_f32_32x32x16_bf16(kf[i], qr[i >> 1], negm, 0, 0, 0);
            else if (i & 1)  N1 = __builtin_amdgcn_mfma_f32_32x32x16_bf16(kf[i], qr[i >> 1], N1, 0, 0, 0);
            else             N0 = __builtin_amdgcn_mfma_f32_32x32x16_bf16(kf[i], qr[i >> 1], N0, 0, 0, 0);
            if (i < 6) kf[i + 2] = ATT_KF(i + 2);
        }
        if (i >= 6) vf[i - 6] = ATT_VF(i - 6);
        ATT_SOFT(i);
        ATT_SB();
    }
#pragma unroll
    for (int j = 0; j < 8; ++j) {
        o[j & 3] = __builtin_amdgcn_mfma_f32_32x32x16_bf16(__builtin_bit_cast(bf16x8, pwu[j >> 2]), vf[j], o[j & 3], 0, 0, 0);
        vf[j + 2] = ATT_VF(j + 2);
        ATT_SOFT(8 + j);
        ATT_SB();
    }
#pragma unroll
    for (int j = 0; j < 8; ++j) {
        o[j & 3] = __builtin_amdgcn_mfma_f32_32x32x16_bf16(__builtin_bit_cast(bf16x8, pwu[2 + (j >> 2)]), vf[8 + j], o[j & 3], 0, 0, 0);
        if (j < 6) vf[8 + j + 2] = ATT_VF(8 + j + 2);
        ATT_SOFT(16 + j);
        ATT_SB();
    }
#undef ATT_SOFT
#undef ATT_KF
#undef ATT_VF
    l += ls;
    if (DOMAX) rm = swapmax(rn); else rm = 0.f;
#ifdef PROBE_DMA2
    if (ik) ATT_WAIT_BAR(8); else if (iv) ATT_WAIT_BAR(4); else ATT_WAIT_BAR(0);
#else
    if (ik) ATT_WAIT_BAR(4); else if (iv) ATT_WAIT_BAR(2); else ATT_WAIT_BAR(0);
#endif
}
__device__ __forceinline__ void attn_unit(LAS char* lds, const bf16* Q, const bf16* Kb, const bf16* Vb, bf16* MIX, int qrow0, int krow0, int NT, int h, float lam, const float* gsub) {
    const int tid = threadIdx.x, lane = tid & 63, r32 = lane & 31, hi = lane >> 5; const int wid = __builtin_amdgcn_readfirstlane(tid >> 6), qg = wid & 3, map = wid >> 2;
    AttnCtx C; C.lds = lds; C.r32 = r32; C.hi = hi; C.NT = NT;
    C.kg = (const char*)Kb + ((size_t)krow0 * 512 + h * 128) * 2;
    C.vg = (const char*)Vb + ((size_t)krow0 * 512 + h * 128) * 2;
    C.wsf = (LAS float*)(lds + WSF_OFF) + wid * 64;
    LAS float* wsf = C.wsf;
#pragma unroll
    for (int j = 0; j < 2; ++j) { const int row = 8 * wid + 4 * j + (lane >> 4); const int sw = (((lane >> 4) & 3) << 2) | ((2 * wid + j) & 3); C.soff[j] = (unsigned)(row * 1024 + (((lane & 15) ^ sw) * 16)); }
    C.lds0 = (unsigned)(uintptr_t)lds + (unsigned)wid * 2048u;
#define ATT_DMAK(t, slot) do { const char* p_ = C.kg + (size_t)(t) * 65536; const unsigned d_ = (unsigned)__builtin_amdgcn_readfirstlane(C.lds0 + (slot) * TILEB); glds16(p_ + C.soff[0], d_); glds16(p_ + C.soff[1], d_ + 1024); } while (0)
#define ATT_DMAV(t, slot) do { const char* p_ = C.vg + (size_t)(t) * 65536; const unsigned d_ = (unsigned)__builtin_amdgcn_readfirstlane(C.lds0 + VRING + (slot) * TILEB); glds16(p_ + C.soff[0], d_); glds16(p_ + C.soff[1], d_ + 1024); } while (0)
    asm volatile("s_waitcnt vmcnt(0)" ::: "memory");
    ATT_DMAK(0, 0); ATT_DMAV(0, 0); ATT_DMAK(1, 1); ATT_DMAV(1, 1);
    if (NT > 2) ATT_DMAK(2, 2);
#undef ATT_DMAK
#undef ATT_DMAV
    bf16x8 qr[4];
    { const bf16* qp = Q + (size_t)(qrow0 + 32 * qg + r32) * 512 + h * 128 + map * 64 + hi * 8;
#pragma unroll
      for (int ds = 0; ds < 4; ++ds) qr[ds] = *(const bf16x8*)(qp + ds * 16); }
    { const int swk = ((r32 & 3) << 2) | ((r32 >> 2) & 3);
#pragma unroll
      for (int ds = 0; ds < 4; ++ds) C.ka[ds] = 256 * r32 + 16 * ((8 * map + 2 * ds + hi) ^ swk);
      const int q = (lane & 15) >> 2, p = lane & 3, blk = (lane >> 4) & 1;
#pragma unroll
      for (int hh = 0; hh < 2; ++hh)
#pragma unroll
          for (int db = 0; db < 4; ++db) { const int row = 4 * hi + q + 8 * hh; const int sw = (q << 2) | ((hi + 2 * hh) & 3); C.va[hh][db] = VRING + 256 * row + 16 * ((4 * db + 2 * blk + (p >> 1)) ^ sw) + 8 * (p & 1); } }
    f32x16 o[4];
#pragma unroll
    for (int i = 0; i < 4; ++i) o[i] = (f32x16){};
    float mhat = 0.f, l = 0.f, rm; f32x16 negm;
    ATT_WAIT_BAR(0);
    f32x16 pA0 = (f32x16){}, pA1 = (f32x16){}, pB0, pB1;
    {
#pragma unroll
        for (int ds = 0; ds < 4; ++ds) {
            const bf16x8 a0 = *(const LAS bf16x8*)(lds + C.ka[ds]), a1 = *(const LAS bf16x8*)(lds + C.ka[ds] + 8192);
            pA0 = __builtin_amdgcn_mfma_f32_32x32x16_bf16(a0, qr[ds], pA0, 0, 0, 0);
            pA1 = __builtin_amdgcn_mfma_f32_32x32x16_bf16(a1, qr[ds], pA1, 0, 0, 0);
        }
        float m0 = fmaxf(pA0[0], pA1[0]);
#pragma unroll
        for (int r = 1; r < 16; ++r) m0 = fmaxf(m0, fmaxf(pA0[r], pA1[r]));
        mhat = swapmax(m0); rm = 0.f;
#pragma unroll
        for (int r = 0; r < 16; ++r) { pA0[r] -= mhat; pA1[r] -= mhat; negm[r] = -mhat; }
    }
    asm volatile("s_waitcnt lgkmcnt(0)\n\ts_barrier" ::: "memory");
    static_assert((KV_PER_B / 64) % 6 == 2 && SEQ_P / 64 == 4, "attention step remainder");
#define ATT_STEP_AB(LASTF, SLOT, tt) attn_step<LASTF, SLOT, false>(C, (tt), pA0, pA1, pB0, pB1, o, negm, qr, mhat, l, rm)
#define ATT_STEP_BA(LASTF, SLOT, tt) attn_step<LASTF, SLOT, !(LASTF)>(C, (tt), pB0, pB1, pA0, pA1, o, negm, qr, mhat, l, rm)
    int t = 0;
    for (; t + 6 < NT; t += 6) {
        ATT_STEP_AB(false, 0, t); ATT_STEP_BA(false, 1, t + 1); ATT_STEP_AB(false, 2, t + 2);
        ATT_STEP_BA(false, 0, t + 3); ATT_STEP_AB(false, 1, t + 4); ATT_STEP_BA(false, 2, t + 5);
    }
    ATT_STEP_AB(false, 0, t);
    if (NT - t == 2) { ATT_STEP_BA(true, 1, t + 1); }
    else { ATT_STEP_BA(false, 1, t + 1); ATT_STEP_AB(false, 2, t + 2); ATT_STEP_BA(true, 0, t + 3); }
#undef ATT_STEP_AB
#undef ATT_STEP_BA
    l = add_swap32(l);
    wsf[32 + r32] = l;
    float rl[16];
#pragma unroll
    for (int r = 0; r < 16; ++r) rl[r] = 1.0f / wsf[32 + crow(r, hi)];
    LAS float* X = (LAS float*)lds + qg * 4096;
    if (map == 1) {
#pragma unroll
        for (int r = 0; r < 16; ++r)
#pragma unroll
            for (int db = 0; db < 4; ++db) X[crow(r, hi) * 128 + db * 32 + r32] = o[db][r] * rl[r];
    }
    __syncthreads();
    if (map == 0) {
        float gs[4];
#pragma unroll
        for (int db = 0; db < 4; ++db) gs[db] = gsub[db * 32 + r32] * 0.8f;
#pragma unroll
        for (int r = 0; r < 16; ++r) {
            float ss = 0.f;
#pragma unroll
            for (int db = 0; db < 4; ++db) { const float v = o[db][r] * rl[r] - lam * X[crow(r, hi) * 128 + db * 32 + r32]; o[db][r] = v; ss += v * v; }
            ss = add_swap16(row16_sum(ss));
            const float rs = __builtin_amdgcn_rsqf(ss * (1.0f / 128.0f) + EPS);
            bf16* op = MIX + (size_t)(qrow0 + 32 * qg + crow(r, hi)) * D + h * 128 + r32;
#pragma unroll
            for (int db = 0; db < 4; ++db) op[db * 32] = (bf16)(pk2(o[db][r] * rs * gs[db], 0.f) & 0xffffu);
        }
    }
    __syncthreads();
}
}

struct Args { const float* in[23]; float* out; unsigned char* ws; int ph_lo, ph_hi; };
enum { I_XP = 0, I_XS, I_CK, I_CV, I_C, I_CCTX, I_WADA, I_BADA, I_GAPRE, I_GAPOST, I_GFPRE, I_GFPOST, I_WIN, I_CONVW, I_CONVB, I_LQ1, I_LK1, I_LQ2, I_LK2, I_GSUB, I_WOUT, I_WFI, I_WFO };
constexpr int N_PHASES = 9;

#define mod ((float*)(args.ws + WS_MOD))
#define rot ((float*)(args.ws + WS_ROT))
#define SS1 ((float*)(args.ws + WS_SS1))
#define SS2 ((float*)(args.ws + WS_SS2))
#define WinT ((bf16*)(args.ws + WS_WIN))
#define WoT ((bf16*)(args.ws + WS_WO))
#define WfiT ((bf16*)(args.ws + WS_WFI))
#define WfoT ((bf16*)(args.ws + WS_WFO))
#define U ((bf16*)(args.ws + WS_U))
#define MIXO ((bf16*)(args.ws + WS_MIXO))
#define Qb ((bf16*)(args.ws + WS_Q))
#define Kb ((bf16*)(args.ws + WS_K))
#define Vb ((bf16*)(args.ws + WS_V))
#define MIX ((bf16*)(args.ws + WS_MIX))
#define BG ((bf16*)(args.ws + WS_BG))
#define Z ((bf16*)(args.ws + WS_Z))
#define H ((bf16*)(args.ws + WS_H))
#define xp (args.in[I_XP])
#define xs (args.in[I_XS])
#define Y (args.out)
#define stK (args.out + (size_t)M * D)
#define stV (args.out + (size_t)M * D + (size_t)MP * 512)

namespace pg8 {
struct PanelOrder {
    int G, c, lo, hi;
    __device__ __forceinline__ bool next(int i, Unit& u) const { const int L = lo + i * G + c; if (L >= hi) return false; const int xcd = L & 7, w = L >> 3; u.pm = 18 * xcd + (w >> 2); u.pn = w & 3; return true; }
    __device__ __forceinline__ void a_ready(const Unit&) const {}
    __device__ __forceinline__ void done(const Unit&) const {}
};
}
__device__ __forceinline__ int rowmap(int e, bool late) { const int p = e >> 8; const int pm = late ? 18 * (p >> 1) + 16 + (p & 1) : 18 * (p >> 4) + (p & 15); return pm * 256 + (e & 255); }
__device__ __forceinline__ void tail_arrive(unsigned* cnt) {
    asm volatile("s_waitcnt vmcnt(0)" ::: "memory");
    __syncthreads();
    if (threadIdx.x == 0) {
        __builtin_amdgcn_fence(__ATOMIC_RELEASE, "agent");
        asm volatile("s_waitcnt vmcnt(0)" ::: "memory");
        (void)xb_add(cnt, 1u);
    }
}
__device__ __forceinline__ void tail_wait(unsigned* cnt, unsigned expect) {
    if (threadIdx.x == 0) {
        unsigned sp = 0u;
        while (xb_ld(cnt) < expect) { __builtin_amdgcn_s_sleep(1); if (++sp > (1u << 20)) break; }
        __builtin_amdgcn_fence(__ATOMIC_ACQUIRE, "agent");
        asm volatile("s_waitcnt vmcnt(0)" ::: "memory");
    }
    __syncthreads();
}
__device__ __forceinline__ void free_share(int f, int& e0, int& en) { if (f < 128) { e0 = f * 171; en = 171; } else { e0 = 128 * 171 + (f - 128) * 170; en = 170; } }
__device__ __forceinline__ void early_share(int bx, int na, int nb, int& e0, int& en) { if (bx < 64) { e0 = bx * nb; en = nb; } else { e0 = 64 * nb + (bx - 64) * na; en = na; } }
__device__ __forceinline__ void p5_rows(const Args& args, int e0, int en, bool late, int wave, int lane) {
        const float* gpo = args.in[I_GAPOST]; const float* gfp = args.in[I_GFPRE];
        for (int i0 = wave; i0 < en; i0 += 8 * 2) {
            f32x4 v[2][4]; v2u mo[2][4]; float ssp[2];
#pragma unroll
            for (int q = 0; q < 2; ++q) { const int idx = i0 + 8 * q; const int r = rowmap(e0 + idx, late); ssp[q] = 0.f;
                if (idx < en) { const float* xr = r < MP ? xp + (size_t)r * D : xs + (size_t)(r - MP) * D;
                    ssp[q] = SS1[(size_t)r * 16 + (lane & 15)];
#pragma unroll
                    for (int j = 0; j < 4; ++j) { v[q][j] = __builtin_nontemporal_load((const f32x4*)(xr + 4 * lane + 256 * j)); mo[q][j] = *(const v2u*)(MIXO + (size_t)r * D + 4 * lane + 256 * j); } } }
#pragma unroll
            for (int q = 0; q < 2; ++q) { const int idx = i0 + 8 * q; const int r = rowmap(e0 + idx, late);
                if (idx < en) {
                    const float* mp = mod + (r < MP ? 0 : 1 + ((r - MP) >> 12)) * 6144;
                    const float sp = row16_sum(ssp[q]);
                    const float rstd1 = __builtin_amdgcn_rsqf(sp * (1.f / D) + EPS); float s = 0.f;
#pragma unroll
                    for (int j = 0; j < 4; ++j) { const int c = 4 * lane + 256 * j;
                        const f32x4 mf = (f32x4){__uint_as_float(mo[q][j][0] << 16), __uint_as_float(mo[q][j][0] & 0xffff0000u), __uint_as_float(mo[q][j][1] << 16), __uint_as_float(mo[q][j][1] & 0xffff0000u)};
                        const f32x4 gg = *(const f32x4*)(gpo + c), ga = *(const f32x4*)(mp + 2048 + c);
                        v[q][j] = v[q][j] + ga * (mf * rstd1 * gg);
                        s += (v[q][j][0] * v[q][j][0] + v[q][j][1] * v[q][j][1]) + (v[q][j][2] * v[q][j][2] + v[q][j][3] * v[q][j][3]); }
                    const float rstd = __builtin_amdgcn_rsqf(wave_sum(s) * (1.f / D) + EPS);
#pragma unroll
                    for (int j = 0; j < 4; ++j) { const int c = 4 * lane + 256 * j; const f32x4 gg = *(const f32x4*)(gfp + c), sh = *(const f32x4*)(mp + 3072 + c), sc = *(const f32x4*)(mp + 4096 + c);
                        const f32x4 u = v[q][j] * rstd * gg * (sc + 1.f) + sh;
                        *(v2u*)(U + (size_t)r * D + c) = (v2u){pk2(u[0], u[1]), pk2(u[2], u[3])}; } } }
        }
}
__device__ __forceinline__ void p8_rows(const Args& args, int e0, int en, bool late, int wave, int lane) {
        const float* gpo = args.in[I_GAPOST]; const float* gfo = args.in[I_GFPOST];
        for (int i0 = wave; i0 < en; i0 += 8 * 2) {
            f32x4 v[2][4]; v2u mo[2][4], fo[2][4]; float ssp1[2], ssp2[2];
#pragma unroll
            for (int q = 0; q < 2; ++q) { const int idx = i0 + 8 * q; const int r = rowmap(e0 + idx, late); ssp1[q] = 0.f; ssp2[q] = 0.f;
                if (idx < en) { const float* xr = r < MP ? xp + (size_t)r * D : xs + (size_t)(r - MP) * D;
                    ssp1[q] = SS1[(size_t)r * 16 + (lane & 15)]; ssp2[q] = SS2[(size_t)r * 16 + (lane & 15)];
#pragma unroll
                    for (int j = 0; j < 4; ++j) { v[q][j] = __builtin_nontemporal_load((const f32x4*)(xr + 4 * lane + 256 * j)); mo[q][j] = *(const v2u*)(MIXO + (size_t)r * D + 4 * lane + 256 * j); fo[q][j] = *(const v2u*)(U + (size_t)r * D + 4 * lane + 256 * j); } } }
#pragma unroll
            for (int q = 0; q < 2; ++q) { const int idx = i0 + 8 * q; const int r = rowmap(e0 + idx, late);
                if (idx < en) {
                    const float* mp = mod + (r < MP ? 0 : 1 + ((r - MP) >> 12)) * 6144;
                    const float sp = row16_sum(ssp1[q]);
                    const float rstd1 = __builtin_amdgcn_rsqf(sp * (1.f / D) + EPS);
                    const float sq = row16_sum(ssp2[q]);
                    const float rstd2 = __builtin_amdgcn_rsqf(sq * (1.f / D) + EPS);
#pragma unroll
                    for (int j = 0; j < 4; ++j) { const int c = 4 * lane + 256 * j;
                        const f32x4 mf = (f32x4){__uint_as_float(mo[q][j][0] << 16), __uint_as_float(mo[q][j][0] & 0xffff0000u), __uint_as_float(mo[q][j][1] << 16), __uint_as_float(mo[q][j][1] & 0xffff0000u)};
                        const f32x4 ff = (f32x4){__uint_as_float(fo[q][j][0] << 16), __uint_as_float(fo[q][j][0] & 0xffff0000u), __uint_as_float(fo[q][j][1] << 16), __uint_as_float(fo[q][j][1] & 0xffff0000u)};
                        const f32x4 gg = *(const f32x4*)(gpo + c), ga = *(const f32x4*)(mp + 2048 + c);
                        const f32x4 x1 = v[q][j] + ga * (mf * rstd1 * gg);
                        const f32x4 g2 = *(const f32x4*)(gfo + c), gf = *(const f32x4*)(mp + 5120 + c);
                        __builtin_nontemporal_store(x1 + gf * (ff * rstd2 * g2), (f32x4*)(Y + (size_t)r * D + c)); } } }
        }
}
struct P0Item { const float* W; bf16* WT; int K, N, dst_row0, src_col0, k0; bool rperm; float scale; };
__device__ __forceinline__ P0Item p0_item(const Args& args, int it) {
    constexpr int I_1 = 16 * 96, I_2 = 16 * 32, I_3 = 16 * 176;
    P0Item q; int r = it; q.rperm = false; q.scale = 1.0f;
    if (r < I_1) { const int kb = r / 96, nb = r % 96, n0 = 32 * nb; int src = n0;
        if (n0 >= 2048) { const int j = (n0 - 2048) >> 8, c = (n0 - 2048) & 255; src = c < 128 ? 2048 + 128 * j + c : 2560 + 128 * j + (c - 128); }
        q.W = args.in[I_WIN]; q.WT = WinT; q.K = D; q.N = NIN; q.dst_row0 = n0; q.src_col0 = src; q.k0 = 64 * kb; q.rperm = n0 < 1024; return q; }
    r -= I_1;
    if (r < I_2) { const int kb = r / 32, nb = r % 32; q.W = args.in[I_WOUT]; q.WT = WoT; q.K = D; q.N = D; q.dst_row0 = 32 * nb; q.src_col0 = 32 * nb; q.k0 = 64 * kb; return q; }
    r -= I_2;
    if (r < I_3) { const int kb = r / 176, nb = r % 176, n0 = 32 * nb; const int j = n0 >> 8, c = n0 & 255; const int src = c < 128 ? 128 * j + c : DFF + 128 * j + (c - 128);
        q.W = args.in[I_WFI]; q.WT = WfiT; q.K = D; q.N = NFI; q.dst_row0 = n0; q.src_col0 = src; q.k0 = 64 * kb;
        q.scale = c < 128 ? -1.4426950408889634f : -0.6931471805599453f; return q; }
    r -= I_3;
    { const int kb = r / 32, nb = r % 32; q.W = args.in[I_WFO]; q.WT = WfoT; q.K = DFF; q.N = D; q.dst_row0 = 32 * nb; q.src_col0 = 32 * nb; q.k0 = 64 * kb; return q; }
}
__device__ __forceinline__ void p0_item_load(const P0Item& q, float (&tv)[32], int lane) {
#pragma unroll
    for (int i = 0; i < 32; ++i) { const int kk = 2 * i + (lane >> 5); tv[i] = __builtin_nontemporal_load(q.W + (size_t)(q.k0 + kk) * q.N + q.src_col0 + (lane & 31)); }
}
__device__ __forceinline__ void p0_item_finish(const P0Item& q, const float (&tv)[32], LAS float* scr, int lane) {
#pragma unroll
    for (int i = 0; i < 32; ++i) { const int kk = 2 * i + (lane >> 5); scr[kk * 33 + (lane & 31)] = tv[i] * q.scale; }
    asm volatile("s_waitcnt lgkmcnt(0)" ::: "memory");
    const int c = lane & 7;
#pragma unroll
    for (int j = 0; j < 4; ++j) { const int n = (lane >> 3) + 8 * j; const int ns = q.rperm ? (16 * ((n >> 2) & 1) + 4 * (n >> 3) + (n & 3)) : n; const LAS float* s = scr + (8 * c) * 33 + ns;
        v4u o; o.x = pk2(s[0 * 33], s[1 * 33]); o.y = pk2(s[2 * 33], s[3 * 33]); o.z = pk2(s[4 * 33], s[5 * 33]); o.w = pk2(s[6 * 33], s[7 * 33]);
        *(v4u*)(q.WT + (size_t)(q.dst_row0 + n) * q.K + q.k0 + 8 * c) = o; }
    asm volatile("s_waitcnt lgkmcnt(0)" ::: "memory");
}

__device__ __forceinline__ void p0_transposes(const Args& args, int it0, int it1, int widx, int nw, LAS float* scr, int lane) {
    int it = it0 + widx;
    if (it < it1) {
        P0Item cur = p0_item(args, it); float ta[32], tb[32];
        p0_item_load(cur, ta, lane);
        for (;;) {
            const int nx = it + nw; const bool more = nx < it1; P0Item nxt = cur;
            if (more) { nxt = p0_item(args, nx); p0_item_load(nxt, tb, lane); }
            p0_item_finish(cur, ta, scr, lane);
            if (!more) break;
#pragma unroll
            for (int i = 0; i < 32; ++i) ta[i] = tb[i];
            cur = nxt; it = nx;
        }
    }
}
constexpr int IT_WIN = 16 * 96, IT_WO = IT_WIN + 16 * 32, IT_WFI = IT_WO + 16 * 176, IT_WFO = IT_WFI + 44 * 32;

__global__ void __launch_bounds__(NTHREADS, 2) fwd_megakernel(Args args) {
    extern __shared__ __attribute__((aligned(16))) unsigned char lds_raw[];
    LAS unsigned char* lds = (LAS unsigned char*)lds_raw;
    cg::grid_group grid = cg::this_grid();
    const int tid = threadIdx.x, lane = tid & 63; const int wave = __builtin_amdgcn_readfirstlane(tid >> 6);
    const int G = gridDim.x, bx = blockIdx.x;
    const int vcu = (G % 8 == 0) ? (bx % 8) * (G / 8) + bx / 8 : bx;
    const int gw = vcu * NWAVES + wave, NGW = G * NWAVES;
    unsigned char* ws = args.ws;
    const int lo = args.ph_lo, hi_ph = args.ph_hi;
#define IN(k) (lo <= (k) && (k) < hi_ph)
    if (tid < 16) ((LAS unsigned*)(lds + MISC_OFF))[tid] = 0u;
    __syncthreads();
    XcdBarrier bar = xcd_barrier_post((unsigned*)(ws + WS_BAR), (volatile LAS unsigned*)(lds + MISC_OFF));
    if (lo < 0) grid.sync();
#ifdef PROBE_BAR2
#define SEAM(k) do { if (IN(k) && IN((k) + 1)) { xcd_barrier(bar); xcd_barrier(bar); } } while (0)
#else
#define SEAM(k) do { if (IN(k) && IN((k) + 1)) xcd_barrier(bar); } while (0)
#endif

    if (IN(0)) {
#ifdef PROBE_P0
      for (int rep_ = 0; rep_ < 3; ++rep_) {
#endif
        if (bx < 192) {
            LAS float* S = (LAS float*)lds; LAS float* red = (LAS float*)(lds + 9 * 1024 * 4);
            { float cv[18];
#pragma unroll
              for (int u = 0; u < 18; ++u) { const int e = tid + u * NTHREADS, i = e >> 10, k = e & 1023; cv[u] = (i == 0) ? args.in[I_CCTX][k] : args.in[I_C][(i - 1) * 1024 + k]; }
#pragma unroll
              for (int u = 0; u < 18; ++u) S[tid + u * NTHREADS] = cv[u] / (1.f + __expf(-cv[u])); }
            __syncthreads();
            const int kgp = tid >> 5, cl = tid & 31, j0 = 32 * bx;
            float a[9];
#pragma unroll
            for (int i = 0; i < 9; ++i) a[i] = 0.f;
            const float* wp = args.in[I_WADA] + (size_t)(kgp * 64) * 6144 + j0 + cl;
            float wv[64];
#pragma unroll
            for (int k = 0; k < 64; ++k) wv[k] = __builtin_nontemporal_load(wp + (size_t)k * 6144);
#pragma unroll
            for (int k = 0; k < 64; ++k) {
#pragma unroll
                for (int i = 0; i < 9; ++i) a[i] += S[i * 1024 + kgp * 64 + k] * wv[k]; }
#pragma unroll
            for (int i = 0; i < 9; ++i) red[(kgp * 9 + i) * 32 + cl] = a[i];
            __syncthreads();
            if (tid < 288) { const int i = tid >> 5; float s = args.in[I_BADA][j0 + cl];
#pragma unroll
                for (int g = 0; g < 16; ++g) s += red[(g * 9 + i) * 32 + cl];
                mod[i * 6144 + j0 + cl] = s; }
            tail_arrive((unsigned*)(args.ws + WS_BAR) + 3712);
        }
        p0_transposes(args, 0, IT_WIN, gw, NGW, (LAS float*)(lds + wave * 16384), lane);
        {
            f32x4 cv0[2], cv1[2];
#pragma unroll
            for (int u = 0; u < 2; ++u) { const int ir = gw + u * NGW;
                if (ir < 2 * NB_S * PAST) { const int which = ir / (NB_S * PAST), rr = ir % (NB_S * PAST);
                    const float* src_ = args.in[which ? I_CV : I_CK] + (size_t)rr * 512 + lane * 8; cv0[u] = *(const f32x4*)src_; cv1[u] = *(const f32x4*)(src_ + 4); } }
#pragma unroll
            for (int u = 0; u < 2; ++u) { const int ir = gw + u * NGW;
                if (ir < 2 * NB_S * PAST) { const int which = ir / (NB_S * PAST), rr = ir % (NB_S * PAST), b = rr / PAST, j = rr % PAST;
                    bf16* drow = (which ? Vb : Kb) + (size_t)(MP + b * KV_PER_B + j) * 512;
                    if (which) *(v4u*)(drow + lane * 8) = (v4u){pk2(cv0[u][0], cv0[u][1]), pk2(cv0[u][2], cv0[u][3]), pk2(cv1[u][0], cv1[u][1]), pk2(cv1[u][2], cv1[u][3])};
                    else { const int l0 = lane * 8, g32 = l0 & ~31, la = l0 & 31, lb = la + 4;
                        *(v2u*)(drow + g32 + 8 * ((la >> 2) & 3) + 4 * (la >> 4)) = (v2u){pk2(cv0[u][0], cv0[u][1]), pk2(cv0[u][2], cv0[u][3])};
                        *(v2u*)(drow + g32 + 8 * ((lb >> 2) & 3) + 4 * (lb >> 4)) = (v2u){pk2(cv1[u][0], cv1[u][1]), pk2(cv1[u][2], cv1[u][3])}; } } }
            for (int ir = gw + 2 * NGW; ir < 2 * NB_S * PAST; ir += NGW) {
                const int which = ir / (NB_S * PAST), rr = ir % (NB_S * PAST), b = rr / PAST, j = rr % PAST;
                const float* src_ = args.in[which ? I_CV : I_CK] + (size_t)rr * 512 + lane * 8;
                const f32x4 v0 = *(const f32x4*)src_, v1 = *(const f32x4*)(src_ + 4);
                bf16* drow = (which ? Vb : Kb) + (size_t)(MP + b * KV_PER_B + j) * 512;
                if (which) *(v4u*)(drow + lane * 8) = (v4u){pk2(v0[0], v0[1]), pk2(v0[2], v0[3]), pk2(v1[0], v1[1]), pk2(v1[2], v1[3])};
                else { const int l0 = lane * 8, g32 = l0 & ~31, la = l0 & 31, lb = la + 4;
                    *(v2u*)(drow + g32 + 8 * ((la >> 2) & 3) + 4 * (la >> 4)) = (v2u){pk2(v0[0], v0[1]), pk2(v0[2], v0[3])};
                    *(v2u*)(drow + g32 + 8 * ((lb >> 2) & 3) + 4 * (lb >> 4)) = (v2u){pk2(v1[0], v1[1]), pk2(v1[2], v1[3])}; }
            }
        }
        if (bx == 255 || (G < 256 && bx == 0)) {
            for (int e = tid; e < 1024; e += NTHREADS) { const int pos = e >> 4, i = e & 15; const float inv = 1.0f / powf(10000.0f, (float)i / 16.0f); const float ang = (float)pos * inv; rot[e] = cosf(ang); rot[1024 + e] = sinf(ang); }
        }
#ifdef PROBE_P0
      __syncthreads(); }
#endif
    }
    if (IN(0) && IN(1)) tail_wait((unsigned*)(args.ws + WS_BAR) + 3712, 192u);

    if (IN(1)) {
        const float* g = args.in[I_GAPRE];
#ifdef PROBE_ROWS
        for (int rep_ = 0; rep_ < 2; ++rep_)
#endif
        for (int r0 = gw; r0 < M; r0 += 3 * NGW) {
            f32x4 v[3][4]; float s[3];
#pragma unroll
            for (int q = 0; q < 3; ++q) { const int r = r0 + q * NGW; s[q] = 0.f;
                if (r < M) { const float* xr = r < MP ? xp + (size_t)r * D : xs + (size_t)(r - MP) * D;
#pragma unroll
                    for (int j = 0; j < 4; ++j) v[q][j] = __builtin_nontemporal_load((const f32x4*)(xr + 4 * lane + 256 * j)); } }
#pragma unroll
            for (int q = 0; q < 3; ++q) { const int r = r0 + q * NGW;
                if (r < M) {
#pragma unroll
                    for (int j = 0; j < 4; ++j) s[q] += (v[q][j][0] * v[q][j][0] + v[q][j][1] * v[q][j][1]) + (v[q][j][2] * v[q][j][2] + v[q][j][3] * v[q][j][3]);
                    const float rstd = __builtin_amdgcn_rsqf(wave_sum(s[q]) * (1.f / D) + EPS);
                    const float* mp = mod + (r < MP ? 0 : 1 + ((r - MP) >> 12)) * 6144;
#pragma unroll
                    for (int j = 0; j < 4; ++j) { const int c = 4 * lane + 256 * j; const f32x4 gg = *(const f32x4*)(g + c), sh = *(const f32x4*)(mp + c), sc = *(const f32x4*)(mp + 1024 + c);
                        const f32x4 u = v[q][j] * rstd * gg * (sc + 1.f) + sh;
                        *(v2u*)(U + (size_t)r * D + c) = (v2u){pk2(u[0], u[1]), pk2(u[2], u[3])}; } } }
        }
    }
    SEAM(1);

    if (IN(2)) {
        pg8::Gemm g{U, WinT, M, NIN, D}; pg8::StaticOrder S; S.init(M, NIN, G, bx);
        pg8::EpiIn E{Qb, Kb, Vb, BG, Z, stK, stV, rot};
        pg8::gemm_phase<pg8::EpiIn, pg8::StaticOrder, PG8_ALIGN, PG8_SP2>(lds, g, S, E);
        if (G == 256 && bx >= 192) p0_transposes(args, IT_WIN, IT_WFI, (bx - 192) * NWAVES + wave, 64 * NWAVES, (LAS float*)(lds + wave * 16384), lane);
        else if (G != 256) p0_transposes(args, IT_WIN, IT_WFI, gw, NGW, (LAS float*)(lds + wave * 16384), lane);
#ifdef PROBE_GEMM2
        __syncthreads(); pg8::gemm_phase<pg8::EpiIn, pg8::StaticOrder, PG8_ALIGN, PG8_SP2>(lds, g, S, E);
#endif
    }
    SEAM(2);

    if (IN(3)) {
        {
            const float* cw = args.in[I_CONVW]; const float* cb = args.in[I_CONVB];
            const int c8 = (tid & 63) * 8;
            float w0[8], w1[8], w2[8], bb[8];
#pragma unroll
            for (int e = 0; e < 8; ++e) { w0[e] = cw[c8 + e]; w1[e] = cw[512 + c8 + e]; w2[e] = cw[1024 + c8 + e]; bb[e] = cb[c8 + e]; }
            const bool hasp = (G == 256) && (vcu < NB_P * 4 * 2); const int cn = (G == 256) ? (hasp ? 112 : 176) : (M + G - 1) / G; const int cbase = (G == 256) ? (hasp ? vcu * 112 : 128 * 112 + (vcu - 128) * 176) : vcu * cn;
#ifdef PROBE_CONV
            for (int rep_ = 0; rep_ < 3; ++rep_)
#endif
            for (int i0 = wave; i0 < cn; i0 += 24) {
                v4u zc[3], zp[3], zn[3], bg[3];
#pragma unroll
                for (int q = 0; q < 3; ++q) { const int idx = i0 + 8 * q; const int r = cbase + idx;
                    zp[q] = (v4u){0u, 0u, 0u, 0u}; zn[q] = (v4u){0u, 0u, 0u, 0u}; zc[q] = zp[q]; bg[q] = zp[q];
                    if (idx < cn && r < M) { const int t = r < MP ? (r & (SEQ_P - 1)) : ((r - MP) & (SEQ_S - 1)); const int L = r < MP ? SEQ_P : SEQ_S;
                        zc[q] = *(const v4u*)(Z + (size_t)r * 512 + c8); bg[q] = *(const v4u*)(BG + (size_t)r * 512 + c8);
                        if (t > 0) zp[q] = *(const v4u*)(Z + (size_t)(r - 1) * 512 + c8);
                        if (t < L - 1) zn[q] = *(const v4u*)(Z + (size_t)(r + 1) * 512 + c8); } }
#pragma unroll
                for (int q = 0; q < 3; ++q) { const int idx = i0 + 8 * q; const int r = cbase + idx;
                    if (idx < cn && r < M) { float o[8];
#pragma unroll
                        for (int e = 0; e < 4; ++e) {
                            const float zc0 = __uint_as_float(zc[q][e] << 16), zc1 = __uint_as_float(zc[q][e] & 0xffff0000u), zp0 = __uint_as_float(zp[q][e] << 16), zp1 = __uint_as_float(zp[q][e] & 0xffff0000u);
                            const float zn0 = __uint_as_float(zn[q][e] << 16), zn1 = __uint_as_float(zn[q][e] & 0xffff0000u), b0 = __uint_as_float(bg[q][e] << 16), b1 = __uint_as_float(bg[q][e] & 0xffff0000u);
                            o[2 * e] = b0 * (w0[2 * e] * zp0 + w1[2 * e] * zc0 + w2[2 * e] * zn0 + bb[2 * e]);
                            o[2 * e + 1] = b1 * (w0[2 * e + 1] * zp1 + w1[2 * e + 1] * zc1 + w2[2 * e + 1] * zn1 + bb[2 * e + 1]); }
                        *(v4u*)(MIX + (size_t)r * D + 512 + c8) = (v4u){pk2(o[0], o[1]), pk2(o[2], o[3]), pk2(o[4], o[5]), pk2(o[6], o[7])}; } }
            }
        }
        float lam;
        { const float a = args.in[I_LQ1][lane] * args.in[I_LK1][lane], b = args.in[I_LQ2][lane] * args.in[I_LK2][lane];
          lam = __expf(wave_sum(a)) - __expf(wave_sum(b)) + 0.2f; }
        __syncthreads();
        const float* gsub = args.in[I_GSUB];
        for (int i = vcu; i < NB_S * 4 * 32; i += G) {
            const int bh = (i >> 5) & 31, qb = i & 31; const int b = bh >> 2, h = bh & 3;
            att::attn_unit((LAS char*)lds, Qb, Kb, Vb, MIX, MP + b * SEQ_S + qb * 128, MP + b * KV_PER_B, KV_PER_B / 64, h, lam, gsub);
        }
#ifdef PROBE_ATT2
        for (int i = vcu; i < NB_S * 4 * 32; i += G) {
            const int bh = (i >> 5) & 31, qb = i & 31; const int b = bh >> 2, h = bh & 3;
            att::attn_unit((LAS char*)lds, Qb, Kb, Vb, MIX, MP + b * SEQ_S + qb * 128, MP + b * KV_PER_B, KV_PER_B / 64, h, lam, gsub);
        }
#endif
        for (int i = vcu; i < NB_P * 4 * 2; i += G) {
            const int b = i >> 3, h = (i >> 1) & 3, qb = i & 1;
            att::attn_unit((LAS char*)lds, Qb, Kb, Vb, MIX, b * SEQ_P + qb * 128, b * SEQ_P, SEQ_P / 64, h, lam, gsub);
        }
    }
    SEAM(3);

    if (IN(4)) {
        pg8::Gemm g{MIX, WoT, M, D, D}; pg8::PanelOrder S{G, bx, 0, 512}; pg8::EpiSS E{MIXO, SS1};
        pg8::gemm_phase<pg8::EpiSS, pg8::PanelOrder, PG8_ALIGN, PG8_SP2>(lds, g, S, E);
    }
    SEAM(4);
    if (IN(5)) {
        unsigned* cnt = (unsigned*)(args.ws + WS_BAR) + 3584;
        if (bx < 64) { pg8::Gemm g{MIX, WoT, M, D, D}; pg8::PanelOrder S{G, bx, 512, 576}; pg8::EpiSS E{MIXO, SS1};
            pg8::gemm_phase<pg8::EpiSS, pg8::PanelOrder, PG8_ALIGN, PG8_SP2>(lds, g, S, E);
            tail_arrive(cnt); }
        int e0, en; early_share(bx, 144, 80, e0, en);
        p5_rows(args, e0, en, false, wave, lane);
        tail_wait(cnt, 64u);
        p5_rows(args, bx * 16, 16, true, wave, lane);
    }
    SEAM(5);
    if (IN(6)) {
        pg8::Gemm g{U, WfiT, M, NFI, D}; pg8::StaticOrder S; S.init(M, NFI, G, bx);
        pg8::EpiGlu E{H};
        pg8::gemm_phase<pg8::EpiGlu, pg8::StaticOrder, PG8_ALIGN, PG8_SP2>(lds, g, S, E);
        if (G == 256 && bx >= 96) p0_transposes(args, IT_WFI, IT_WFO, (bx - 96) * NWAVES + wave, 160 * NWAVES, (LAS float*)(lds + wave * 16384), lane);
        else if (G != 256) p0_transposes(args, IT_WFI, IT_WFO, gw, NGW, (LAS float*)(lds + wave * 16384), lane);
    }
    SEAM(6);
    if (IN(7)) {
        pg8::Gemm g{H, WfoT, M, D, DFF}; pg8::PanelOrder S{G, bx, 0, 512}; pg8::EpiSS E{U, SS2};
        pg8::gemm_phase<pg8::EpiSS, pg8::PanelOrder, PG8_ALIGN, PG8_SP2>(lds, g, S, E);
    }
    SEAM(7);
    if (IN(8)) {
        unsigned* cnt = (unsigned*)(args.ws + WS_BAR) + 3648;
        if (bx < 64) { pg8::Gemm g{H, WfoT, M, D, DFF}; pg8::PanelOrder S{G, bx, 512, 576}; pg8::EpiSS E{U, SS2};
            pg8::gemm_phase<pg8::EpiSS, pg8::PanelOrder, PG8_ALIGN, PG8_SP2>(lds, g, S, E);
            tail_arrive(cnt); }
        if (bx >= 64) { int e0, en; free_share(bx - 64, e0, en); p8_rows(args, e0, en, false, wave, lane); }
        tail_wait(cnt, 64u);
        p8_rows(args, bx * 16, 16, true, wave, lane);
    }
#undef IN
#undef SEAM
#undef mod
#undef rot
#undef SS1
#undef SS2
#undef WinT
#undef WoT
#undef WfiT
#undef WfoT
#undef U
#undef MIXO
#undef Qb
#undef Kb
#undef Vb
#undef MIX
#undef BG
#undef Z
#undef H
#undef xp
#undef xs
#undef Y
#undef stK
#undef stV
}

extern "C" void kernel_launch(void* const* d_in, const int* in_sizes, int n_in, void* d_out, int out_size, void* d_ws, size_t ws_size, hipStream_t stream) {
    static int grid = 0;
    if (grid == 0) {
        if (n_in != 23 || ws_size < WS_END || out_size != M * D + 2 * MP * 512) { fprintf(stderr, "kernel_launch: unexpected problem (n_in %d, ws %zu, out %d)\n", n_in, ws_size, out_size); grid = -1; return; }
        int dev = 0, cus = 0, per_cu = 0;
        hipGetDevice(&dev); hipDeviceGetAttribute(&cus, hipDeviceAttributeMultiprocessorCount, dev);
        if (hipFuncSetAttribute((const void*)fwd_megakernel, hipFuncAttributeMaxDynamicSharedMemorySize, LDS_BYTES) != hipSuccess) { fprintf(stderr, "kernel_launch: hipFuncSetAttribute failed\n"); grid = -1; return; }
        if (hipOccupancyMaxActiveBlocksPerMultiprocessor(&per_cu, (const void*)fwd_megakernel, NTHREADS, LDS_BYTES) != hipSuccess || per_cu < 1) { fprintf(stderr, "kernel_launch: occupancy query failed (%d)\n", per_cu); (void)hipGetLastError(); per_cu = 1; }
        grid = cus * 1;
        if (grid > cus * per_cu) grid = cus * per_cu;
    }
    if (grid < 0) return;
    Args a{};
    for (int i = 0; i < 23; ++i) a.in[i] = (const float*)d_in[i];
    a.out = (float*)d_out; a.ws = (unsigned char*)d_ws;
    if (hipMemsetAsync((char*)d_ws + WS_BAR, 0, BAR_BYTES, stream) != hipSuccess) { fprintf(stderr, "kernel_launch: memset failed\n"); return; }
#if MK_COOP
    a.ph_lo = 0; a.ph_hi = N_PHASES;
    void* kargs[] = {&a};
    hipError_t e = hipLaunchCooperativeKernel((const void*)fwd_megakernel, dim3(grid), dim3(NTHREADS), kargs, LDS_BYTES, stream);
    if (e != hipSuccess) fprintf(stderr, "cooperative launch failed: %s (grid %d)\n", hipGetErrorString(e), grid);
#else
    for (int p = 0; p < N_PHASES; ++p) { a.ph_lo = p; a.ph_hi = p + 1; hipLaunchKernelGGL(fwd_megakernel, dim3(grid), dim3(NTHREADS), LDS_BYTES, stream, a); }
#endif
}
```

```cpp
#include <hip/hip_runtime.h>
#include <hip/hip_cooperative_groups.h>
#include <cstdio>
#include <cstdint>
namespace cg = cooperative_groups;
namespace pg8 {
#define PG8_LAS __attribute__((address_space(3)))
typedef unsigned short bf16_t;
typedef short bf16x8 __attribute__((ext_vector_type(8)));
typedef float f32x4 __attribute__((ext_vector_type(4)));
typedef unsigned u32x4 __attribute__((ext_vector_type(4)));
constexpr int BM = 256, BK = 64, HALF = 128, HTB = HALF * BK * 2  , STAGE_BYTES = 8 * HTB, NXCD = 8, WGM = 8;

__host__ __device__ __forceinline__ int lds_byte(int r, int c) { const int st = (r >> 4) * 2 + (c >> 5), rr = r & 15, cc = c & 31, ob = rr * 64 + cc * 2; return st * 1024 + (ob ^ (((ob >> 9) & 1) << 5)); }
__host__ __device__ __forceinline__ void stage_rc(int b, int& R, int& C) { const int st = b / 1024, sb = b % 1024, swz = sb ^ (((sb >> 9) & 1) << 5); R = (st >> 1) * 16 + swz / 64; C = (st & 1) * 32 + (swz % 64) / 2; }
__host__ __device__ __forceinline__ int perm32(int rho) { const int n = rho >> 4, i = rho & 15; return 8 * (i >> 2) + 4 * n + (i & 3); }

struct Unit { int pm, pn; };
struct Gemm { const bf16_t* A; const bf16_t* Bt; int M, N, K; };

struct StaticOrder {
    int nM, nN, nwg, G, c;
    __host__ __device__ void init(int M, int N, int G_, int c_) { nM = M / BM; nN = N / BM; nwg = nM * nN; G = G_; c = c_; }
    __host__ __device__ bool next(int i, Unit& u) const {
        const long L = (long)i * G + c; if (L >= nwg) return false;
        int wgid = (int)L; { const int q = nwg / NXCD, r = nwg % NXCD, xcd = wgid % NXCD, off = wgid / NXCD; wgid = (xcd < r ? xcd * (q + 1) : r * (q + 1) + (xcd - r) * q) + off; }
        const int nig = WGM * nN, gid = wgid / nig, fm = gid * WGM, gsz = (nM - fm) < WGM ? (nM - fm) : WGM;
        u.pm = fm + ((wgid % nig) % gsz); u.pn = (wgid % nig) / gsz; return true;
    }
    __device__ __forceinline__ void a_ready(const Unit&) const {}
    __device__ __forceinline__ void done(const Unit&) const {}
};

__device__ __forceinline__ unsigned cvt_pk_bf16(float lo, float hi) { unsigned r; asm volatile("v_cvt_pk_bf16_f32 %0, %1, %2" : "=v"(r) : "v"(lo), "v"(hi)); return r; }
template <class Epi, class Sched, bool ALIGN_EPI = false, bool SP2 = false>
__device__ __forceinline__ void gemm_phase(PG8_LAS unsigned char* lds, const Gemm g, const Sched& S, const Epi& E) {
    const int tid = threadIdx.x, wid = __builtin_amdgcn_readfirstlane(tid >> 6), lane = tid & 63, wr = wid >> 2, wc = wid & 3, fr = lane & 15, fq = lane >> 4;
    const int K = g.K, nt = K / BK;
    unsigned voffA[2], voffB[2];
#pragma unroll
    for (int i = 0; i < 2; ++i) { int R, C; stage_rc(tid * 16 + i * 8192, R, C); const int Rb = Epi::PERM ? ((R & ~31) + perm32(R & 31)) : R;
        voffA[i] = (unsigned)(R * K + C) * 2u; voffB[i] = (unsigned)(Rb * K + C) * 2u; }
    const size_t kstep = (size_t)(BK * 2);
    const size_t hstep = (size_t)HALF * K * 2;
    const size_t tstep = 2 * hstep;
    const unsigned ldsw = (unsigned)wid * 1024u;
    const int aoff = lds_byte(wr * 64 + fr, fq * 8), boff = lds_byte(wc * 32 + fr, fq * 8);
#define PG8_SA(b, h) (((b) * 2 + (h)) * HTB)
#define PG8_SB(b, h) ((4 + (b) * 2 + (h)) * HTB)
#define PG8_STAGE(bufoff, gbase, voff) do { _Pragma("unroll") for (int _i = 0; _i < 2; ++_i) \
        __builtin_amdgcn_global_load_lds((const unsigned*)((const char*)(gbase) + (voff)[_i]), (PG8_LAS unsigned*)(lds + (bufoff) + ldsw + _i * 8192), 16, 0, 0); } while (0)
#define PG8_LDA(dst, b, h) do { _Pragma("unroll") for (int m = 0; m < 4; ++m) _Pragma("unroll") for (int k = 0; k < 2; ++k) dst[m][k] = *(const PG8_LAS bf16x8*)(lds + PG8_SA(b, h) + aoff + m * 2048 + k * 1024); } while (0)
#define PG8_LDB(dst, b, h) do { _Pragma("unroll") for (int n = 0; n < 2; ++n) _Pragma("unroll") for (int k = 0; k < 2; ++k) dst[n][k] = *(const PG8_LAS bf16x8*)(lds + PG8_SB(b, h) + boff + n * 2048 + k * 1024); } while (0)
#define PG8_MMA(ai, bj, At, Bt) do { __builtin_amdgcn_s_setprio(1); _Pragma("unroll") for (int m = 0; m < 4; ++m) _Pragma("unroll") for (int n = 0; n < 2; ++n) _Pragma("unroll") for (int k = 0; k < 2; ++k) \
        acc[ai][bj][m][n] = __builtin_amdgcn_mfma_f32_16x16x32_bf16(Bt[n][k], At[m][k], acc[ai][bj][m][n], 0, 0, 0); __builtin_amdgcn_s_setprio(0); } while (0)
#define PG8_WAIT_V(n) asm volatile("s_waitcnt vmcnt(" #n ")" ::: "memory")
#define PG8_WAIT_L(n) asm volatile("s_waitcnt lgkmcnt(" #n ")" ::: "memory")
#define PG8_BAR __builtin_amdgcn_s_barrier()
#define PG8_SCHED __builtin_amdgcn_sched_barrier(0)
    Unit cur, nxt; int ui = 0;
    if (!S.next(0, cur)) return;
    f32x4 acc[2][2][4][2];
#pragma unroll
    for (int a = 0; a < 2; ++a)
#pragma unroll
        for (int b = 0; b < 2; ++b)
#pragma unroll
            for (int m = 0; m < 4; ++m)
#pragma unroll
                for (int n = 0; n < 2; ++n) acc[a][b][m][n] = (f32x4){0.f, 0.f, 0.f, 0.f};
    bf16x8 At[4][2], B0[2][2], B1[2][2];
    const char* cA = (const char*)g.A + (size_t)cur.pm * tstep; const char* cB = (const char*)g.Bt + (size_t)cur.pn * tstep;
    S.a_ready(cur);
    if constexpr (SP2) {
        PG8_STAGE(PG8_SB(0, 0), cB, voffB); PG8_STAGE(PG8_SB(0, 1), cB + hstep, voffB); PG8_STAGE(PG8_SA(0, 0), cA, voffA); PG8_STAGE(PG8_SA(0, 1), cA + hstep, voffA);
        if (wr == 1) PG8_BAR;
        PG8_WAIT_V(2); PG8_BAR;
        PG8_STAGE(PG8_SB(1, 0), cB + kstep, voffB); PG8_STAGE(PG8_SA(1, 0), cA + kstep, voffA); PG8_STAGE(PG8_SB(1, 1), cB + hstep + kstep, voffB);
        PG8_WAIT_V(6); PG8_BAR;
    } else {
        PG8_STAGE(PG8_SB(0, 0), cB, voffB); PG8_STAGE(PG8_SA(0, 0), cA, voffA); PG8_STAGE(PG8_SB(0, 1), cB + hstep, voffB); PG8_STAGE(PG8_SA(0, 1), cA + hstep, voffA);
        if (wr == 1) PG8_BAR;
        PG8_WAIT_V(4); PG8_BAR;
        PG8_STAGE(PG8_SB(1, 0), cB + kstep, voffB); PG8_STAGE(PG8_SA(1, 0), cA + kstep, voffA); PG8_STAGE(PG8_SB(1, 1), cB + hstep + kstep, voffB);
        PG8_WAIT_V(6); PG8_BAR;
    }
    for (;;) {
        const bool has_next = S.next(ui + 1, nxt);
        const char* nA = has_next ? (const char*)g.A + (size_t)nxt.pm * tstep : cA; const char* nB = has_next ? (const char*)g.Bt + (size_t)nxt.pn * tstep : cB;
        for (int t = 0; t < nt; t += 2) {
            const bool last = (t == nt - 2);
            const char* a1 = cA + (size_t)(t + 1) * kstep;
            const char* a2 = last ? nA : cA + (size_t)(t + 2) * kstep; const char* b2 = last ? nB : cB + (size_t)(t + 2) * kstep;
            const char* a3 = a2 + kstep; const char* b3 = b2 + kstep;
            if (last && has_next) S.a_ready(nxt);
            if constexpr (SP2) {
            PG8_LDB(B0, 0, 0); PG8_LDB(B1, 0, 1); PG8_SCHED; PG8_LDA(At, 0, 0); PG8_STAGE(PG8_SA(1, 1), a1 + hstep, voffA);
            PG8_WAIT_V(8); PG8_WAIT_L(0); PG8_BAR; PG8_MMA(0, 0, At, B0); PG8_MMA(0, 1, At, B1); PG8_BAR; PG8_SCHED;
            PG8_LDA(At, 0, 1); PG8_STAGE(PG8_SB(0, 0), b2, voffB); PG8_STAGE(PG8_SB(0, 1), b2 + hstep, voffB); PG8_STAGE(PG8_SA(0, 0), a2, voffA);
            PG8_WAIT_V(8); PG8_WAIT_L(0); PG8_BAR; PG8_MMA(1, 0, At, B0); PG8_MMA(1, 1, At, B1); PG8_BAR; PG8_SCHED;
            PG8_LDB(B0, 1, 0); PG8_LDB(B1, 1, 1); PG8_SCHED; PG8_LDA(At, 1, 0); PG8_STAGE(PG8_SA(0, 1), a2 + hstep, voffA);
            PG8_WAIT_V(8); PG8_WAIT_L(0); PG8_BAR; PG8_MMA(0, 0, At, B0); PG8_MMA(0, 1, At, B1); PG8_BAR; PG8_SCHED;
            PG8_LDA(At, 1, 1); PG8_STAGE(PG8_SB(1, 0), b3, voffB); PG8_STAGE(PG8_SB(1, 1), b3 + hstep, voffB); PG8_STAGE(PG8_SA(1, 0), a3, voffA);
            PG8_WAIT_V(8); PG8_WAIT_L(0); PG8_BAR; PG8_MMA(1, 0, At, B0); PG8_MMA(1, 1, At, B1); PG8_BAR; PG8_SCHED;
            } else {
            PG8_LDB(B0, 0, 0); PG8_SCHED; PG8_LDA(At, 0, 0); PG8_STAGE(PG8_SA(1, 1), a1 + hstep, voffA);
            PG8_WAIT_L(8); PG8_BAR; PG8_WAIT_L(0); PG8_MMA(0, 0, At, B0); PG8_BAR; PG8_SCHED;
            PG8_LDB(B1, 0, 1); PG8_STAGE(PG8_SB(0, 0), b2, voffB);
            PG8_BAR; PG8_WAIT_L(0); PG8_MMA(0, 1, At, B1); PG8_BAR;
            PG8_LDA(At, 0, 1); PG8_STAGE(PG8_SA(0, 0), a2, voffA);
            PG8_BAR; PG8_WAIT_L(0); PG8_MMA(1, 0, At, B0); PG8_BAR; PG8_SCHED;
            PG8_STAGE(PG8_SB(0, 1), b2 + hstep, voffB);
            PG8_WAIT_V(6); PG8_BAR; PG8_MMA(1, 1, At, B1); PG8_BAR;
            PG8_LDB(B0, 1, 0); PG8_SCHED; PG8_LDA(At, 1, 0); PG8_STAGE(PG8_SA(0, 1), a2 + hstep, voffA);
            PG8_WAIT_L(8); PG8_BAR; PG8_WAIT_L(0); PG8_MMA(0, 0, At, B0); PG8_BAR; PG8_SCHED;
            PG8_LDB(B1, 1, 1); PG8_STAGE(PG8_SB(1, 0), b3, voffB);
            PG8_BAR; PG8_WAIT_L(0); PG8_MMA(0, 1, At, B1); PG8_BAR;
            PG8_LDA(At, 1, 1); PG8_STAGE(PG8_SA(1, 0), a3, voffA);
            PG8_BAR; PG8_WAIT_L(0); PG8_MMA(1, 0, At, B0); PG8_BAR; PG8_SCHED;
            PG8_STAGE(PG8_SB(1, 1), b3 + hstep, voffB);
            PG8_WAIT_V(6); PG8_BAR; PG8_MMA(1, 1, At, B1); PG8_BAR;
            }
        }
        if constexpr (ALIGN_EPI) { if (wr == 0) PG8_BAR; }
        if constexpr (!Epi::AFTER_DRAIN) { E(acc, cur, wr, wc, fr, fq);
#ifdef PROBE_EPI2
            if constexpr (Epi::PROBE_ID == PROBE_EPI2) { asm volatile("" ::: "memory"); E(acc, cur, wr, wc, fr, fq); }
#endif
            S.done(cur); }
        if (!has_next) break;
#pragma unroll
        for (int a = 0; a < 2; ++a)
#pragma unroll
            for (int b = 0; b < 2; ++b)
#pragma unroll
                for (int m = 0; m < 4; ++m)
#pragma unroll
                    for (int n = 0; n < 2; ++n) acc[a][b][m][n] = (f32x4){0.f, 0.f, 0.f, 0.f};
        cur = nxt; cA = nA; cB = nB; ++ui;
        if constexpr (ALIGN_EPI) { if (wr == 1) PG8_BAR; }
    }
    PG8_WAIT_V(0);
    if constexpr (!ALIGN_EPI) { if (wr == 0) PG8_BAR; }
    PG8_BAR;
    if constexpr (Epi::AFTER_DRAIN) { E.fused(acc, cur, wr, wc, fr, fq, lds, wid, lane); S.done(cur); }
#undef PG8_SA
#undef PG8_SB
#undef PG8_STAGE
#undef PG8_LDA
#undef PG8_LDB
#undef PG8_MMA
#undef PG8_WAIT_V
#undef PG8_WAIT_L
#undef PG8_BAR
#undef PG8_SCHED
}
}
#ifndef PG8_SP2
#define PG8_SP2 true
#endif
#ifndef PG8_ALIGN
#define PG8_ALIGN true
#endif
#ifndef MK_COOP
#define MK_COOP 1
#endif

#define LAS __attribute__((address_space(3)))
typedef unsigned short bf16;
typedef unsigned v4u __attribute__((ext_vector_type(4)));
typedef unsigned v2u __attribute__((ext_vector_type(2)));
typedef float f32x4 __attribute__((ext_vector_type(4)));
typedef float f32x16 __attribute__((ext_vector_type(16)));
typedef short bf16x8 __attribute__((ext_vector_type(8)));
typedef short v4i16_t __attribute__((ext_vector_type(4)));
typedef float f32x2_t __attribute__((ext_vector_type(2)));
typedef __bf16 bf16x2_t __attribute__((ext_vector_type(2)));

constexpr int D = 1024, MP = 4096, MS = 32768, M = MP + MS, NIN = 3072, DFF = 2816, NFI = 2 * DFF;
constexpr int SEQ_P = 256, SEQ_S = 4096, PAST = 256, NB_S = 8, NB_P = 16;
constexpr int KV_PER_B = PAST + SEQ_S;
constexpr int KROWS = MP + NB_S * KV_PER_B;
constexpr float EPS = 1e-6f;
constexpr float QSCALE = 0.125f * 1.4426950408889634f;
constexpr int NWAVES = 8, NTHREADS = 512;

constexpr size_t MiB = 1u << 20;
constexpr size_t WS_MOD = 0;
constexpr size_t WS_ROT = 256 * 1024;
constexpr size_t WS_BAR = 512 * 1024, BAR_BYTES = 16384;
constexpr size_t WS_SS1 = 1 * MiB;
constexpr size_t WS_SS2 = 4 * MiB;
constexpr size_t WS_WIN = 8 * MiB, WS_WO = 14 * MiB, WS_WFI = 16 * MiB, WS_WFO = 27 * MiB;
constexpr size_t WS_U = 34 * MiB;
constexpr size_t WS_MIXO = 106 * MiB;
constexpr size_t WS_Q = 178 * MiB;
constexpr size_t WS_K = 214 * MiB;
constexpr size_t WS_V = 252 * MiB;
constexpr size_t WS_MIX = 290 * MiB;
constexpr size_t WS_BG = 362 * MiB;
constexpr size_t WS_Z = 398 * MiB;
constexpr size_t WS_H = 178 * MiB;
constexpr size_t WS_END = 434 * MiB;
static_assert(WS_H + (size_t)M * DFF * 2 <= WS_Z, "H overlay");
static_assert(WS_K + (size_t)KROWS * 512 * 2 <= WS_V && WS_V + (size_t)KROWS * 512 * 2 <= WS_MIX, "kv map");

constexpr int MISC_OFF = 131072 + 1024;
constexpr int LDS_BYTES = 131072 + 2048;

__device__ __forceinline__ unsigned pk2(float lo, float hi) { f32x2_t v = {lo, hi}; bf16x2_t b = __builtin_convertvector(v, bf16x2_t); return __builtin_bit_cast(unsigned, b); }
__device__ __forceinline__ float bf2f(unsigned short b) { return __uint_as_float((unsigned)b << 16); }
template <int CTRL> __device__ __forceinline__ float dpp_mov(float v) { return __builtin_bit_cast(float, __builtin_amdgcn_mov_dpp(__builtin_bit_cast(int, v), CTRL, 0xF, 0xF, false)); }
__device__ __forceinline__ float row16_sum(float v) {
    v += dpp_mov<0xB1>(v);
    v += dpp_mov<0x4E>(v);
    v += dpp_mov<0x124>(v);
    v += dpp_mov<0x128>(v);
    return v;
}
__device__ __forceinline__ float add_swap16(float v) { auto rr = __builtin_amdgcn_permlane16_swap(__float_as_uint(v), __float_as_uint(v), false, false); return __uint_as_float(rr[0]) + __uint_as_float(rr[1]); }
__device__ __forceinline__ float add_swap32(float v) { auto rr = __builtin_amdgcn_permlane32_swap(__float_as_uint(v), __float_as_uint(v), false, false); return __uint_as_float(rr[0]) + __uint_as_float(rr[1]); }
__device__ __forceinline__ float wave_sum(float v) { return add_swap32(add_swap16(row16_sum(v))); }
__device__ __forceinline__ int krow_of(int r) { return r < MP ? r : MP + ((r - MP) >> 12) * KV_PER_B + PAST + ((r - MP) & 4095); }

#define XB_TMO      128
#define XB_XCNT(j)  (256  + 64 * (j))
#define XB_XSUB(j)  (1280 + 64 * (j))
#define XB_XGEN(j)  (2304 + 64 * (j))
#define XB_TOP      3328
#define XB_TOPGEN   3392
#define XCD_BAR_WORDS 3456
#define XB_SPIN_CAP (1u << 18)

__device__ __forceinline__ unsigned xb_ld(unsigned* p)              { return __hip_atomic_load(p, __ATOMIC_RELAXED, __HIP_MEMORY_SCOPE_AGENT); }
__device__ __forceinline__ unsigned xb_add(unsigned* p, unsigned v) { return __hip_atomic_fetch_add(p, v, __ATOMIC_RELAXED, __HIP_MEMORY_SCOPE_AGENT); }
__device__ __forceinline__ unsigned xb_xcc_id() { return (unsigned)__builtin_amdgcn_s_getreg((3 << 11) | 20) & 0xFu; }
#define XB_SPIN(cond, bar) do { unsigned _sp = 0; while (cond) { __builtin_amdgcn_s_sleep(1); \
    if ((++_sp & 255u) == 0u) { if (xb_ld(&(bar)[XB_TMO])) break; if (_sp > XB_SPIN_CAP) { atomicAdd(&(bar)[XB_TMO], 1u); break; } } } } while (0)

struct XcdBarrier {
    unsigned* bar; unsigned x;
    volatile LAS unsigned* st;
};

__device__ __forceinline__ XcdBarrier xcd_barrier_post(unsigned* bar, volatile LAS unsigned* st) {
    XcdBarrier b; b.bar = bar; b.x = xb_xcc_id(); b.st = st;
    if (threadIdx.x == 0) (void)xb_add(&bar[XB_XCNT(b.x)], 1u);
    return b;
}
__device__ __forceinline__ void xcd_barrier_complete(unsigned* bar, unsigned x, unsigned& nloc, unsigned& nx) {
    const unsigned G = gridDim.x * gridDim.y * gridDim.z;
    unsigned sum, cnt, mine, sp = 0u;
    for (;;) {
        sum = 0u; cnt = 0u; mine = 0u;
#pragma unroll
        for (unsigned j = 0; j < 16; ++j) { const unsigned c = xb_ld(&bar[XB_XCNT(j)]); sum += c; cnt += (c > 0u) ? 1u : 0u; mine = (j == x) ? c : mine; }
        if (sum == G) break;
        __builtin_amdgcn_s_sleep(1);
        if ((++sp & 255u) == 0u) { if (xb_ld(&bar[XB_TMO])) break; if (sp > XB_SPIN_CAP) { atomicAdd(&bar[XB_TMO], 1u); break; } }
    }
    nloc = mine > 0u ? mine : 1u; nx = cnt > 0u ? cnt : 1u;
}

__device__ __forceinline__ void xcd_barrier(const XcdBarrier& b) {
    asm volatile("s_waitcnt vmcnt(0)" ::: "memory");
    __syncthreads();
    if (threadIdx.x == 0) {
        unsigned* bar = b.bar;
        __builtin_amdgcn_s_waitcnt(0);
        unsigned nloc = b.st[0], nx = b.st[1];
        if (nloc == 0u) { xcd_barrier_complete(bar, b.x, nloc, nx); b.st[0] = nloc; b.st[1] = nx; }
        const unsigned old = xb_add(&bar[XB_XSUB(b.x)], 1u);
        const unsigned gen = old / nloc;
        if (old + 1u == (gen + 1u) * nloc) {
            __builtin_amdgcn_fence(__ATOMIC_RELEASE, "agent");
            asm volatile("s_waitcnt vmcnt(0)" ::: "memory");
            const unsigned og = xb_add(&bar[XB_TOP], 1u);
            const unsigned tg = og / nx;
            if (og + 1u == (tg + 1u) * nx) xb_add(&bar[XB_TOPGEN], 1u);
            else XB_SPIN(xb_ld(&bar[XB_TOPGEN]) == tg, bar);
            __builtin_amdgcn_fence(__ATOMIC_ACQUIRE, "agent");
            xb_add(&bar[XB_XGEN(b.x)], 1u);
            asm volatile("s_waitcnt vmcnt(0)" ::: "memory");
        } else {
            XB_SPIN(xb_ld(&bar[XB_XGEN(b.x)]) == gen, bar);
            __builtin_amdgcn_fence(__ATOMIC_ACQUIRE, "agent");
            asm volatile("s_waitcnt vmcnt(0)" ::: "memory");
        }
    }
    __syncthreads();
}

namespace pg8 {
struct EpiIn {
    static constexpr bool PERM = true, AFTER_DRAIN = false; static constexpr int PROBE_ID = 1;
    bf16_t *Q, *Kb, *Vb, *BG, *Z; float *stK, *stV; const float* rot;
    __device__ __forceinline__ void operator()(const f32x4 (&acc)[2][2][4][2], const Unit& u, int wr, int wc, int fr, int fq) const {
        const int pn = u.pn; const bool sample = u.pm >= (MP / 256);
        const int rbase = u.pm * BM + wr * 64 + fr;
        const int cp = wc * 32 + 8 * fq;
        if (pn < 4) {
            const bool isq = pn < 2; const int cbp = (pn & 1) * 256 + cp, cbl = (pn & 1) * 256 + wc * 32 + 4 * fq;
            const float qs = isq ? QSCALE : 1.0f;
#pragma unroll
            for (int ai = 0; ai < 2; ++ai)
#pragma unroll
                for (int m = 0; m < 4; ++m) {
                    const int r = rbase + ai * HALF + m * 16;
                    f32x4 cs = (f32x4){1.f, 1.f, 1.f, 1.f}, sn = (f32x4){0.f, 0.f, 0.f, 0.f};
                    if (sample) { const int t = (r - MP) & 4095; const int pos = (wc & 1) ? (t & 63) : (t >> 6);
                        cs = *(const f32x4*)(rot + pos * 16 + 4 * fq); sn = *(const f32x4*)(rot + 1024 + pos * 16 + 4 * fq); }
                    cs = cs * qs; sn = sn * qs;
                    const size_t kr = (size_t)krow_of(r);
#pragma unroll
                    for (int bj = 0; bj < 2; ++bj) {
                        const f32x4 x1 = acc[ai][bj][m][0], x2 = acc[ai][bj][m][1];
                        const f32x4 o1 = x1 * cs - x2 * sn, o2 = x2 * cs + x1 * sn;
                        u32x4 w; w.x = pk2(o1[0], o1[1]); w.y = pk2(o1[2], o1[3]); w.z = pk2(o2[0], o2[1]); w.w = pk2(o2[2], o2[3]);
                        if (isq) *(u32x4*)(Q + (size_t)r * 512 + cbp + bj * HALF) = w;
                        else { *(u32x4*)(Kb + kr * 512 + cbp + bj * HALF) = w;
                            if (!sample) { float* s = stK + (size_t)r * 512 + cbl + bj * HALF; *(f32x4*)s = x1; *(f32x4*)(s + 16) = x2; } }
                    }
                }
        } else if (pn < 8) {
            const bool isv = pn < 6; const int cb = (pn & 1) * 256 + cp;
#pragma unroll
            for (int ai = 0; ai < 2; ++ai)
#pragma unroll
                for (int m = 0; m < 4; ++m) {
                    const int r = rbase + ai * HALF + m * 16;
                    const size_t orow = isv ? (size_t)krow_of(r) : (size_t)r;
                    bf16_t* base = (isv ? Vb : BG) + orow * 512 + cb;
#pragma unroll
                    for (int bj = 0; bj < 2; ++bj) {
                        const f32x4 x1 = acc[ai][bj][m][0], x2 = acc[ai][bj][m][1];
                        u32x4 w; w.x = pk2(x1[0], x1[1]); w.y = pk2(x1[2], x1[3]); w.z = pk2(x2[0], x2[1]); w.w = pk2(x2[2], x2[3]);
                        *(u32x4*)(base + bj * HALF) = w;
                        if (isv && !sample) { float* s = stV + (size_t)r * 512 + cb + bj * HALF; *(f32x4*)s = x1; *(f32x4*)(s + 4) = x2; }
                    }
                }
        } else {
            const int cb = (pn - 8) * 128 + cp;
#pragma unroll
            for (int ai = 0; ai < 2; ++ai)
#pragma unroll
                for (int m = 0; m < 4; ++m) {
                    const int r = rbase + ai * HALF + m * 16;
                    const f32x4 z1 = acc[ai][0][m][0] * acc[ai][1][m][0], z2 = acc[ai][0][m][1] * acc[ai][1][m][1];
                    u32x4 w; w.x = pk2(z1[0], z1[1]); w.y = pk2(z1[2], z1[3]); w.z = pk2(z2[0], z2[1]); w.w = pk2(z2[2], z2[3]);
                    *(u32x4*)(Z + (size_t)r * 512 + cb) = w;
                }
        }
    }
};
struct EpiSS {
    static constexpr bool PERM = true, AFTER_DRAIN = false; static constexpr int PROBE_ID = 2;
    bf16_t* O; float* SS;
    __device__ __forceinline__ void operator()(const f32x4 (&acc)[2][2][4][2], const Unit& u, int wr, int wc, int fr, int fq) const {
        const int rbase = u.pm * BM + wr * 64 + fr; const int c0 = u.pn * BM + wc * 32 + 8 * fq;
#pragma unroll
        for (int ai = 0; ai < 2; ++ai)
#pragma unroll
            for (int m = 0; m < 4; ++m) {
                const int r = rbase + ai * HALF + m * 16; float s = 0.f;
#pragma unroll
                for (int bj = 0; bj < 2; ++bj) {
                    const f32x4 v0 = acc[ai][bj][m][0], v1 = acc[ai][bj][m][1];
                    s += (v0[0] * v0[0] + v0[1] * v0[1]) + (v0[2] * v0[2] + v0[3] * v0[3]) + (v1[0] * v1[0] + v1[1] * v1[1]) + (v1[2] * v1[2] + v1[3] * v1[3]);
                    u32x4 w; w.x = pk2(v0[0], v0[1]); w.y = pk2(v0[2], v0[3]); w.z = pk2(v1[0], v1[1]); w.w = pk2(v1[2], v1[3]);
                    *(u32x4*)(O + (size_t)r * D + c0 + bj * HALF) = w;
                }
                s = add_swap32(add_swap16(s));
                if (fq == 0) SS[(size_t)r * 16 + u.pn * 4 + wc] = s;
            }
    }
};
struct EpiGlu {
    static constexpr bool PERM = true, AFTER_DRAIN = false; static constexpr int PROBE_ID = 3;
    bf16_t* H;
    __device__ __forceinline__ void operator()(const f32x4 (&acc)[2][2][4][2], const Unit& u, int wr, int wc, int fr, int fq) const {
        const int rbase = u.pm * BM + wr * 64 + fr; const int c0 = u.pn * HALF + wc * 32 + 8 * fq;
#pragma unroll
        for (int ai = 0; ai < 2; ++ai)
#pragma unroll
            for (int m = 0; m < 4; ++m) {
                const int r = rbase + ai * HALF + m * 16; f32x4 hv[2];
#pragma unroll
                for (int n = 0; n < 2; ++n) { const f32x4 g = acc[ai][0][m][n], up = acc[ai][1][m][n];
                    f32x4 e; e[0] = __builtin_amdgcn_exp2f(g[0]); e[1] = __builtin_amdgcn_exp2f(g[1]); e[2] = __builtin_amdgcn_exp2f(g[2]); e[3] = __builtin_amdgcn_exp2f(g[3]);
                    const f32x4 d = e + 1.0f;
                    f32x4 rc; rc[0] = __builtin_amdgcn_rcpf(d[0]); rc[1] = __builtin_amdgcn_rcpf(d[1]); rc[2] = __builtin_amdgcn_rcpf(d[2]); rc[3] = __builtin_amdgcn_rcpf(d[3]);
                    hv[n] = (g * up) * rc; }
                u32x4 w; w.x = pk2(hv[0][0], hv[0][1]); w.y = pk2(hv[0][2], hv[0][3]); w.z = pk2(hv[1][0], hv[1][1]); w.w = pk2(hv[1][2], hv[1][3]);
                *(u32x4*)(H + (size_t)r * DFF + c0) = w;
            }
    }
};
}

namespace att {
constexpr int TILEB = 16384, NSLOT = 3, VRING = NSLOT * TILEB, WSF_OFF = 2 * NSLOT * TILEB, LDS_NEED = WSF_OFF + NWAVES * 256;
static_assert(LDS_NEED <= 131072 && 4 * 32 * 128 * 4 <= WSF_OFF, "attention LDS");
constexpr float THR = 8.f;
__device__ __forceinline__ int crow(int r, int hi) { return (r & 3) + 8 * (r >> 2) + 4 * hi; }
__device__ __forceinline__ bf16x8 vfrag(const LAS char* p0, const LAS char* p1) {
    const v4i16_t lo = __builtin_amdgcn_ds_read_tr16_b64_v4i16((LAS v4i16_t*)p0), hi = __builtin_amdgcn_ds_read_tr16_b64_v4i16((LAS v4i16_t*)p1);
    return (bf16x8){lo[0], lo[1], lo[2], lo[3], hi[0], hi[1], hi[2], hi[3]};
}
__device__ __forceinline__ void glds16(const void* gsrc, unsigned lds_dst) { unsigned keep;
    asm volatile("s_mov_b32 %0, m0\n\ts_mov_b32 m0, %2\n\ts_nop 0\n\tglobal_load_lds_dwordx4 %1, off\n\ts_mov_b32 m0, %0" : "=&s"(keep) : "v"(gsrc), "s"(lds_dst) : "memory"); }
__device__ __forceinline__ void glds16s(const void* sbase, unsigned voff, unsigned lds_dst) { unsigned keep;
    asm volatile("s_mov_b32 %0, m0\n\ts_mov_b32 m0, %3\n\ts_nop 0\n\tglobal_load_lds_dwordx4 %1, %2\n\ts_mov_b32 m0, %0" : "=&s"(keep) : "v"(voff), "s"(sbase), "s"(lds_dst) : "memory"); }
__device__ __forceinline__ float swapmax(float m) { auto rr = __builtin_amdgcn_permlane32_swap(__float_as_uint(m), __float_as_uint(m), false, false); return fmaxf(__uint_as_float(rr[0]), __uint_as_float(rr[1])); }
#define ATT_WAIT_BAR(N) asm volatile("s_waitcnt vmcnt(" #N ") lgkmcnt(0)\n\ts_barrier" ::: "memory")
#define ATT_SB() __builtin_amdgcn_sched_barrier(0)
struct AttnCtx {
    LAS char* lds; LAS float* wsf; const char* kg; const char* vg; unsigned soff[2]; unsigned lds0; int ka[4]; int va[2][4]; int r32, hi, NT;
};
__device__ __forceinline__ float max3f(float a, float b, float c) { return fmaxf(fmaxf(a, b), c); }
template <bool LAST, int S0, bool DOMAX>
__device__ __forceinline__ void attn_step(const AttnCtx& C, int t, f32x16& P0, f32x16& P1, f32x16& N0, f32x16& N1, f32x16 (&o)[4], f32x16& negm, const bf16x8 (&qr)[4], float& mhat, float& l, float& rm) {
    constexpr int s0 = S0, s1 = (S0 + 1) % 3, s2 = (S0 + 2) % 3;
    const bool ik = (t + 3 < C.NT), iv = (t + 2 < C.NT);
    const LAS char* kb = C.lds + s1 * TILEB; const LAS char* vb = C.lds + s0 * TILEB;
    bf16x8 kf[8], vf[16];
#define ATT_KF(i) (*(const LAS bf16x8*)(kb + C.ka[(i) >> 1] + ((i) & 1) * 8192))
#define ATT_VF(n) vfrag(vb + C.va[0][(n) & 3] + ((n) >> 2) * 4096, vb + C.va[1][(n) & 3] + ((n) >> 2) * 4096)
    if (!LAST) { kf[0] = ATT_KF(0); kf[1] = ATT_KF(1); }
#ifdef PROBE_DMA2
    if (ik) { const char* p_ = C.kg + (size_t)(t + 3) * 65536; const unsigned d_ = (unsigned)__builtin_amdgcn_readfirstlane(C.lds0 + s0 * TILEB); glds16(p_ + C.soff[0], d_); glds16(p_ + C.soff[1], d_ + 1024); glds16(p_ + C.soff[0], d_); glds16(p_ + C.soff[1], d_ + 1024); }
    if (iv) { const char* p_ = C.vg + (size_t)(t + 2) * 65536; const unsigned d_ = (unsigned)__builtin_amdgcn_readfirstlane(C.lds0 + VRING + s2 * TILEB); glds16(p_ + C.soff[0], d_); glds16(p_ + C.soff[1], d_ + 1024); glds16(p_ + C.soff[0], d_); glds16(p_ + C.soff[1], d_ + 1024); }
#else
    if (ik) { const char* p_ = C.kg + (size_t)(t + 3) * 65536; const unsigned d_ = (unsigned)__builtin_amdgcn_readfirstlane(C.lds0 + s0 * TILEB); glds16s(p_, C.soff[0], d_); glds16s(p_, C.soff[1], d_ + 1024); }
    if (iv) { const char* p_ = C.vg + (size_t)(t + 2) * 65536; const unsigned d_ = (unsigned)__builtin_amdgcn_readfirstlane(C.lds0 + VRING + s2 * TILEB); glds16s(p_, C.soff[0], d_); glds16s(p_, C.soff[1], d_ + 1024); }
#endif
    ATT_SB();
    if (__any(rm > THR)) {
        const float dl = fmaxf(rm, 0.f);
        mhat += dl;
#pragma unroll
        for (int r = 0; r < 16; ++r) { P0[r] -= dl; P1[r] -= dl; negm[r] = -mhat; }
        const float f = __builtin_amdgcn_exp2f(-dl); l *= f;
        C.wsf[C.r32] = f;
#pragma unroll
        for (int r = 0; r < 16; ++r) { const float fr_ = C.wsf[crow(r, C.hi)];
#pragma unroll
            for (int db = 0; db < 4; ++db) o[db][r] *= fr_; }
    }
    ATT_SB();
    float ls = 0.f; v4u pwu[4]; float rn = -INFINITY;
#define ATT_SOFT(g) do { _Pragma("unroll") for (int e_ = ((g) < 4 ? 0 : 2 * ((g) - 4)); e_ < ((g) < 4 ? 0 : (2 * ((g) - 3) < 32 ? 2 * ((g) - 3) : 32)); ++e_) { \
        float x_; if (e_ < 16) { x_ = __builtin_amdgcn_exp2f(P0[e_ & 15]); P0[e_ & 15] = x_; } else { x_ = __builtin_amdgcn_exp2f(P1[e_ & 15]); P1[e_ & 15] = x_; } \
        ls += x_; \
        if (e_ & 1) { unsigned w_ = pk2(e_ < 16 ? P0[(e_ - 1) & 15] : P1[(e_ - 1) & 15], x_); asm volatile("" : "+v"(w_)); pwu[e_ >> 3][(e_ >> 1) & 3] = w_; } } \
        asm volatile("" : "+v"(ls)); \
        if (DOMAX && (g) >= 20) { _Pragma("unroll") for (int k_ = 4 * ((g) - 20); k_ < 4 * ((g) - 20) + 4; ++k_) rn = max3f(rn, N0[k_ & 15], N1[k_ & 15]); asm volatile("" : "+v"(rn)); } } while (0)
#pragma unroll
    for (int i = 0; i < 8; ++i) {
        if (!LAST) {
            if (i == 0)      N0 = __builtin_amdgcn_mfma_f32_32x32x16_bf16(kf[i], qr[i >> 1], negm, 0, 0, 0);
            else if (i == 1) N1 = __builtin_amdgcn_mfma_f32_32x32x16_bf16(kf[i], qr[i >> 1], negm, 0, 0, 0);
            else if (i & 1)  N1 = __builtin_amdgcn_mfma_f32_32x32x16_bf16(kf[i], qr[i >> 1], N1, 0, 0, 0);
            else             N0 = __builtin_amdgcn_mfma_f32_32x32x16_bf16(kf[i], qr[i >> 1], N0, 0, 0, 0);
            if (i < 6) kf[i + 2] = ATT_KF(i + 2);
        }
        if (i >= 6) vf[i - 6] = ATT_VF(i - 6);
        ATT_SOFT(i);
        ATT_SB();
    }
#pragma unroll
    for (int j = 0; j < 8; ++j) {
        o[j & 3] = __builtin_amdgcn_mfma_f32_32x32x16_bf16(__builtin_bit_cast(bf16x8, pwu[j >> 2]), vf[j], o[j & 3], 0, 0, 0);
        vf[j + 2] = ATT_VF(j + 2);
        ATT_SOFT(8 + j);
        ATT_SB();
    }
#pragma unroll
    for (int j = 0; j < 8; ++j) {
        o[j & 3] = __builtin_amdgcn_mfma_f32_32x32x16_bf16(__builtin_bit_cast(bf16x8, pwu[2 + (j >> 2)]), vf[8 + j], o[j & 3], 0, 0, 0);
        if (j < 6) vf[8 + j + 2] = ATT_VF(8 + j + 2);
        ATT_SOFT(16 + j);
        ATT_SB();
    }
#undef ATT_SOFT
#undef ATT_KF
#undef ATT_VF
    l += ls;
    if (DOMAX) rm = swapmax(rn); else rm = 0.f;
#ifdef PROBE_DMA2
    if (ik) ATT_WAIT_BAR(8); else if (iv) ATT_WAIT_BAR(4); else ATT_WAIT_BAR(0);
#else
    if (ik) ATT_WAIT_BAR(4); else if (iv) ATT_WAIT_BAR(2); else ATT_WAIT_BAR(0);
#endif
}
__device__ __forceinline__ void attn_unit(LAS char* lds, const bf16* Q, const bf16* Kb, const bf16* Vb, bf16* MIX, int qrow0, int krow0, int NT, int h, float lam, const float* gsub) {
    const int tid = threadIdx.x, lane = tid & 63, r32 = lane & 31, hi = lane >> 5; const int wid = __builtin_amdgcn_readfirstlane(tid >> 6), qg = wid & 3, map = wid >> 2;
    AttnCtx C; C.lds = lds; C.r32 = r32; C.hi = hi; C.NT = NT;
    C.kg = (const char*)Kb + ((size_t)krow0 * 512 + h * 128) * 2;
    C.vg = (const char*)Vb + ((size_t)krow0 * 512 + h * 128) * 2;
    C.wsf = (LAS float*)(lds + WSF_OFF) + wid * 64;
    LAS float* wsf = C.wsf;
#pragma unroll
    for (int j = 0; j < 2; ++j) { const int row = 8 * wid + 4 * j + (lane >> 4); const int sw = (((lane >> 4) & 3) << 2) | ((2 * wid + j) & 3); C.soff[j] = (unsigned)(row * 1024 + (((lane & 15) ^ sw) * 16)); }
    C.lds0 = (unsigned)(uintptr_t)lds + (unsigned)wid * 2048u;
#define ATT_DMAK(t, slot) do { const char* p_ = C.kg + (size_t)(t) * 65536; const unsigned d_ = (unsigned)__builtin_amdgcn_readfirstlane(C.lds0 + (slot) * TILEB); glds16(p_ + C.soff[0], d_); glds16(p_ + C.soff[1], d_ + 1024); } while (0)
#define ATT_DMAV(t, slot) do { const char* p_ = C.vg + (size_t)(t) * 65536; const unsigned d_ = (unsigned)__builtin_amdgcn_readfirstlane(C.lds0 + VRING + (slot) * TILEB); glds16(p_ + C.soff[0], d_); glds16(p_ + C.soff[1], d_ + 1024); } while (0)
    asm volatile("s_waitcnt vmcnt(0)" ::: "memory");
    ATT_DMAK(0, 0); ATT_DMAV(0, 0); ATT_DMAK(1, 1); ATT_DMAV(1, 1);
    if (NT > 2) ATT_DMAK(2, 2);
#undef ATT_DMAK
#undef ATT_DMAV
    bf16x8 qr[4];
    { const bf16* qp = Q + (size_t)(qrow0 + 32 * qg + r32) * 512 + h * 128 + map * 64 + hi * 8;
#pragma unroll
      for (int ds = 0; ds < 4; ++ds) qr[ds] = *(const bf16x8*)(qp + ds * 16); }
    { const int swk = ((r32 & 3) << 2) | ((r32 >> 2) & 3);
#pragma unroll
      for (int ds = 0; ds < 4; ++ds) C.ka[ds] = 256 * r32 + 16 * ((8 * map + 2 * ds + hi) ^ swk);
      const int q = (lane & 15) >> 2, p = lane & 3, blk = (lane >> 4) & 1;
#pragma unroll
      for (int hh = 0; hh < 2; ++hh)
#pragma unroll
          for (int db = 0; db < 4; ++db) { const int row = 4 * hi + q + 8 * hh; const int sw = (q << 2) | ((hi + 2 * hh) & 3); C.va[hh][db] = VRING + 256 * row + 16 * ((4 * db + 2 * blk + (p >> 1)) ^ sw) + 8 * (p & 1); } }
    f32x16 o[4];
#pragma unroll
    for (int i = 0; i < 4; ++i) o[i] = (f32x16){};
    float mhat = 0.f, l = 0.f, rm; f32x16 negm;
    ATT_WAIT_BAR(0);
    f32x16 pA0 = (f32x16){}, pA1 = (f32x16){}, pB0, pB1;
    {
#pragma unroll
        for (int ds = 0; ds < 4; ++ds) {
            const bf16x8 a0 = *(const LAS bf16x8*)(lds + C.ka[ds]), a1 = *(const LAS bf16x8*)(lds + C.ka[ds] + 8192);
            pA0 = __builtin_amdgcn_mfma_f32_32x32x16_bf16(a0, qr[ds], pA0, 0, 0, 0);
            pA1 = __builtin_amdgcn_mfma_f32_32x32x16_bf16(a1, qr[ds], pA1, 0, 0, 0);
        }
        float m0 = fmaxf(pA0[0], pA1[0]);
#pragma unroll
        for (int r = 1; r < 16; ++r) m0 = fmaxf(m0, fmaxf(pA0[r], pA1[r]));
        mhat = swapmax(m0); rm = 0.f;
#pragma unroll
        for (int r = 0; r < 16; ++r) { pA0[r] -= mhat; pA1[r] -= mhat; negm[r] = -mhat; }
    }
    asm volatile("s_waitcnt lgkmcnt(0)\n\ts_barrier" ::: "memory");
    static_assert((KV_PER_B / 64) % 6 == 2 && SEQ_P / 64 == 4, "attention step remainder");
#define ATT_STEP_AB(LASTF, SLOT, MAXF, tt) attn_step<LASTF, SLOT, MAXF>(C, (tt), pA0, pA1, pB0, pB1, o, negm, qr, mhat, l, rm)
#define ATT_STEP_BA(LASTF, SLOT, MAXF, tt) attn_step<LASTF, SLOT, MAXF>(C, (tt), pB0, pB1, pA0, pA1, o, negm, qr, mhat, l, rm)
    int t = 0;
    for (; t + 6 < NT; t += 6) {
        ATT_STEP_AB(false, 0, false, t); ATT_STEP_BA(false, 1, false, t + 1); ATT_STEP_AB(false, 2, true, t + 2);
        ATT_STEP_BA(false, 0, false, t + 3); ATT_STEP_AB(false, 1, false, t + 4); ATT_STEP_BA(false, 2, true, t + 5);
    }
    ATT_STEP_AB(false, 0, false, t);
    if (NT - t == 2) { ATT_STEP_BA(true, 1, false, t + 1); }
    else { ATT_STEP_BA(false, 1, true, t + 1); ATT_STEP_AB(false, 2, false, t + 2); ATT_STEP_BA(true, 0, false, t + 3); }
#undef ATT_STEP_AB
#undef ATT_STEP_BA
    l = add_swap32(l);
    wsf[32 + r32] = l;
    float rl[16];
#pragma unroll
    for (int r = 0; r < 16; ++r) rl[r] = 1.0f / wsf[32 + crow(r, hi)];
    LAS float* X = (LAS float*)lds + qg * 4096;
    if (map == 1) {
#pragma unroll
        for (int r = 0; r < 16; ++r)
#pragma unroll
            for (int db = 0; db < 4; ++db) X[crow(r, hi) * 128 + db * 32 + r32] = o[db][r] * rl[r];
    }
    __syncthreads();
    if (map == 0) {
        float gs[4];
#pragma unroll
        for (int db = 0; db < 4; ++db) gs[db] = gsub[db * 32 + r32] * 0.8f;
#pragma unroll
        for (int r = 0; r < 16; ++r) {
            float ss = 0.f;
#pragma unroll
            for (int db = 0; db < 4; ++db) { const float v = o[db][r] * rl[r] - lam * X[crow(r, hi) * 128 + db * 32 + r32]; o[db][r] = v; ss += v * v; }
            ss = add_swap16(row16_sum(ss));
            const float rs = __builtin_amdgcn_rsqf(ss * (1.0f / 128.0f) + EPS);
            bf16* op = MIX + (size_t)(qrow0 + 32 * qg + crow(r, hi)) * D + h * 128 + r32;
#pragma unroll
            for (int db = 0; db < 4; ++db) op[db * 32] = (bf16)(pk2(o[db][r] * rs * gs[db], 0.f) & 0xffffu);
        }
    }
    __syncthreads();
}
}

struct Args { const float* in[23]; float* out; unsigned char* ws; int ph_lo, ph_hi; };
enum { I_XP = 0, I_XS, I_CK, I_CV, I_C, I_CCTX, I_WADA, I_BADA, I_GAPRE, I_GAPOST, I_GFPRE, I_GFPOST, I_WIN, I_CONVW, I_CONVB, I_LQ1, I_LK1, I_LQ2, I_LK2, I_GSUB, I_WOUT, I_WFI, I_WFO };
constexpr int N_PHASES = 9;

#define mod ((float*)(args.ws + WS_MOD))
#define rot ((float*)(args.ws + WS_ROT))
#define SS1 ((float*)(args.ws + WS_SS1))
#define SS2 ((float*)(args.ws + WS_SS2))
#define WinT ((bf16*)(args.ws + WS_WIN))
#define WoT ((bf16*)(args.ws + WS_WO))
#define WfiT ((bf16*)(args.ws + WS_WFI))
#define WfoT ((bf16*)(args.ws + WS_WFO))
#define U ((bf16*)(args.ws + WS_U))
#define MIXO ((bf16*)(args.ws + WS_MIXO))
#define Qb ((bf16*)(args.ws + WS_Q))
#define Kb ((bf16*)(args.ws + WS_K))
#define Vb ((bf16*)(args.ws + WS_V))
#define MIX ((bf16*)(args.ws + WS_MIX))
#define BG ((bf16*)(args.ws + WS_BG))
#define Z ((bf16*)(args.ws + WS_Z))
#define H ((bf16*)(args.ws + WS_H))
#define xp (args.in[I_XP])
#define xs (args.in[I_XS])
#define Y (args.out)
#define stK (args.out + (size_t)M * D)
#define stV (args.out + (size_t)M * D + (size_t)MP * 512)

namespace pg8 {
struct PanelOrder {
    int G, c, lo, hi;
    __device__ __forceinline__ bool next(int i, Unit& u) const { const int L = lo + i * G + c; if (L >= hi) return false; const int xcd = L & 7, w = L >> 3; u.pm = 18 * xcd + (w >> 2); u.pn = w & 3; return true; }
    __device__ __forceinline__ void a_ready(const Unit&) const {}
    __device__ __forceinline__ void done(const Unit&) const {}
};
}
__device__ __forceinline__ int rowmap(int e, bool late) { const int p = e >> 8; const int pm = late ? 18 * (p >> 1) + 16 + (p & 1) : 18 * (p >> 4) + (p & 15); return pm * 256 + (e & 255); }
__device__ __forceinline__ void tail_arrive(unsigned* cnt) {
    asm volatile("s_waitcnt vmcnt(0)" ::: "memory");
    __syncthreads();
    if (threadIdx.x == 0) {
        __builtin_amdgcn_fence(__ATOMIC_RELEASE, "agent");
        asm volatile("s_waitcnt vmcnt(0)" ::: "memory");
        (void)xb_add(cnt, 1u);
    }
}
__device__ __forceinline__ void tail_wait(unsigned* cnt, unsigned expect) {
    if (threadIdx.x == 0) {
        unsigned sp = 0u;
        while (xb_ld(cnt) < expect) { __builtin_amdgcn_s_sleep(1); if (++sp > (1u << 20)) break; }
        __builtin_amdgcn_fence(__ATOMIC_ACQUIRE, "agent");
        asm volatile("s_waitcnt vmcnt(0)" ::: "memory");
    }
    __syncthreads();
}
__device__ __forceinline__ void free_share(int f, int& e0, int& en) { if (f < 128) { e0 = f * 171; en = 171; } else { e0 = 128 * 171 + (f - 128) * 170; en = 170; } }
__device__ __forceinline__ void early_share(int bx, int na, int nb, int& e0, int& en) { if (bx < 64) { e0 = bx * nb; en = nb; } else { e0 = 64 * nb + (bx - 64) * na; en = na; } }
__device__ __forceinline__ void p5_rows(const Args& args, int e0, int en, bool late, int wave, int lane) {
        const float* gpo = args.in[I_GAPOST]; const float* gfp = args.in[I_GFPRE];
        for (int i0 = wave; i0 < en; i0 += 8 * 2) {
            f32x4 v[2][4]; v2u mo[2][4]; float ssp[2];
#pragma unroll
            for (int q = 0; q < 2; ++q) { const int idx = i0 + 8 * q; const int r = rowmap(e0 + idx, late); ssp[q] = 0.f;
                if (idx < en) { const float* xr = r < MP ? xp + (size_t)r * D : xs + (size_t)(r - MP) * D;
                    ssp[q] = SS1[(size_t)r * 16 + (lane & 15)];
#pragma unroll
                    for (int j = 0; j < 4; ++j) { v[q][j] = __builtin_nontemporal_load((const f32x4*)(xr + 4 * lane + 256 * j)); mo[q][j] = *(const v2u*)(MIXO + (size_t)r * D + 4 * lane + 256 * j); } } }
#pragma unroll
            for (int q = 0; q < 2; ++q) { const int idx = i0 + 8 * q; const int r = rowmap(e0 + idx, late);
                if (idx < en) {
                    const float* mp = mod + (r < MP ? 0 : 1 + ((r - MP) >> 12)) * 6144;
                    const float sp = row16_sum(ssp[q]);
                    const float rstd1 = __builtin_amdgcn_rsqf(sp * (1.f / D) + EPS); float s = 0.f;
#pragma unroll
                    for (int j = 0; j < 4; ++j) { const int c = 4 * lane + 256 * j;
                        const f32x4 mf = (f32x4){__uint_as_float(mo[q][j][0] << 16), __uint_as_float(mo[q][j][0] & 0xffff0000u), __uint_as_float(mo[q][j][1] << 16), __uint_as_float(mo[q][j][1] & 0xffff0000u)};
                        const f32x4 gg = *(const f32x4*)(gpo + c), ga = *(const f32x4*)(mp + 2048 + c);
                        v[q][j] = v[q][j] + ga * (mf * rstd1 * gg);
                        s += (v[q][j][0] * v[q][j][0] + v[q][j][1] * v[q][j][1]) + (v[q][j][2] * v[q][j][2] + v[q][j][3] * v[q][j][3]); }
                    const float rstd = __builtin_amdgcn_rsqf(wave_sum(s) * (1.f / D) + EPS);
#pragma unroll
                    for (int j = 0; j < 4; ++j) { const int c = 4 * lane + 256 * j; const f32x4 gg = *(const f32x4*)(gfp + c), sh = *(const f32x4*)(mp + 3072 + c), sc = *(const f32x4*)(mp + 4096 + c);
                        const f32x4 u = v[q][j] * rstd * gg * (sc + 1.f) + sh;
                        *(v2u*)(U + (size_t)r * D + c) = (v2u){pk2(u[0], u[1]), pk2(u[2], u[3])}; } } }
        }
}
__device__ __forceinline__ void p8_rows(const Args& args, int e0, int en, bool late, int wave, int lane) {
        const float* gpo = args.in[I_GAPOST]; const float* gfo = args.in[I_GFPOST];
        for (int i0 = wave; i0 < en; i0 += 8 * 2) {
            f32x4 v[2][4]; v2u mo[2][4], fo[2][4]; float ssp1[2], ssp2[2];
#pragma unroll
            for (int q = 0; q < 2; ++q) { const int idx = i0 + 8 * q; const int r = rowmap(e0 + idx, late); ssp1[q] = 0.f; ssp2[q] = 0.f;
                if (idx < en) { const float* xr = r < MP ? xp + (size_t)r * D : xs + (size_t)(r - MP) * D;
                    ssp1[q] = SS1[(size_t)r * 16 + (lane & 15)]; ssp2[q] = SS2[(size_t)r * 16 + (lane & 15)];
#pragma unroll
                    for (int j = 0; j < 4; ++j) { v[q][j] = __builtin_nontemporal_load((const f32x4*)(xr + 4 * lane + 256 * j)); mo[q][j] = *(const v2u*)(MIXO + (size_t)r * D + 4 * lane + 256 * j); fo[q][j] = *(const v2u*)(U + (size_t)r * D + 4 * lane + 256 * j); } } }
#pragma unroll
            for (int q = 0; q < 2; ++q) { const int idx = i0 + 8 * q; const int r = rowmap(e0 + idx, late);
                if (idx < en) {
                    const float* mp = mod + (r < MP ? 0 : 1 + ((r - MP) >> 12)) * 6144;
                    const float sp = row16_sum(ssp1[q]);
                    const float rstd1 = __builtin_amdgcn_rsqf(sp * (1.f / D) + EPS);
                    const float sq = row16_sum(ssp2[q]);
                    const float rstd2 = __builtin_amdgcn_rsqf(sq * (1.f / D) + EPS);
#pragma unroll
                    for (int j = 0; j < 4; ++j) { const int c = 4 * lane + 256 * j;
                        const f32x4 mf = (f32x4){__uint_as_float(mo[q][j][0] << 16), __uint_as_float(mo[q][j][0] & 0xffff0000u), __uint_as_float(mo[q][j][1] << 16), __uint_as_float(mo[q][j][1] & 0xffff0000u)};
                        const f32x4 ff = (f32x4){__uint_as_float(fo[q][j][0] << 16), __uint_as_float(fo[q][j][0] & 0xffff0000u), __uint_as_float(fo[q][j][1] << 16), __uint_as_float(fo[q][j][1] & 0xffff0000u)};
                        const f32x4 gg = *(const f32x4*)(gpo + c), ga = *(const f32x4*)(mp + 2048 + c);
                        const f32x4 x1 = v[q][j] + ga * (mf * rstd1 * gg);
                        const f32x4 g2 = *(const f32x4*)(gfo + c), gf = *(const f32x4*)(mp + 5120 + c);
                        __builtin_nontemporal_store(x1 + gf * (ff * rstd2 * g2), (f32x4*)(Y + (size_t)r * D + c)); } } }
        }
}
struct P0Item { const float* W; bf16* WT; int K, N, dst_row0, src_col0, k0; bool rperm; float scale; };
__device__ __forceinline__ P0Item p0_item(const Args& args, int it) {
    constexpr int I_1 = 16 * 96, I_2 = 16 * 32, I_3 = 16 * 176;
    P0Item q; int r = it; q.rperm = false; q.scale = 1.0f;
    if (r < I_1) { const int kb = r / 96, nb = r % 96, n0 = 32 * nb; int src = n0;
        if (n0 >= 2048) { const int j = (n0 - 2048) >> 8, c = (n0 - 2048) & 255; src = c < 128 ? 2048 + 128 * j + c : 2560 + 128 * j + (c - 128); }
        q.W = args.in[I_WIN]; q.WT = WinT; q.K = D; q.N = NIN; q.dst_row0 = n0; q.src_col0 = src; q.k0 = 64 * kb; q.rperm = n0 < 1024; return q; }
    r -= I_1;
    if (r < I_2) { const int kb = r / 32, nb = r % 32; q.W = args.in[I_WOUT]; q.WT = WoT; q.K = D; q.N = D; q.dst_row0 = 32 * nb; q.src_col0 = 32 * nb; q.k0 = 64 * kb; return q; }
    r -= I_2;
    if (r < I_3) { const int kb = r / 176, nb = r % 176, n0 = 32 * nb; const int j = n0 >> 8, c = n0 & 255; const int src = c < 128 ? 128 * j + c : DFF + 128 * j + (c - 128);
        q.W = args.in[I_WFI]; q.WT = WfiT; q.K = D; q.N = NFI; q.dst_row0 = n0; q.src_col0 = src; q.k0 = 64 * kb;
        q.scale = c < 128 ? -1.4426950408889634f : -0.6931471805599453f; return q; }
    r -= I_3;
    { const int kb = r / 32, nb = r % 32; q.W = args.in[I_WFO]; q.WT = WfoT; q.K = DFF; q.N = D; q.dst_row0 = 32 * nb; q.src_col0 = 32 * nb; q.k0 = 64 * kb; return q; }
}
__device__ __forceinline__ void p0_item_load(const P0Item& q, float (&tv)[32], int lane) {
#pragma unroll
    for (int i = 0; i < 32; ++i) { const int kk = 2 * i + (lane >> 5); tv[i] = __builtin_nontemporal_load(q.W + (size_t)(q.k0 + kk) * q.N + q.src_col0 + (lane & 31)); }
}
__device__ __forceinline__ void p0_item_finish(const P0Item& q, const float (&tv)[32], LAS float* scr, int lane) {
#pragma unroll
    for (int i = 0; i < 32; ++i) { const int kk = 2 * i + (lane >> 5); scr[kk * 33 + (lane & 31)] = tv[i] * q.scale; }
    asm volatile("s_waitcnt lgkmcnt(0)" ::: "memory");
    const int c = lane & 7;
#pragma unroll
    for (int j = 0; j < 4; ++j) { const int n = (lane >> 3) + 8 * j; const int ns = q.rperm ? (16 * ((n >> 2) & 1) + 4 * (n >> 3) + (n & 3)) : n; const LAS float* s = scr + (8 * c) * 33 + ns;
        v4u o; o.x = pk2(s[0 * 33], s[1 * 33]); o.y = pk2(s[2 * 33], s[3 * 33]); o.z = pk2(s[4 * 33], s[5 * 33]); o.w = pk2(s[6 * 33], s[7 * 33]);
        *(v4u*)(q.WT + (size_t)(q.dst_row0 + n) * q.K + q.k0 + 8 * c) = o; }
    asm volatile("s_waitcnt lgkmcnt(0)" ::: "memory");
}

__device__ __forceinline__ void p0_transposes(const Args& args, int it0, int it1, int widx, int nw, LAS float* scr, int lane) {
    int it = it0 + widx;
    if (it < it1) {
        P0Item cur = p0_item(args, it); float ta[32], tb[32];
        p0_item_load(cur, ta, lane);
        for (;;) {
            const int nx = it + nw; const bool more = nx < it1; P0Item nxt = cur;
            if (more) { nxt = p0_item(args, nx); p0_item_load(nxt, tb, lane); }
            p0_item_finish(cur, ta, scr, lane);
            if (!more) break;
#pragma unroll
            for (int i = 0; i < 32; ++i) ta[i] = tb[i];
            cur = nxt; it = nx;
        }
    }
}
constexpr int IT_WIN = 16 * 96, IT_WO = IT_WIN + 16 * 32, IT_WFI = IT_WO + 16 * 176, IT_WFO = IT_WFI + 44 * 32;

__global__ void __launch_bounds__(NTHREADS, 2) fwd_megakernel(Args args) {
    extern __shared__ __attribute__((aligned(16))) unsigned char lds_raw[];
    LAS unsigned char* lds = (LAS unsigned char*)lds_raw;
    cg::grid_group grid = cg::this_grid();
    const int tid = threadIdx.x, lane = tid & 63; const int wave = __builtin_amdgcn_readfirstlane(tid >> 6);
    const int G = gridDim.x, bx = blockIdx.x;
    const int vcu = (G % 8 == 0) ? (bx % 8) * (G / 8) + bx / 8 : bx;
    const int gw = vcu * NWAVES + wave, NGW = G * NWAVES;
    unsigned char* ws = args.ws;
    const int lo = args.ph_lo, hi_ph = args.ph_hi;
#define IN(k) (lo <= (k) && (k) < hi_ph)
    if (tid < 16) ((LAS unsigned*)(lds + MISC_OFF))[tid] = 0u;
    __syncthreads();
    XcdBarrier bar = xcd_barrier_post((unsigned*)(ws + WS_BAR), (volatile LAS unsigned*)(lds + MISC_OFF));
    if (lo < 0) grid.sync();
#ifdef PROBE_BAR2
#define SEAM(k) do { if (IN(k) && IN((k) + 1)) { xcd_barrier(bar); xcd_barrier(bar); } } while (0)
#else
#define SEAM(k) do { if (IN(k) && IN((k) + 1)) xcd_barrier(bar); } while (0)
#endif

    if (IN(0)) {
#ifdef PROBE_P0
      for (int rep_ = 0; rep_ < 3; ++rep_) {
#endif
        if (bx < 192) {
            LAS float* S = (LAS float*)lds; LAS float* red = (LAS float*)(lds + 9 * 1024 * 4);
            { float cv[18];
#pragma unroll
              for (int u = 0; u < 18; ++u) { const int e = tid + u * NTHREADS, i = e >> 10, k = e & 1023; cv[u] = (i == 0) ? args.in[I_CCTX][k] : args.in[I_C][(i - 1) * 1024 + k]; }
#pragma unroll
              for (int u = 0; u < 18; ++u) S[tid + u * NTHREADS] = cv[u] / (1.f + __expf(-cv[u])); }
            __syncthreads();
            const int kgp = tid >> 5, cl = tid & 31, j0 = 32 * bx;
            float a[9];
#pragma unroll
            for (int i = 0; i < 9; ++i) a[i] = 0.f;
            const float* wp = args.in[I_WADA] + (size_t)(kgp * 64) * 6144 + j0 + cl;
            float wv[64];
#pragma unroll
            for (int k = 0; k < 64; ++k) wv[k] = __builtin_nontemporal_load(wp + (size_t)k * 6144);
#pragma unroll
            for (int k = 0; k < 64; ++k) {
#pragma unroll
                for (int i = 0; i < 9; ++i) a[i] += S[i * 1024 + kgp * 64 + k] * wv[k]; }
#pragma unroll
            for (int i = 0; i < 9; ++i) red[(kgp * 9 + i) * 32 + cl] = a[i];
            __syncthreads();
            if (tid < 288) { const int i = tid >> 5; float s = args.in[I_BADA][j0 + cl];
#pragma unroll
                for (int g = 0; g < 16; ++g) s += red[(g * 9 + i) * 32 + cl];
                mod[i * 6144 + j0 + cl] = s; }
            tail_arrive((unsigned*)(args.ws + WS_BAR) + 3712);
        }
        p0_transposes(args, 0, IT_WIN, gw, NGW, (LAS float*)(lds + wave * 16384), lane);
        {
            f32x4 cv0[2], cv1[2];
#pragma unroll
            for (int u = 0; u < 2; ++u) { const int ir = gw + u * NGW;
                if (ir < 2 * NB_S * PAST) { const int which = ir / (NB_S * PAST), rr = ir % (NB_S * PAST);
                    const float* src_ = args.in[which ? I_CV : I_CK] + (size_t)rr * 512 + lane * 8; cv0[u] = *(const f32x4*)src_; cv1[u] = *(const f32x4*)(src_ + 4); } }
#pragma unroll
            for (int u = 0; u < 2; ++u) { const int ir = gw + u * NGW;
                if (ir < 2 * NB_S * PAST) { const int which = ir / (NB_S * PAST), rr = ir % (NB_S * PAST), b = rr / PAST, j = rr % PAST;
                    bf16* drow = (which ? Vb : Kb) + (size_t)(MP + b * KV_PER_B + j) * 512;
                    if (which) *(v4u*)(drow + lane * 8) = (v4u){pk2(cv0[u][0], cv0[u][1]), pk2(cv0[u][2], cv0[u][3]), pk2(cv1[u][0], cv1[u][1]), pk2(cv1[u][2], cv1[u][3])};
                    else { const int l0 = lane * 8, g32 = l0 & ~31, la = l0 & 31, lb = la + 4;
                        *(v2u*)(drow + g32 + 8 * ((la >> 2) & 3) + 4 * (la >> 4)) = (v2u){pk2(cv0[u][0], cv0[u][1]), pk2(cv0[u][2], cv0[u][3])};
                        *(v2u*)(drow + g32 + 8 * ((lb >> 2) & 3) + 4 * (lb >> 4)) = (v2u){pk2(cv1[u][0], cv1[u][1]), pk2(cv1[u][2], cv1[u][3])}; } } }
            for (int ir = gw + 2 * NGW; ir < 2 * NB_S * PAST; ir += NGW) {
                const int which = ir / (NB_S * PAST), rr = ir % (NB_S * PAST), b = rr / PAST, j = rr % PAST;
                const float* src_ = args.in[which ? I_CV : I_CK] + (size_t)rr * 512 + lane * 8;
                const f32x4 v0 = *(const f32x4*)src_, v1 = *(const f32x4*)(src_ + 4);
                bf16* drow = (which ? Vb : Kb) + (size_t)(MP + b * KV_PER_B + j) * 512;
                if (which) *(v4u*)(drow + lane * 8) = (v4u){pk2(v0[0], v0[1]), pk2(v0[2], v0[3]), pk2(v1[0], v1[1]), pk2(v1[2], v1[3])};
                else { const int l0 = lane * 8, g32 = l0 & ~31, la = l0 & 31, lb = la + 4;
                    *(v2u*)(drow + g32 + 8 * ((la >> 2) & 3) + 4 * (la >> 4)) = (v2u){pk2(v0[0], v0[1]), pk2(v0[2], v0[3])};
                    *(v2u*)(drow + g32 + 8 * ((lb >> 2) & 3) + 4 * (lb >> 4)) = (v2u){pk2(v1[0], v1[1]), pk2(v1[2], v1[3])}; }
            }
        }
        if (bx == 255 || (G < 256 && bx == 0)) {
            for (int e = tid; e < 1024; e += NTHREADS) { const int pos = e >> 4, i = e & 15; const float inv = 1.0f / powf(10000.0f, (float)i / 16.0f); const float ang = (float)pos * inv; rot[e] = cosf(ang); rot[1024 + e] = sinf(ang); }
        }
#ifdef PROBE_P0
      __syncthreads(); }
#endif
    }
    if (IN(0) && IN(1)) tail_wait((unsigned*)(args.ws + WS_BAR) + 3712, 192u);

    if (IN(1)) {
        const float* g = args.in[I_GAPRE];
#ifdef PROBE_ROWS
        for (int rep_ = 0; rep_ < 2; ++rep_)
#endif
        for (int r0 = gw; r0 < M; r0 += 3 * NGW) {
            f32x4 v[3][4]; float s[3];
#pragma unroll
            for (int q = 0; q < 3; ++q) { const int r = r0 + q * NGW; s[q] = 0.f;
                if (r < M) { const float* xr = r < MP ? xp + (size_t)r * D : xs + (size_t)(r - MP) * D;
#pragma unroll
                    for (int j = 0; j < 4; ++j) v[q][j] = __builtin_nontemporal_load((const f32x4*)(xr + 4 * lane + 256 * j)); } }
#pragma unroll
            for (int q = 0; q < 3; ++q) { const int r = r0 + q * NGW;
                if (r < M) {
#pragma unroll
                    for (int j = 0; j < 4; ++j) s[q] += (v[q][j][0] * v[q][j][0] + v[q][j][1] * v[q][j][1]) + (v[q][j][2] * v[q][j][2] + v[q][j][3] * v[q][j][3]);
                    const float rstd = __builtin_amdgcn_rsqf(wave_sum(s[q]) * (1.f / D) + EPS);
                    const float* mp = mod + (r < MP ? 0 : 1 + ((r - MP) >> 12)) * 6144;
#pragma unroll
                    for (int j = 0; j < 4; ++j) { const int c = 4 * lane + 256 * j; const f32x4 gg = *(const f32x4*)(g + c), sh = *(const f32x4*)(mp + c), sc = *(const f32x4*)(mp + 1024 + c);
                        const f32x4 u = v[q][j] * rstd * gg * (sc + 1.f) + sh;
                        *(v2u*)(U + (size_t)r * D + c) = (v2u){pk2(u[0], u[1]), pk2(u[2], u[3])}; } } }
        }
    }
    SEAM(1);

    if (IN(2)) {
        pg8::Gemm g{U, WinT, M, NIN, D}; pg8::StaticOrder S; S.init(M, NIN, G, bx);
        pg8::EpiIn E{Qb, Kb, Vb, BG, Z, stK, stV, rot};
        pg8::gemm_phase<pg8::EpiIn, pg8::StaticOrder, PG8_ALIGN, PG8_SP2>(lds, g, S, E);
        if (G == 256 && bx >= 192) p0_transposes(args, IT_WIN, IT_WFI, (bx - 192) * NWAVES + wave, 64 * NWAVES, (LAS float*)(lds + wave * 16384), lane);
        else if (G != 256) p0_transposes(args, IT_WIN, IT_WFI, gw, NGW, (LAS float*)(lds + wave * 16384), lane);
#ifdef PROBE_GEMM2
        __syncthreads(); pg8::gemm_phase<pg8::EpiIn, pg8::StaticOrder, PG8_ALIGN, PG8_SP2>(lds, g, S, E);
#endif
    }
    SEAM(2);

    if (IN(3)) {
        {
            const float* cw = args.in[I_CONVW]; const float* cb = args.in[I_CONVB];
            const int c8 = (tid & 63) * 8;
            float w0[8], w1[8], w2[8], bb[8];
#pragma unroll
            for (int e = 0; e < 8; ++e) { w0[e] = cw[c8 + e]; w1[e] = cw[512 + c8 + e]; w2[e] = cw[1024 + c8 + e]; bb[e] = cb[c8 + e]; }
            const bool hasp = (G == 256) && (vcu < NB_P * 4 * 2); const int cn = (G == 256) ? (hasp ? 112 : 176) : (M + G - 1) / G; const int cbase = (G == 256) ? (hasp ? vcu * 112 : 128 * 112 + (vcu - 128) * 176) : vcu * cn;
#ifdef PROBE_CONV
            for (int rep_ = 0; rep_ < 3; ++rep_)
#endif
            for (int i0 = wave; i0 < cn; i0 += 24) {
                v4u zc[3], zp[3], zn[3], bg[3];
#pragma unroll
                for (int q = 0; q < 3; ++q) { const int idx = i0 + 8 * q; const int r = cbase + idx;
                    zp[q] = (v4u){0u, 0u, 0u, 0u}; zn[q] = (v4u){0u, 0u, 0u, 0u}; zc[q] = zp[q]; bg[q] = zp[q];
                    if (idx < cn && r < M) { const int t = r < MP ? (r & (SEQ_P - 1)) : ((r - MP) & (SEQ_S - 1)); const int L = r < MP ? SEQ_P : SEQ_S;
                        zc[q] = *(const v4u*)(Z + (size_t)r * 512 + c8); bg[q] = *(const v4u*)(BG + (size_t)r * 512 + c8);
                        if (t > 0) zp[q] = *(const v4u*)(Z + (size_t)(r - 1) * 512 + c8);
                        if (t < L - 1) zn[q] = *(const v4u*)(Z + (size_t)(r + 1) * 512 + c8); } }
#pragma unroll
                for (int q = 0; q < 3; ++q) { const int idx = i0 + 8 * q; const int r = cbase + idx;
                    if (idx < cn && r < M) { float o[8];
#pragma unroll
                        for (int e = 0; e < 4; ++e) {
                            const float zc0 = __uint_as_float(zc[q][e] << 16), zc1 = __uint_as_float(zc[q][e] & 0xffff0000u), zp0 = __uint_as_float(zp[q][e] << 16), zp1 = __uint_as_float(zp[q][e] & 0xffff0000u);
                            const float zn0 = __uint_as_float(zn[q][e] << 16), zn1 = __uint_as_float(zn[q][e] & 0xffff0000u), b0 = __uint_as_float(bg[q][e] << 16), b1 = __uint_as_float(bg[q][e] & 0xffff0000u);
                            o[2 * e] = b0 * (w0[2 * e] * zp0 + w1[2 * e] * zc0 + w2[2 * e] * zn0 + bb[2 * e]);
                            o[2 * e + 1] = b1 * (w0[2 * e + 1] * zp1 + w1[2 * e + 1] * zc1 + w2[2 * e + 1] * zn1 + bb[2 * e + 1]); }
                        *(v4u*)(MIX + (size_t)r * D + 512 + c8) = (v4u){pk2(o[0], o[1]), pk2(o[2], o[3]), pk2(o[4], o[5]), pk2(o[6], o[7])}; } }
            }
        }
        float lam;
        { const float a = args.in[I_LQ1][lane] * args.in[I_LK1][lane], b = args.in[I_LQ2][lane] * args.in[I_LK2][lane];
          lam = __expf(wave_sum(a)) - __expf(wave_sum(b)) + 0.2f; }
        __syncthreads();
        const float* gsub = args.in[I_GSUB];
        for (int i = vcu; i < NB_S * 4 * 32; i += G) {
            const int bh = (i >> 5) & 31, qb = i & 31; const int b = bh >> 2, h = bh & 3;
            att::attn_unit((LAS char*)lds, Qb, Kb, Vb, MIX, MP + b * SEQ_S + qb * 128, MP + b * KV_PER_B, KV_PER_B / 64, h, lam, gsub);
        }
#ifdef PROBE_ATT2
        for (int i = vcu; i < NB_S * 4 * 32; i += G) {
            const int bh = (i >> 5) & 31, qb = i & 31; const int b = bh >> 2, h = bh & 3;
            att::attn_unit((LAS char*)lds, Qb, Kb, Vb, MIX, MP + b * SEQ_S + qb * 128, MP + b * KV_PER_B, KV_PER_B / 64, h, lam, gsub);
        }
#endif
        for (int i = vcu; i < NB_P * 4 * 2; i += G) {
            const int b = i >> 3, h = (i >> 1) & 3, qb = i & 1;
            att::attn_unit((LAS char*)lds, Qb, Kb, Vb, MIX, b * SEQ_P + qb * 128, b * SEQ_P, SEQ_P / 64, h, lam, gsub);
        }
    }
    SEAM(3);

    if (IN(4)) {
        pg8::Gemm g{MIX, WoT, M, D, D}; pg8::PanelOrder S{G, bx, 0, 512}; pg8::EpiSS E{MIXO, SS1};
        pg8::gemm_phase<pg8::EpiSS, pg8::PanelOrder, PG8_ALIGN, PG8_SP2>(lds, g, S, E);
    }
    SEAM(4);
    if (IN(5)) {
        unsigned* cnt = (unsigned*)(args.ws + WS_BAR) + 3584;
        if (bx < 64) { pg8::Gemm g{MIX, WoT, M, D, D}; pg8::PanelOrder S{G, bx, 512, 576}; pg8::EpiSS E{MIXO, SS1};
            pg8::gemm_phase<pg8::EpiSS, pg8::PanelOrder, PG8_ALIGN, PG8_SP2>(lds, g, S, E);
            tail_arrive(cnt); }
        int e0, en; early_share(bx, 144, 80, e0, en);
        p5_rows(args, e0, en, false, wave, lane);
        tail_wait(cnt, 64u);
        p5_rows(args, bx * 16, 16, true, wave, lane);
    }
    SEAM(5);
    if (IN(6)) {
        pg8::Gemm g{U, WfiT, M, NFI, D}; pg8::StaticOrder S; S.init(M, NFI, G, bx);
        pg8::EpiGlu E{H};
        pg8::gemm_phase<pg8::EpiGlu, pg8::StaticOrder, PG8_ALIGN, PG8_SP2>(lds, g, S, E);
        if (G == 256 && bx >= 96) p0_transposes(args, IT_WFI, IT_WFO, (bx - 96) * NWAVES + wave, 160 * NWAVES, (LAS float*)(lds + wave * 16384), lane);
        else if (G != 256) p0_transposes(args, IT_WFI, IT_WFO, gw, NGW, (LAS float*)(lds + wave * 16384), lane);
    }
    SEAM(6);
    if (IN(7)) {
        pg8::Gemm g{H, WfoT, M, D, DFF}; pg8::PanelOrder S{G, bx, 0, 512}; pg8::EpiSS E{U, SS2};
        pg8::gemm_phase<pg8::EpiSS, pg8::PanelOrder, PG8_ALIGN, PG8_SP2>(lds, g, S, E);
    }
    SEAM(7);
    if (IN(8)) {
        unsigned* cnt = (unsigned*)(args.ws + WS_BAR) + 3648;
        if (bx < 64) { pg8::Gemm g{H, WfoT, M, D, DFF}; pg8::PanelOrder S{G, bx, 512, 576}; pg8::EpiSS E{U, SS2};
            pg8::gemm_phase<pg8::EpiSS, pg8::PanelOrder, PG8_ALIGN, PG8_SP2>(lds, g, S, E);
            tail_arrive(cnt); }
        if (bx >= 64) { int e0, en; free_share(bx - 64, e0, en); p8_rows(args, e0, en, false, wave, lane); }
        tail_wait(cnt, 64u);
        p8_rows(args, bx * 16, 16, true, wave, lane);
    }
#undef IN
#undef SEAM
#undef mod
#undef rot
#undef SS1
#undef SS2
#undef WinT
#undef WoT
#undef WfiT
#undef WfoT
#undef U
#undef MIXO
#undef Qb
#undef Kb
#undef Vb
#undef MIX
#undef BG
#undef Z
#undef H
#undef xp
#undef xs
#undef Y
#undef stK
#undef stV
}

extern "C" void kernel_launch(void* const* d_in, const int* in_sizes, int n_in, void* d_out, int out_size, void* d_ws, size_t ws_size, hipStream_t stream) {
    static int grid = 0;
    if (grid == 0) {
        if (n_in != 23 || ws_size < WS_END || out_size != M * D + 2 * MP * 512) { fprintf(stderr, "kernel_launch: unexpected problem (n_in %d, ws %zu, out %d)\n", n_in, ws_size, out_size); grid = -1; return; }
        int dev = 0, cus = 0, per_cu = 0;
        hipGetDevice(&dev); hipDeviceGetAttribute(&cus, hipDeviceAttributeMultiprocessorCount, dev);
        if (hipFuncSetAttribute((const void*)fwd_megakernel, hipFuncAttributeMaxDynamicSharedMemorySize, LDS_BYTES) != hipSuccess) { fprintf(stderr, "kernel_launch: hipFuncSetAttribute failed\n"); grid = -1; return; }
        if (hipOccupancyMaxActiveBlocksPerMultiprocessor(&per_cu, (const void*)fwd_megakernel, NTHREADS, LDS_BYTES) != hipSuccess || per_cu < 1) { fprintf(stderr, "kernel_launch: occupancy query failed (%d)\n", per_cu); (void)hipGetLastError(); per_cu = 1; }
        grid = cus * 1;
        if (grid > cus * per_cu) grid = cus * per_cu;
    }
    if (grid < 0) return;
    Args a{};
    for (int i = 0; i < 23; ++i) a.in[i] = (const float*)d_in[i];
    a.out = (float*)d_out; a.ws = (unsigned char*)d_ws;
    if (hipMemsetAsync((char*)d_ws + WS_BAR, 0, BAR_BYTES, stream) != hipSuccess) { fprintf(stderr, "kernel_launch: memset failed\n"); return; }
#if MK_COOP
    a.ph_lo = 0; a.ph_hi = N_PHASES;
    void* kargs[] = {&a};
    hipError_t e = hipLaunchCooperativeKernel((const void*)fwd_megakernel, dim3(grid), dim3(NTHREADS), kargs, LDS_BYTES, stream);
    if (e != hipSuccess) fprintf(stderr, "cooperative launch failed: %s (grid %d)\n", hipGetErrorString(e), grid);
#else
    for (int p = 0; p < N_PHASES; ++p) { a.ph_lo = p; a.ph_hi = p + 1; hipLaunchKernelGGL(fwd_megakernel, dim3(grid), dim3(NTHREADS), LDS_BYTES, stream, a); }
#endif
}
```
